# Optimizing an MI355X kernel written in HIP

```python
import jax, jax.numpy as jnp
from jax import lax
import numpy as np

D_MODEL = 1024
BATCH = 32
SEQ = 2048
DEPTH = 2

CHUNK = 64
N_META = 16
EPS = 1e-6
ROPE_BASE = 10000.0

RET_HEADS = D_MODEL // 256
RET_DK = 128
RET_DV = 128
HG_HEADS = D_MODEL // 256
HG_DK = 128
HG_DV = 128
RW_HEADS = D_MODEL // 128
RW_HD = 64
RW_DECAY_LORA = 64
RW_AAA_LORA = 64
RW_GATE_LORA = 128
RW_LNX_EPS = 64e-5
GDN_HEADS = D_MODEL // 256
GDN_DK = 128
GDN_DV = 128
GDN_CONV = 4
D_FF = 128 * ((8 * D_MODEL // 3 + 127) // 128)
FFN_CONV = 3

RET_KW = RET_HEADS * RET_DK
RET_VW = RET_HEADS * RET_DV
HG_KW = HG_HEADS * HG_DK
HG_VW = HG_HEADS * HG_DV
RW_W = RW_HEADS * RW_HD
GDN_KW = GDN_HEADS * GDN_DK
GDN_VW = GDN_HEADS * GDN_DV

EVEN_SPLITS = (RET_KW, RET_KW, RET_VW, RET_VW, HG_KW, HG_KW, HG_VW, HG_VW)
EVEN_IN = sum(EVEN_SPLITS)
EVEN_MIX = RET_VW + HG_VW
RW_SPLITS = (RW_W, RW_W, RW_W, RW_DECAY_LORA, RW_AAA_LORA, RW_GATE_LORA)
RW_IN = sum(RW_SPLITS)
GDN_CONV_CH = 2 * GDN_KW + GDN_VW
GDN_REST = (GDN_VW, GDN_HEADS, GDN_HEADS)
GDN_IN = GDN_CONV_CH + sum(GDN_REST)
ODD_IN = RW_IN + GDN_IN
ODD_MIX = RW_W + GDN_VW

N_EVEN = (DEPTH + 1) // 2
N_ODD = DEPTH // 2

kernel_name = 'hybrid_retention_hgrn2_rwkv7_gdn_convffn'

F32 = jnp.float32


def split_cols(p, sizes):
    return jnp.split(p, [int(c) for c in np.cumsum(sizes)[:-1]], axis=-1)


def rmsnorm(x, g):
    xf = x.astype(F32)
    y = xf * lax.rsqrt(jnp.mean(xf * xf, axis=-1, keepdims=True) + EPS)
    return (y * g.astype(F32)).astype(x.dtype)


def head_layernorm(x, eps):
    xf = x.astype(F32)
    xc = xf - jnp.mean(xf, axis=-1, keepdims=True)
    return xc * lax.rsqrt(jnp.mean(xc * xc, axis=-1, keepdims=True) + eps)


def l2norm(x):
    xf = x.astype(F32)
    return xf * lax.rsqrt(jnp.sum(xf * xf, axis=-1, keepdims=True) + EPS)


def token_shift(t):
    return jnp.pad(t[:, :-1], ((0, 0), (1, 0), (0, 0)))


def causal_dwconv(t, w):
    k_taps = w.shape[0]
    l = t.shape[1]
    tp = jnp.pad(t, ((0, 0), (k_taps - 1, 0), (0, 0)))
    y = tp[:, 0:l] * w[0]
    for j in range(1, k_taps):
        y = y + tp[:, j:j + l] * w[j]
    return y


def rotary(t, pos):
    half = t.shape[-1] // 2
    inv = ROPE_BASE ** (-jnp.arange(half, dtype=F32) / half)
    ang = pos.astype(F32)[:, None] * inv[None, :]
    cos = jnp.cos(ang)[None, :, None, :]
    sin = jnp.sin(ang)[None, :, None, :]
    t1 = t[..., :half].astype(F32)
    t2 = t[..., half:].astype(F32)
    return jnp.concatenate([t1 * cos - t2 * sin, t1 * sin + t2 * cos], axis=-1)


def to_chunks(t):
    b, l, h, d = t.shape
    pad = (-l) % CHUNK
    t = jnp.pad(t.astype(F32), ((0, 0), (pad, 0), (0, 0), (0, 0)))
    n = (l + pad) // CHUNK
    return t.reshape(b, n, CHUNK, h, d).transpose(1, 0, 3, 2, 4)


def from_chunks(t, l):
    n, b, h, c, d = t.shape
    return t.transpose(1, 0, 3, 2, 4).reshape(b, n * c, h, d)[:, n * c - l:]


def retention_chunkwise(q, k, v):
    b, l, h, dk = q.shape
    dv = v.shape[-1]
    log_gamma = jnp.log1p(-jnp.exp2(-5.0 - jnp.arange(h, dtype=F32)))
    idx = jnp.arange(CHUNK, dtype=F32)
    diff = idx[:, None] - idx[None, :]
    intra = jnp.where(diff >= 0, jnp.exp(log_gamma[:, None, None] * jnp.maximum(diff, 0.0)), 0.0)
    q_dec = jnp.exp(log_gamma[:, None] * (idx + 1.0))[..., None]
    k_dec = jnp.exp(log_gamma[:, None] * (CHUNK - 1.0 - idx))[..., None]
    s_dec = jnp.exp(log_gamma * CHUNK)[:, None, None]

    def step(s, inp):
        qi, ki, vi = inp
        att = jnp.einsum('bhid,bhjd->bhij', qi, ki) * intra
        o = jnp.einsum('bhij,bhjv->bhiv', att, vi) + jnp.einsum('bhid,bhdv->bhiv', qi * q_dec, s)
        s = s * s_dec + jnp.einsum('bhjd,bhjv->bhdv', ki * k_dec, vi)
        return s, o

    s0 = jnp.zeros((b, h, dk, dv), F32)
    _, o = lax.scan(step, s0, (to_chunks(q), to_chunks(k), to_chunks(v)))
    return from_chunks(o, l)


def hgrn2_chunkwise(q, k, v, log_f):
    b, l, h, dk = q.shape
    dv = v.shape[-1]
    causal = jnp.tril(jnp.ones((CHUNK, CHUNK), bool))[:, :, None]

    def step(s, inp):
        qi, ki, vi, lfi = inp
        cb = jnp.cumsum(lfi, axis=2)
        rel = jnp.exp(jnp.where(causal, cb[:, :, :, None, :] - cb[:, :, None, :, :], -jnp.inf))
        att = jnp.einsum('bhid,bhjd,bhijd->bhij', qi, ki, rel)
        o = jnp.einsum('bhij,bhjv->bhiv', att, vi) + jnp.einsum('bhid,bhdv->bhiv', qi * jnp.exp(cb), s)
        last = cb[:, :, -1:, :]
        s = s * jnp.exp(last)[:, :, 0, :, None] + jnp.einsum('bhjd,bhjv->bhdv', ki * jnp.exp(last - cb), vi)
        return s, o

    s0 = jnp.zeros((b, h, dk, dv), F32)
    _, o = lax.scan(step, s0, (to_chunks(q), to_chunks(k), to_chunks(v), to_chunks(log_f)))
    return from_chunks(o, l)


def gated_delta_chunkwise(q, k, v, g, beta):
    b, l, h, dk = q.shape
    dv = v.shape[-1]
    qc, kc, vc = to_chunks(q), to_chunks(k), to_chunks(v)
    gc = to_chunks(g[..., None])[..., 0]
    bc = to_chunks(beta[..., None])[..., 0]
    cg = jnp.cumsum(gc, axis=-1)
    incl = jnp.tril(jnp.ones((CHUNK, CHUNK), bool))
    strict = jnp.tril(jnp.ones((CHUNK, CHUNK), bool), -1)
    decay_in = jnp.exp(jnp.where(incl, cg[..., :, None] - cg[..., None, :], -jnp.inf))
    kk = jnp.einsum('nbhid,nbhjd->nbhij', kc, kc)
    m = jnp.eye(CHUNK, dtype=F32) + jnp.where(strict, bc[..., :, None] * kk * decay_in, 0.0)
    rhs = jnp.concatenate([bc[..., None] * vc, bc[..., None] * kc * jnp.exp(cg)[..., None]], axis=-1)
    sol = lax.linalg.triangular_solve(m, rhs, left_side=True, lower=True, unit_diagonal=True)
    u, w = sol[..., :dv], sol[..., dv:]
    qk = jnp.einsum('nbhid,nbhjd->nbhij', qc, kc) * decay_in
    q_in = qc * jnp.exp(cg)[..., None]
    k_out = kc * jnp.exp(cg[..., -1:] - cg)[..., None]
    s_dec = jnp.exp(cg[..., -1])[..., None, None]

    def step(s, inp):
        q_i, k_i, u_i, w_i, qk_i, sd_i = inp
        v_new = u_i - jnp.einsum('bhcd,bhdv->bhcv', w_i, s)
        o = jnp.einsum('bhcd,bhdv->bhcv', q_i, s) + jnp.einsum('bhij,bhjv->bhiv', qk_i, v_new)
        s = s * sd_i + jnp.einsum('bhcd,bhcv->bhdv', k_i, v_new)
        return s, o

    s0 = jnp.zeros((b, h, dk, dv), F32)
    _, o = lax.scan(step, s0, (q_in, k_out, u, w, qk, s_dec))
    return from_chunks(o, l)


def rwkv7_scan(r, w, k, v, a, bb):
    bsz, l, h, d = r.shape

    def step(s, inp):
        rt, wt, kt, vt, at, bt = inp
        sa = jnp.einsum('bhvk,bhk->bhv', s, at)
        s = s * wt[:, :, None, :] + sa[..., None] * bt[:, :, None, :] + vt[..., None] * kt[:, :, None, :]
        return s, jnp.einsum('bhvk,bhk->bhv', s, rt)

    tm = lambda t: jnp.swapaxes(t.astype(F32), 0, 1)
    s0 = jnp.zeros((bsz, h, d, d), F32)
    _, y = lax.scan(step, s0, tuple(tm(t) for t in (r, w, k, v, a, bb)))
    return jnp.swapaxes(y, 0, 1)


def even_mixer(u, w_in, w_out, lb, hg_gain, pos):
    bsz, l, _ = u.shape
    p = u @ w_in
    qa, ka, va, ga, qb, fb, ib, gb = split_cols(p, EVEN_SPLITS)
    hs = lambda t, h: t.reshape(bsz, l, h, -1)
    qa = rotary(hs(qa, RET_HEADS), pos)
    ka = rotary(hs(ka, RET_HEADS), pos) * (RET_DK ** -0.5)
    oa = retention_chunkwise(qa, ka, hs(va, RET_HEADS))
    oa = head_layernorm(oa, EPS) * jax.nn.silu(hs(ga, RET_HEADS).astype(F32))
    fb32 = fb.astype(F32)
    lb32 = lb.astype(F32)
    log_f = jnp.log(lb32 + (1.0 - lb32) * jax.nn.sigmoid(fb32))
    kb = (1.0 - lb32) * jax.nn.sigmoid(-fb32)
    ob = hgrn2_chunkwise(hs(qb, HG_HEADS), hs(kb, HG_HEADS), hs(ib, HG_HEADS), hs(log_f, HG_HEADS))
    ob = rmsnorm(ob, hg_gain.reshape(HG_HEADS, HG_DV)) * jax.nn.silu(hs(gb, HG_HEADS).astype(F32))
    y = jnp.concatenate([oa.reshape(bsz, l, RET_VW), ob.reshape(bsz, l, HG_VW)], axis=-1).astype(u.dtype)
    return y @ w_out


def odd_mixer(u, w_in, w_out, rw_mu, rw_w0, rw_w2, rw_a0, rw_a2, rw_g2, rw_kk_scale, rw_ka_scale,
              rw_rk, rw_lnx_w, rw_lnx_b, gdn_conv_w, gdn_a_log, gdn_dt_bias, gdn_norm_gain):
    bsz, l, _ = u.shape
    p = u @ w_in
    pc, pd = p[..., :RW_IN], p[..., RW_IN:]
    pc = pc + (token_shift(pc) - pc) * rw_mu
    r, k, v, w_lo, a_lo, g_lo = split_cols(pc, RW_SPLITS)
    rh = lambda t: t.reshape(bsz, l, RW_HEADS, RW_HD)
    log_w = -jax.nn.softplus(-(rw_w0 + jnp.tanh(w_lo) @ rw_w2).astype(F32)) - 0.5
    decay = jnp.exp(-jnp.exp(log_w))
    a = jax.nn.sigmoid((rw_a0 + a_lo @ rw_a2).astype(F32))
    gate = jax.nn.sigmoid(g_lo) @ rw_g2
    kk = l2norm(rh(k * rw_kk_scale))
    k = k.astype(F32) * (1.0 + (a - 1.0) * rw_ka_scale.astype(F32))
    r_h, k_h, v_h, a_h = rh(r.astype(F32)), rh(k), rh(v.astype(F32)), rh(a)
    y = rwkv7_scan(r_h, rh(decay), k_h, v_h, -kk, kk * a_h)
    y = head_layernorm(y, RW_LNX_EPS) * rw_lnx_w.reshape(RW_HEADS, RW_HD) + rw_lnx_b.reshape(RW_HEADS, RW_HD)
    y = y + jnp.sum(r_h * k_h * rw_rk, axis=-1, keepdims=True) * v_h
    y_c = y.reshape(bsz, l, RW_W) * gate
    qkv = jax.nn.silu(causal_dwconv(pd[..., :GDN_CONV_CH], gdn_conv_w))
    qd, kd, vd = split_cols(qkv, (GDN_KW, GDN_KW, GDN_VW))
    og, al, be = split_cols(pd[..., GDN_CONV_CH:], GDN_REST)
    gh = lambda t: t.reshape(bsz, l, GDN_HEADS, -1)
    qd = l2norm(gh(qd)) * (GDN_DK ** -0.5)
    kd = l2norm(gh(kd))
    g_log = -jnp.exp(gdn_a_log.astype(F32)) * jax.nn.softplus((al + gdn_dt_bias).astype(F32))
    beta = jax.nn.sigmoid(be.astype(F32))
    o = gated_delta_chunkwise(qd, kd, gh(vd), g_log, beta)
    o = rmsnorm(o, gdn_norm_gain) * jax.nn.silu(gh(og).astype(F32))
    y_d = o.reshape(bsz, l, GDN_VW)
    y = jnp.concatenate([y_c, y_d], axis=-1).astype(u.dtype)
    return y @ w_out


def conv_ffn(h, w_up, conv_w, conv_b, w_down):
    z = causal_dwconv(h @ w_up, conv_w) + conv_b
    gate, val = z[..., :D_FF], z[..., D_FF:]
    return (jax.nn.silu(gate) * val) @ w_down


def setup_inputs(seed: int = 0) -> dict:
    key = jax.random.key(seed)
    ks = iter(jax.random.split(key, 40))
    nrm = lambda shape, scale: jax.random.normal(next(ks), shape, F32) * scale
    dt = jnp.exp(jax.random.uniform(next(ks), (N_ODD, GDN_HEADS), F32, np.log(1e-3), np.log(1e-1)))
    return {
        'x': nrm((BATCH, SEQ, D_MODEL), 1.0),
        'meta_tokens': nrm((N_META, D_MODEL), 1.0),
        'norm_gains': 1.0 + nrm((DEPTH, 4, D_MODEL), 0.02),
        'w_in_even': nrm((N_EVEN, D_MODEL, EVEN_IN), D_MODEL ** -0.5),
        'w_out_even': nrm((N_EVEN, EVEN_MIX, D_MODEL), EVEN_MIX ** -0.5),
        'hg_lb_logits': nrm((DEPTH + 1, HG_KW), 0.5),
        'hg_norm_gain': 1.0 + nrm((N_EVEN, HG_VW), 0.02),
        'w_in_odd': nrm((N_ODD, D_MODEL, ODD_IN), D_MODEL ** -0.5),
        'w_out_odd': nrm((N_ODD, ODD_MIX, D_MODEL), ODD_MIX ** -0.5),
        'rw_mu': jax.random.uniform(next(ks), (N_ODD, RW_IN), F32),
        'rw_w0': -1.0 + nrm((N_ODD, RW_W), 1.0),
        'rw_w2': nrm((N_ODD, RW_DECAY_LORA, RW_W), 0.5 * RW_DECAY_LORA ** -0.5),
        'rw_a0': nrm((N_ODD, RW_W), 0.5),
        'rw_a2': nrm((N_ODD, RW_AAA_LORA, RW_W), 0.5 * RW_AAA_LORA ** -0.5),
        'rw_g2': nrm((N_ODD, RW_GATE_LORA, RW_W), RW_GATE_LORA ** -0.5),
        'rw_kk_scale': 0.85 + nrm((N_ODD, RW_W), 0.1),
        'rw_ka_scale': 1.0 + nrm((N_ODD, RW_W), 0.1),
        'rw_rk': nrm((N_ODD, RW_HEADS, RW_HD), 0.1),
        'rw_lnx_w': 1.0 + nrm((N_ODD, RW_W), 0.02),
        'rw_lnx_b': nrm((N_ODD, RW_W), 0.02),
        'gdn_conv_w': nrm((N_ODD, GDN_CONV, GDN_CONV_CH), GDN_CONV ** -0.5),
        'gdn_a_log': jnp.log(jax.random.uniform(next(ks), (N_ODD, GDN_HEADS), F32, 1.0, 16.0)),
        'gdn_dt_bias': dt + jnp.log(-jnp.expm1(-dt)),
        'gdn_norm_gain': 1.0 + nrm((N_ODD, GDN_DV), 0.02),
        'ffn_w_up': nrm((DEPTH, D_MODEL, 2 * D_FF), D_MODEL ** -0.5),
        'ffn_conv_w': nrm((DEPTH, FFN_CONV, 2 * D_FF), FFN_CONV ** -0.5),
        'ffn_conv_b': nrm((DEPTH, 2 * D_FF), 0.02),
        'ffn_w_down': nrm((DEPTH, D_FF, D_MODEL), D_FF ** -0.5),
    }


def reference(x, meta_tokens, norm_gains, w_in_even, w_out_even, hg_lb_logits, hg_norm_gain,
              w_in_odd, w_out_odd, rw_mu, rw_w0, rw_w2, rw_a0, rw_a2, rw_g2, rw_kk_scale, rw_ka_scale,
              rw_rk, rw_lnx_w, rw_lnx_b, gdn_conv_w, gdn_a_log, gdn_dt_bias, gdn_norm_gain,
              ffn_w_up, ffn_conv_w, ffn_conv_b, ffn_w_down):
    bsz = x.shape[0]
    meta = jnp.broadcast_to(meta_tokens[None].astype(x.dtype), (bsz, N_META, D_MODEL))
    h = jnp.concatenate([meta, x], axis=1)
    l = h.shape[1]
    pos = jnp.arange(l, dtype=jnp.int32)
    lb_all = jnp.cumsum(jax.nn.softmax(hg_lb_logits.astype(F32), axis=0), axis=0)
    for layer in range(DEPTH):
        g = norm_gains[layer]
        u = rmsnorm(h, g[0])
        i = layer // 2
        if layer % 2 == 0:
            m = even_mixer(u, w_in_even[i], w_out_even[i], lb_all[layer], hg_norm_gain[i], pos)
        else:
            m = odd_mixer(u, w_in_odd[i], w_out_odd[i], rw_mu[i], rw_w0[i], rw_w2[i], rw_a0[i], rw_a2[i],
                          rw_g2[i], rw_kk_scale[i], rw_ka_scale[i], rw_rk[i], rw_lnx_w[i], rw_lnx_b[i],
                          gdn_conv_w[i], gdn_a_log[i], gdn_dt_bias[i], gdn_norm_gain[i])
        h = h + rmsnorm(m, g[1])
        f = conv_ffn(rmsnorm(h, g[2]), ffn_w_up[layer], ffn_conv_w[layer], ffn_conv_b[layer], ffn_w_down[layer])
        h = h + rmsnorm(f, g[3])
    return h[:, N_META:]
```

```cpp
#include <hip/hip_runtime.h>
#include <hip/hip_cooperative_groups.h>
#include <cstdio>
namespace cg = cooperative_groups;

#define LAS __attribute__((address_space(3)))
typedef unsigned short bf16_t;
typedef short bf16x8 __attribute__((ext_vector_type(8)));
typedef float f32x4 __attribute__((ext_vector_type(4)));
typedef unsigned u32x4 __attribute__((ext_vector_type(4)));
typedef unsigned u32x2 __attribute__((ext_vector_type(2)));

constexpr int NB = 32, SEQ = 2048, NMETA = 16, L = 2064, D = 1024, M = NB * L;
constexpr int DFF = 2816, DFF2 = 5632;
constexpr int PW = 4096;
constexpr int ODD_IN = 3848;
constexpr int SLAB = 33024;
constexpr int MHEAD = 65536;
constexpr float EPS = 1e-6f;

constexpr size_t WS_H = 0;
constexpr size_t WS_A1 = WS_H + (size_t)M * D * 4;
constexpr size_t WS_BIG = WS_A1 + (size_t)M * D * 2;
constexpr size_t BIG_ZUP = 0, BIG_ACT = (size_t)SLAB * DFF2 * 2;
constexpr size_t BIG_BYTES = BIG_ACT + (size_t)SLAB * DFF * 2;
constexpr size_t WS_WB = WS_BIG + BIG_BYTES;
constexpr size_t WB_INE = 0, WB_OUTE = WB_INE + (size_t)4096 * 1024 * 2, WB_INO = WB_OUTE + (size_t)1024 * 1024 * 2, WB_OUTO = WB_INO + (size_t)4096 * 1024 * 2;
constexpr size_t WB_UP0 = WB_OUTO + (size_t)1024 * 1024 * 2, WB_UP1 = WB_UP0 + (size_t)DFF2 * 1024 * 2, WB_DN0 = WB_UP1 + (size_t)DFF2 * 1024 * 2, WB_DN1 = WB_DN0 + (size_t)1024 * DFF * 2;
constexpr size_t WS_BAR = WS_WB + WB_DN1 + (size_t)1024 * DFF * 2;
constexpr size_t WS_END = WS_BAR + 16384;
static_assert(BIG_BYTES >= (size_t)M * PW * 2, "BIG holds the projection");

constexpr int LDS_BYTES = 131072 + 4096;

struct Params { const float* in[28]; float* out; unsigned char* ws; int ph_lo, ph_hi; };

__device__ __forceinline__ float bf2f(bf16_t v) { return __uint_as_float(((unsigned)v) << 16); }
typedef __bf16 bf16x2_t __attribute__((ext_vector_type(2)));
typedef float f32x2_t __attribute__((ext_vector_type(2)));
__device__ __forceinline__ unsigned cvt_pk_bf16(float lo, float hi) { const f32x2_t f = {lo, hi}; const bf16x2_t v = __builtin_convertvector(f, bf16x2_t); return __builtin_bit_cast(unsigned, v); }
__device__ __forceinline__ bf16_t f2bf(float f) { return (bf16_t)(cvt_pk_bf16(f, 0.f) & 0xffffu); }
__device__ __forceinline__ float sigmoidf_(float x) { return __builtin_amdgcn_rcpf(1.0f + __expf(-x)); }
__device__ __forceinline__ float siluf_(float x) { return x * sigmoidf_(x); }
__device__ __forceinline__ float softplusf_(float x) { return fmaxf(x, 0.f) + __logf(1.0f + __expf(-fabsf(x))); }
__device__ __forceinline__ int otid() { int t = threadIdx.x; asm volatile("" : "+v"(t)); return t; }
__device__ __forceinline__ int obid() { int b = blockIdx.x; asm volatile("" : "+s"(b)); return b; }
template <int CTRL> __device__ __forceinline__ float dppf(float x) { return __int_as_float(__builtin_amdgcn_update_dpp(0, __float_as_int(x), CTRL, 0xF, 0xF, true)); }
__device__ __forceinline__ float allreduce8(float x) { x += dppf<0xB1>(x); x += dppf<0x4E>(x); x += dppf<0x141>(x); return x; }
__device__ __forceinline__ float allreduce16(float x) { x = allreduce8(x); x += dppf<0x140>(x); return x; }
__device__ __forceinline__ float wave_sum(float x) {
    x = allreduce16(x);
    const int xi = __float_as_int(x);
    const float r0 = __int_as_float(__builtin_amdgcn_readlane(xi, 0)), r1 = __int_as_float(__builtin_amdgcn_readlane(xi, 16));
    const float r2 = __int_as_float(__builtin_amdgcn_readlane(xi, 32)), r3 = __int_as_float(__builtin_amdgcn_readlane(xi, 48));
    return (r0 + r1) + (r2 + r3);
}

namespace pg8 {
constexpr int BM = 256, BK = 64, HALF = 128, HTB = HALF * BK * 2, STAGE_BYTES = 8 * HTB, NXCD = 8, WGM = 8;
__host__ __device__ __forceinline__ int lds_byte(int r, int c) { const int st = (r >> 4) * 2 + (c >> 5), rr = r & 15, cc = c & 31, ob = rr * 64 + cc * 2; return st * 1024 + (ob ^ (((ob >> 9) & 1) << 5)); }
__host__ __device__ __forceinline__ void stage_rc(int b, int& R, int& C) { const int st = b / 1024, sb = b % 1024, swz = sb ^ (((sb >> 9) & 1) << 5); R = (st >> 1) * 16 + swz / 64; C = (st & 1) * 32 + (swz % 64) / 2; }
__host__ __device__ __forceinline__ int perm32(int rho) { const int n = rho >> 4, i = rho & 15; return 8 * (i >> 2) + 4 * n + (i & 3); }
struct Unit { int pm, pn; };
struct Gemm { const bf16_t* A; const bf16_t* Bt; int M, N, K; };
struct StaticOrder {
    int nM, nN, nwg, G, c;
    __device__ void init(int M_, int N_, int G_, int c_) { nM = M_ / BM; nN = N_ / BM; nwg = nM * nN; G = G_; c = c_; }
    __device__ bool next(int i, Unit& u) const {
        const long Lx = (long)i * G + c; if (Lx >= nwg) return false;
        int wgid = (int)Lx; { const int q = nwg / NXCD, r = nwg % NXCD, xcd = wgid % NXCD, off = wgid / NXCD; wgid = (xcd < r ? xcd * (q + 1) : r * (q + 1) + (xcd - r) * q) + off; }
        const int nig = WGM * nN, gid = wgid / nig, fm = gid * WGM, gsz = (nM - fm) < WGM ? (nM - fm) : WGM;
        u.pm = fm + ((wgid % nig) % gsz); u.pn = (wgid % nig) / gsz; return true;
    }
};
struct EpiBf16 {
    bf16_t* O; int ldc; int mode; const float* cw; const float* cb; bf16_t* halo; LAS float* wlds;
    __device__ __forceinline__ void operator()(const f32x4 (&acc)[2][2][4][2], const Unit& u, int wr, int wc, int fr, int fq) const {
        if (mode == 0) {
            const int row0 = u.pm * BM + wr * 64 + fr; const int col0 = u.pn * BM + wc * 32 + 8 * fq;
#pragma unroll
            for (int ai = 0; ai < 2; ++ai)
#pragma unroll
                for (int m = 0; m < 4; ++m) { bf16_t* rowp = O + (size_t)(row0 + ai * HALF + m * 16) * ldc + col0;
#pragma unroll
                    for (int bj = 0; bj < 2; ++bj) { const f32x4 v0 = acc[ai][bj][m][0], v1 = acc[ai][bj][m][1];
                        u32x4 w; w.x = cvt_pk_bf16(v0[0], v0[1]); w.y = cvt_pk_bf16(v0[2], v0[3]); w.z = cvt_pk_bf16(v1[0], v1[1]); w.w = cvt_pk_bf16(v1[2], v1[3]);
                        *(u32x4*)(rowp + bj * HALF) = w; } }
            return;
        }
        const int ch0 = u.pn * 128 + wc * 32 + 8 * fq;
        const bool l15 = (fr == 15), l14 = (fr >= 14);
        LAS float* wsc = wlds + ((wr * 4 + wc) * 4 + fq) * 32;
        {
            f32x4 t[8];
#pragma unroll
            for (int j = 0; j < 3; ++j) { t[j] = *(const f32x4*)(cw + j * DFF2 + ch0 + 4); t[3 + j] = *(const f32x4*)(cw + j * DFF2 + DFF + ch0 + 4); }
            t[6] = *(const f32x4*)(cb + ch0 + 4); t[7] = *(const f32x4*)(cb + DFF + ch0 + 4);
#pragma unroll
            for (int j = 0; j < 8; ++j) *(LAS f32x4*)(wsc + 4 * j) = t[j];
        }
#pragma unroll
        for (int n = 0; n < 2; ++n) {
            float wg[3][4], wv[3][4], bg[4], bv[4];
            if (n == 0) {
#pragma unroll
                for (int j = 0; j < 3; ++j) {
                    const float4 a = *(const float4*)(cw + j * DFF2 + ch0), c = *(const float4*)(cw + j * DFF2 + DFF + ch0);
                    wg[j][0] = a.x; wg[j][1] = a.y; wg[j][2] = a.z; wg[j][3] = a.w; wv[j][0] = c.x; wv[j][1] = c.y; wv[j][2] = c.z; wv[j][3] = c.w;
                }
                const float4 a = *(const float4*)(cb + ch0), c = *(const float4*)(cb + DFF + ch0);
                bg[0] = a.x; bg[1] = a.y; bg[2] = a.z; bg[3] = a.w; bv[0] = c.x; bv[1] = c.y; bv[2] = c.z; bv[3] = c.w;
            } else {
#pragma unroll
                for (int j = 0; j < 3; ++j) {
                    const f32x4 a = *(const LAS f32x4*)(wsc + 4 * j), c = *(const LAS f32x4*)(wsc + 4 * (3 + j));
                    wg[j][0] = a[0]; wg[j][1] = a[1]; wg[j][2] = a[2]; wg[j][3] = a[3]; wv[j][0] = c[0]; wv[j][1] = c[1]; wv[j][2] = c[2]; wv[j][3] = c[3];
                }
                const f32x4 a = *(const LAS f32x4*)(wsc + 24), c = *(const LAS f32x4*)(wsc + 28);
                bg[0] = a[0]; bg[1] = a[1]; bg[2] = a[2]; bg[3] = a[3]; bv[0] = c[0]; bv[1] = c[1]; bv[2] = c[2]; bv[3] = c[3];
            }
#pragma unroll
            for (int ai = 0; ai < 2; ++ai)
#pragma unroll
                for (int m = 0; m < 4; ++m) {
                    const int r = u.pm * BM + ai * HALF + wr * 64 + m * 16 + fr; const int tb = r % L;
                    const bool k1 = (tb >= 1), k2 = (tb >= 2);
                    float o[4];
#pragma unroll
                    for (int e = 0; e < 4; ++e) {
                        const float g0 = acc[ai][0][m][n][e], v0 = acc[ai][1][m][n][e];
                        const float gm = (m > 0) ? acc[ai][0][m > 0 ? m - 1 : 0][n][e] : 0.f, vm = (m > 0) ? acc[ai][1][m > 0 ? m - 1 : 0][n][e] : 0.f;
                        float g1 = dppf<0x121>(l15 ? gm : g0), g2 = dppf<0x122>(l14 ? gm : g0), v1 = dppf<0x121>(l15 ? vm : v0), v2 = dppf<0x122>(l14 ? vm : v0);
                        g1 = k1 ? g1 : 0.f; v1 = k1 ? v1 : 0.f; g2 = k2 ? g2 : 0.f; v2 = k2 ? v2 : 0.f;
                        const float zg = fmaf(wg[0][e], g2, fmaf(wg[1][e], g1, fmaf(wg[2][e], g0, bg[e])));
                        const float zv = fmaf(wv[0][e], v2, fmaf(wv[1][e], v1, fmaf(wv[2][e], v0, bv[e])));
                        o[e] = siluf_(zg) * zv;
                    }
                    if (!(m == 0 && fr < 2)) {
                        u32x2 w; w.x = cvt_pk_bf16(o[0], o[1]); w.y = cvt_pk_bf16(o[2], o[3]);
                        *(u32x2*)(O + (size_t)r * ldc + ch0 + 4 * n) = w;
                    }
                }
        }
#pragma unroll
        for (int ai = 0; ai < 2; ++ai)
#pragma unroll
            for (int m = 0; m < 4; m += 3) {
                if ((m == 3 && fr >= 14) || (m == 0 && fr < 2)) {
                    const int r = u.pm * BM + ai * HALF + wr * 64 + m * 16 + fr;
                    const int slot = (m == 3) ? (fr - 14) : (2 + fr);
                    bf16_t* hp = halo + ((size_t)(r >> 6) * 4 + slot) * DFF2 + u.pn * 256 + wc * 32 + 8 * fq;
#pragma unroll
                    for (int bj = 0; bj < 2; ++bj) { const f32x4 a0 = acc[ai][bj][m][0], a1 = acc[ai][bj][m][1];
                        u32x4 w; w.x = cvt_pk_bf16(a0[0], a0[1]); w.y = cvt_pk_bf16(a0[2], a0[3]); w.z = cvt_pk_bf16(a1[0], a1[1]); w.w = cvt_pk_bf16(a1[2], a1[3]);
                        *(u32x4*)(hp + bj * 128) = w; }
                }
            }
    }
};

__device__ __forceinline__ void gemm_phase(LAS unsigned char* lds, const Gemm g, const StaticOrder& S, const EpiBf16& E) {
    const int tid = otid(), wid = __builtin_amdgcn_readfirstlane(tid >> 6), lane = tid & 63, wr = wid >> 2, wc = wid & 3, fr = lane & 15, fq = lane >> 4;
    const int K = g.K, nt = K / BK;
    unsigned voffA[2], voffB[2];
#pragma unroll
    for (int i = 0; i < 2; ++i) { int R, C; stage_rc(tid * 16 + i * 8192, R, C); const int Rb = (R & ~31) + perm32(R & 31);
        voffA[i] = (unsigned)(R * K + C) * 2u; voffB[i] = (unsigned)(Rb * K + C) * 2u; }
    const size_t kstep = (size_t)(BK * 2);
    const size_t hstep = (size_t)HALF * K * 2;
    const size_t tstep = 2 * hstep;
    const unsigned ldsw = (unsigned)wid * 1024u;
    const int aoff = lds_byte(wr * 64 + fr, fq * 8), boff = lds_byte(wc * 32 + fr, fq * 8);
#define PG8_SA(b, h) (((b) * 2 + (h)) * HTB)
#define PG8_SB(b, h) ((4 + (b) * 2 + (h)) * HTB)
#define PG8_STAGE(bufoff, gbase, voff) do { _Pragma("unroll") for (int _i = 0; _i < 2; ++_i) \
        __builtin_amdgcn_global_load_lds((const unsigned*)((const char*)(gbase) + (voff)[_i]), (LAS unsigned*)(lds + (bufoff) + ldsw + _i * 8192), 16, 0, 0); } while (0)
#define PG8_LDA(dst, b, h) do { _Pragma("unroll") for (int m = 0; m < 4; ++m) _Pragma("unroll") for (int k = 0; k < 2; ++k) dst[m][k] = *(const LAS bf16x8*)(lds + PG8_SA(b, h) + aoff + m * 2048 + k * 1024); } while (0)
#define PG8_LDB(dst, b, h) do { _Pragma("unroll") for (int n = 0; n < 2; ++n) _Pragma("unroll") for (int k = 0; k < 2; ++k) dst[n][k] = *(const LAS bf16x8*)(lds + PG8_SB(b, h) + boff + n * 2048 + k * 1024); } while (0)
#define PG8_MMA(ai, bj, At, Bt) do { __builtin_amdgcn_s_setprio(1); _Pragma("unroll") for (int m = 0; m < 4; ++m) _Pragma("unroll") for (int n = 0; n < 2; ++n) _Pragma("unroll") for (int k = 0; k < 2; ++k) \
        acc[ai][bj][m][n] = __builtin_amdgcn_mfma_f32_16x16x32_bf16(Bt[n][k], At[m][k], acc[ai][bj][m][n], 0, 0, 0); __builtin_amdgcn_s_setprio(0); } while (0)
#define PG8_WAIT_V(n) asm volatile("s_waitcnt vmcnt(" #n ")" ::: "memory")
#define PG8_WAIT_L(n) asm volatile("s_waitcnt lgkmcnt(" #n ")" ::: "memory")
#define PG8_BAR __builtin_amdgcn_s_barrier()
#define PG8_SCHED __builtin_amdgcn_sched_barrier(0)
    Unit cur, nxt; int ui = 0;
    if (!S.next(0, cur)) return;
    f32x4 acc[2][2][4][2];
#pragma unroll
    for (int a = 0; a < 2; ++a)
#pragma unroll
        for (int b = 0; b < 2; ++b)
#pragma unroll
            for (int m = 0; m < 4; ++m)
#pragma unroll
                for (int n = 0; n < 2; ++n) acc[a][b][m][n] = (f32x4){0.f, 0.f, 0.f, 0.f};
    bf16x8 At[4][2], B0[2][2], B1[2][2];
    const char* cA = (const char*)g.A + (size_t)cur.pm * tstep; const char* cB = (const char*)g.Bt + (size_t)cur.pn * tstep;
    PG8_STAGE(PG8_SB(0, 0), cB, voffB); PG8_STAGE(PG8_SA(0, 0), cA, voffA); PG8_STAGE(PG8_SB(0, 1), cB + hstep, voffB); PG8_STAGE(PG8_SA(0, 1), cA + hstep, voffA);
    if (wr == 1) PG8_BAR;
    PG8_WAIT_V(4); PG8_BAR;
    PG8_STAGE(PG8_SB(1, 0), cB + kstep, voffB); PG8_STAGE(PG8_SA(1, 0), cA + kstep, voffA); PG8_STAGE(PG8_SB(1, 1), cB + hstep + kstep, voffB);
    PG8_WAIT_V(6); PG8_BAR;
    for (;;) {
        const bool has_next = S.next(ui + 1, nxt);
        const char* nA = has_next ? (const char*)g.A + (size_t)nxt.pm * tstep : cA; const char* nB = has_next ? (const char*)g.Bt + (size_t)nxt.pn * tstep : cB;
        for (int t = 0; t < nt; t += 2) {
            const bool last = (t == nt - 2);
            const char* a1 = cA + (size_t)(t + 1) * kstep;
            const char* a2 = last ? nA : cA + (size_t)(t + 2) * kstep; const char* b2 = last ? nB : cB + (size_t)(t + 2) * kstep;
            const char* a3 = a2 + kstep; const char* b3 = b2 + kstep;
            PG8_LDB(B0, 0, 0); PG8_SCHED; PG8_LDA(At, 0, 0); PG8_STAGE(PG8_SA(1, 1), a1 + hstep, voffA);
            PG8_WAIT_L(8); PG8_BAR; PG8_WAIT_L(0); PG8_MMA(0, 0, At, B0); PG8_BAR; PG8_SCHED;
            PG8_LDB(B1, 0, 1); PG8_STAGE(PG8_SB(0, 0), b2, voffB);
            PG8_BAR; PG8_WAIT_L(0); PG8_MMA(0, 1, At, B1); PG8_BAR;
            PG8_LDA(At, 0, 1); PG8_STAGE(PG8_SA(0, 0), a2, voffA);
            PG8_BAR; PG8_WAIT_L(0); PG8_MMA(1, 0, At, B0); PG8_BAR; PG8_SCHED;
            PG8_STAGE(PG8_SB(0, 1), b2 + hstep, voffB);
            PG8_WAIT_V(6); PG8_BAR; PG8_MMA(1, 1, At, B1); PG8_BAR;
            PG8_LDB(B0, 1, 0); PG8_SCHED; PG8_LDA(At, 1, 0); PG8_STAGE(PG8_SA(0, 1), a2 + hstep, voffA);
            PG8_WAIT_L(8); PG8_BAR; PG8_WAIT_L(0); PG8_MMA(0, 0, At, B0); PG8_BAR; PG8_SCHED;
            PG8_LDB(B1, 1, 1); PG8_STAGE(PG8_SB(1, 0), b3, voffB);
            PG8_BAR; PG8_WAIT_L(0); PG8_MMA(0, 1, At, B1); PG8_BAR;
            PG8_LDA(At, 1, 1); PG8_STAGE(PG8_SA(1, 0), a3, voffA);
            PG8_BAR; PG8_WAIT_L(0); PG8_MMA(1, 0, At, B0); PG8_BAR; PG8_SCHED;
            PG8_STAGE(PG8_SB(1, 1), b3 + hstep, voffB);
            PG8_WAIT_V(6); PG8_BAR; PG8_MMA(1, 1, At, B1); PG8_BAR;
        }
        E(acc, cur, wr, wc, fr, fq);
        if (!has_next) break;
#pragma unroll
        for (int a = 0; a < 2; ++a)
#pragma unroll
            for (int b = 0; b < 2; ++b)
#pragma unroll
                for (int m = 0; m < 4; ++m)
#pragma unroll
                    for (int n = 0; n < 2; ++n) acc[a][b][m][n] = (f32x4){0.f, 0.f, 0.f, 0.f};
        cur = nxt; cA = nA; cB = nB; ++ui;
    }
    PG8_WAIT_V(0);
    if (wr == 0) PG8_BAR;
    PG8_BAR;
#undef PG8_SA
#undef PG8_SB
#undef PG8_STAGE
#undef PG8_LDA
#undef PG8_LDB
#undef PG8_MMA
#undef PG8_WAIT_V
#undef PG8_WAIT_L
#undef PG8_BAR
#undef PG8_SCHED
}
}

__device__ __noinline__ void transpose_job(float* tile  , const float* __restrict__ src, bf16_t* __restrict__ dst, int K, int N, int Npad, int glu) {
    const int tid = otid();
    const int tk = K / 64, tn = Npad / 64, ntiles = tk * tn;
    const int kkA = tid >> 4, n4 = (tid & 15) * 4;
    float4 v[2];
    auto fetch = [&](int tl) {
        const int k0 = (tl % tk) * 64, n0 = (tl / tk) * 64;
#pragma unroll
        for (int it = 0; it < 2; ++it) { v[it] = make_float4(0.f, 0.f, 0.f, 0.f); if (n0 + n4 < N) v[it] = *(const float4*)(src + (size_t)(k0 + kkA + it * 32) * N + n0 + n4); }
    };
    int tl = obid();
    if (tl < ntiles) fetch(tl);
    while (tl < ntiles) {
        const int k0 = (tl % tk) * 64, n0 = (tl / tk) * 64;
        __syncthreads();
#pragma unroll
        for (int it = 0; it < 2; ++it) { float* tp = tile + (kkA + it * 32) * 65 + n4; tp[0] = v[it].x; tp[1] = v[it].y; tp[2] = v[it].z; tp[3] = v[it].w; }
        const int nxt = tl + (int)gridDim.x;
        if (nxt < ntiles) fetch(nxt);
        __syncthreads();
        const int nn = tid >> 3, k8 = (tid & 7) * 8;
        float e[8];
#pragma unroll
        for (int j = 0; j < 8; ++j) e[j] = tile[(k8 + j) * 65 + nn];
        u32x4 w; w.x = cvt_pk_bf16(e[0], e[1]); w.y = cvt_pk_bf16(e[2], e[3]); w.z = cvt_pk_bf16(e[4], e[5]); w.w = cvt_pk_bf16(e[6], e[7]);
        const int r0 = !glu ? n0 : (n0 < DFF ? (n0 >> 7) * 256 + (n0 & 127) : ((n0 - DFF) >> 7) * 256 + 128 + ((n0 - DFF) & 127));
        *(u32x4*)(dst + (size_t)(r0 + nn) * K + k0 + k8) = w;
        tl = nxt;
    }
}

__device__ void norm_phase(const Params& p, int mode, const bf16_t* msrc, const float* __restrict__ gA, const float* __restrict__ gB, bf16_t* udst, int row_lo, int row_hi, int blk_skip) {
    bf16_t* H = (bf16_t*)(p.ws + WS_H);
    const int tid_ = otid(); const int lane = tid_ & 63, w = tid_ >> 6;
    const int nw = ((int)gridDim.x - blk_skip) * 8; const int bid_ = obid() - blk_skip;
    if (bid_ < 0) return;
    float4 ga[4], gb[4];
#pragma unroll
    for (int i = 0; i < 4; ++i) { ga[i] = (mode != 0) ? *(const float4*)(gA + i * 256 + lane * 4) : make_float4(0.f, 0.f, 0.f, 0.f); gb[i] = (mode != 2) ? *(const float4*)(gB + i * 256 + lane * 4) : make_float4(0.f, 0.f, 0.f, 0.f); }
    float4 xr[4]; u32x2 hr[4], mr[4];
    auto fetch = [&](int row) {
        if (mode == 0) {
            const int b = row / L, t = row - b * L;
            const float* src = (t < NMETA) ? (p.in[1] + (size_t)t * D) : (p.in[0] + ((size_t)b * SEQ + (t - NMETA)) * D);
#pragma unroll
            for (int i = 0; i < 4; ++i) xr[i] = *(const float4*)(src + i * 256 + lane * 4);
        } else {
#pragma unroll
            for (int i = 0; i < 4; ++i) { hr[i] = *(const u32x2*)(H + (size_t)row * D + i * 256 + lane * 4); mr[i] = *(const u32x2*)(msrc + (size_t)row * D + i * 256 + lane * 4); }
        }
    };
    int row = row_lo + bid_ * 8 + w;
    if (row < row_hi) fetch(row);
    while (row < row_hi) {
        const int b = row / L, t = row - b * L;
        float4 hv[4];
        float mv[4][4]; float ssm = 0.f;
        if (mode == 0) {
#pragma unroll
            for (int i = 0; i < 4; ++i) hv[i] = xr[i];
        } else {
#pragma unroll
            for (int i = 0; i < 4; ++i) {
                hv[i] = make_float4(__uint_as_float(hr[i].x << 16), __uint_as_float(hr[i].x & 0xffff0000u), __uint_as_float(hr[i].y << 16), __uint_as_float(hr[i].y & 0xffff0000u));
                mv[i][0] = __uint_as_float(mr[i].x << 16); mv[i][1] = __uint_as_float(mr[i].x & 0xffff0000u); mv[i][2] = __uint_as_float(mr[i].y << 16); mv[i][3] = __uint_as_float(mr[i].y & 0xffff0000u);
                ssm += mv[i][0] * mv[i][0] + mv[i][1] * mv[i][1] + mv[i][2] * mv[i][2] + mv[i][3] * mv[i][3];
            }
        }
        const int nxt = row + nw;
        if (nxt < row_hi) fetch(nxt);
        if (mode != 0) {
            ssm = wave_sum(ssm);
            const float rs = rsqrtf(ssm * (1.0f / D) + EPS);
#pragma unroll
            for (int i = 0; i < 4; ++i) { hv[i].x += mv[i][0] * rs * ga[i].x; hv[i].y += mv[i][1] * rs * ga[i].y; hv[i].z += mv[i][2] * rs * ga[i].z; hv[i].w += mv[i][3] * rs * ga[i].w; }
        }
        if (mode == 2) {
            if (t >= NMETA) {
                float* o = p.out + ((size_t)b * SEQ + (t - NMETA)) * D;
#pragma unroll
                for (int i = 0; i < 4; ++i) *(float4*)(o + i * 256 + lane * 4) = hv[i];
            }
        } else {
            float ss = 0.f;
#pragma unroll
            for (int i = 0; i < 4; ++i) {
                { u32x2 hw; hw.x = cvt_pk_bf16(hv[i].x, hv[i].y); hw.y = cvt_pk_bf16(hv[i].z, hv[i].w); *(u32x2*)(H + (size_t)row * D + i * 256 + lane * 4) = hw; }
                ss += hv[i].x * hv[i].x + hv[i].y * hv[i].y + hv[i].z * hv[i].z + hv[i].w * hv[i].w;
            }
            ss = wave_sum(ss);
            const float rs = rsqrtf(ss * (1.0f / D) + EPS);
#pragma unroll
            for (int i = 0; i < 4; ++i) {
                u32x2 o; o.x = cvt_pk_bf16(hv[i].x * rs * gb[i].x, hv[i].y * rs * gb[i].y); o.y = cvt_pk_bf16(hv[i].z * rs * gb[i].z, hv[i].w * rs * gb[i].w);
                *(u32x2*)(udst + (size_t)row * D + i * 256 + lane * 4) = o;
            }
        }
        row = nxt;
    }
}

constexpr size_t BIG_HALO = (size_t)M * DFF * 2;
static_assert(BIG_HALO + (size_t)(M / 64) * 4 * DFF2 * 2 <= BIG_BYTES, "activation + halo fit");
__device__ void ffn_fixup_phase(const Params& p, int layer) {
    bf16_t* act = (bf16_t*)(p.ws + WS_BIG);
    const bf16_t* halo = (const bf16_t*)(p.ws + WS_BIG + BIG_HALO);
    const float* cw = p.in[25] + (size_t)layer * 3 * DFF2;
    const float* cb = p.in[26] + (size_t)layer * DFF2;
    constexpr int NCG = DFF / 8, NBLK = M / 64;
    const int nitems = NCG * NBLK;
    for (int item = obid() * 512 + otid(); item < nitems; item += gridDim.x * 512) {
        const int cgp = item % NCG, blk = item / NCG;
        const int c0 = cgp * 8;
        const int gcol = (c0 >> 7) * 256 + (c0 & 127);
        float wg[3][8], wv[3][8], bg[8], bv[8];
#pragma unroll
        for (int j = 0; j < 3; ++j)
#pragma unroll
            for (int e = 0; e < 8; ++e) { wg[j][e] = cw[j * DFF2 + c0 + e]; wv[j][e] = cw[j * DFF2 + DFF + c0 + e]; }
#pragma unroll
        for (int e = 0; e < 8; ++e) { bg[e] = cb[c0 + e]; bv[e] = cb[DFF + c0 + e]; }
        auto ldrow = [&](int bk, int slot, float (&g)[8], float (&v)[8]) {
            const bf16_t* hp = halo + ((size_t)bk * 4 + slot) * DFF2 + gcol;
            const u32x4 a = *(const u32x4*)hp, c = *(const u32x4*)(hp + 128);
#pragma unroll
            for (int e = 0; e < 4; ++e) { g[2 * e] = __uint_as_float(a[e] << 16); g[2 * e + 1] = __uint_as_float(a[e] & 0xffff0000u); v[2 * e] = __uint_as_float(c[e] << 16); v[2 * e + 1] = __uint_as_float(c[e] & 0xffff0000u); }
        };
        float gz[4][8], vz[4][8];
#pragma unroll
        for (int e = 0; e < 8; ++e) { gz[0][e] = 0.f; gz[1][e] = 0.f; vz[0][e] = 0.f; vz[1][e] = 0.f; }
        if (blk > 0) { ldrow(blk - 1, 0, gz[0], vz[0]); ldrow(blk - 1, 1, gz[1], vz[1]); }
        ldrow(blk, 2, gz[2], vz[2]); ldrow(blk, 3, gz[3], vz[3]);
#pragma unroll
        for (int q = 0; q < 2; ++q) {
            const int r = blk * 64 + q; const int tb = r % L;
            const float k1 = (tb >= 1) ? 1.f : 0.f, k2 = (tb >= 2) ? 1.f : 0.f;
            float o[8];
#pragma unroll
            for (int e = 0; e < 8; ++e) {
                const float zg = wg[0][e] * (k2 * gz[q][e]) + wg[1][e] * (k1 * gz[q + 1][e]) + wg[2][e] * gz[q + 2][e] + bg[e];
                const float zv = wv[0][e] * (k2 * vz[q][e]) + wv[1][e] * (k1 * vz[q + 1][e]) + wv[2][e] * vz[q + 2][e] + bv[e];
                o[e] = siluf_(zg) * zv;
            }
            u32x4 w; w.x = cvt_pk_bf16(o[0], o[1]); w.y = cvt_pk_bf16(o[2], o[3]); w.z = cvt_pk_bf16(o[4], o[5]); w.w = cvt_pk_bf16(o[6], o[7]);
            *(u32x4*)(act + (size_t)r * DFF + c0) = w;
        }
    }
}

constexpr int TCH = 32;
template <int PPR, int NROW, int NLD, int NT = 512, class ColFn>
__device__ __forceinline__ void raw_fetch(u32x4 (&reg)[NLD], const bf16_t* P, int tid, size_t brow, int tfirst, ColFn col) {
#pragma unroll
    for (int i = 0; i < NLD; ++i) {
        int idx = tid + i * NT;
        asm volatile("" : "+v"(idx));
        u32x4 v = {0u, 0u, 0u, 0u};
        if (idx < NROW * PPR) { const int r = idx / PPR, pc = idx - r * PPR; const int t = tfirst + r;
            if (t >= 0 && t < L) v = *(const u32x4*)(P + (brow + t) * PW + col(pc)); }
        reg[i] = v;
    }
}
template <int PPR, int NROW, int NLD, int NT = 512>
__device__ __forceinline__ void raw_store(const u32x4 (&reg)[NLD], bf16_t* raw, int tid) {
#pragma unroll
    for (int i = 0; i < NLD; ++i) { const int idx = tid + i * NT; if (idx < NROW * PPR) *(u32x4*)(raw + (size_t)idx * 8) = reg[i]; }
}

template <bool HG>
__device__ __forceinline__ void even_item(const Params& p, float* lds, int b, int h) {
    const bf16_t* P = (const bf16_t*)(p.ws + WS_BIG);
    bf16_t* Y = (bf16_t*)(p.ws + WS_A1);
    constexpr int QP = 136;
    float* O = lds; float* Gt = O + TCH * 128; float* PC = Gt + TCH * 128;
    bf16_t* Qt = (bf16_t*)(PC + 256); bf16_t* Kt = Qt + TCH * QP;
    bf16_t* KhT = Kt + TCH * QP; bf16_t* VT = KhT + 2 * 128 * 16;
    bf16_t* raw = VT + 2 * 128 * 16;
    constexpr int PPR = 64, NROW = 32, NLD = 4, RP = 512;
    const int tid = otid(), lane = tid & 63, w = tid >> 6;
    const int fn = lane & 15, g = lane >> 4, vs = w * 16;
    const int cbase = (HG ? 2048 : 0) + h * 128;
    auto col = [&](int pc) { return cbase + (pc >> 4) * 512 + (pc & 15) * 8; };
    const size_t brow = (size_t)b * L;
    const float gamma = 1.0f - exp2f(-5.0f - (float)h);
    const int d_ = tid & 127, c2_ = (tid >> 7) & 1, hf_ = tid >> 8;
    float lbv = 0.f; float2 hgn = make_float2(0.f, 0.f);
    if (HG) {
        const float* lg = p.in[5]; const int c = h * 128 + d_;
        const float l0 = lg[c], l1 = lg[512 + c], l2 = lg[1024 + c]; const float mx = fmaxf(l0, fmaxf(l1, l2));
        const float e0 = __expf(l0 - mx), e1 = __expf(l1 - mx), e2 = __expf(l2 - mx); lbv = e0 / (e0 + e1 + e2);
        hgn = *(const float2*)(p.in[6] + h * 128 + 2 * lane);
    }
    const float rinv = exp2f(-(float)(d_ & 63) * 0.20762050593046f) * 0.15915494309189535f;
    f32x4 S[8];
#pragma unroll
    for (int T = 0; T < 8; ++T) S[T] = (f32x4){0.f, 0.f, 0.f, 0.f};
    u32x4 rg[NLD];
    __syncthreads();
    raw_fetch<PPR, NROW, NLD>(rg, P, tid, brow, 0, col); raw_store<PPR, NROW, NLD>(rg, raw, tid);
    for (int t0 = 0; t0 < L; t0 += TCH) {
        const int ns = (L - t0) < TCH ? (L - t0) : TCH;
        const bool more = (t0 + TCH < L);
        __syncthreads();
        if (more) raw_fetch<PPR, NROW, NLD>(rg, P, tid, brow, t0 + TCH, col);
        if (hf_ == 0) {
            float Pc = 1.0f; float kt[16];
#pragma unroll
            for (int i = 0; i < 16; ++i) {
                const int t = c2_ * 16 + i; const bf16_t* rr = raw + t * RP;
                float q, k, f;
                if (!HG) {
                    const int dd = d_ & 63;
                    float r = (float)(t0 + t) * rinv; r -= floorf(r);
                    const float sn = __builtin_amdgcn_sinf(r), cs = __builtin_amdgcn_cosf(r);
                    const float q1 = bf2f(rr[dd]), q2 = bf2f(rr[64 + dd]), k1 = bf2f(rr[128 + dd]), k2 = bf2f(rr[192 + dd]);
                    q = (d_ < 64) ? (q1 * cs - q2 * sn) : (q1 * sn + q2 * cs);
                    k = ((d_ < 64) ? (k1 * cs - k2 * sn) : (k1 * sn + k2 * cs)) * 0.08838834764831845f;
                    f = gamma;
                } else {
                    q = bf2f(rr[d_]); const float sg = sigmoidf_(bf2f(rr[128 + d_]));
                    f = lbv + (1.0f - lbv) * sg; k = (1.0f - lbv) * (1.0f - sg);
                }
                Pc *= f;
                Qt[t * QP + d_] = f2bf(q * Pc);
                kt[i] = k * __builtin_amdgcn_rcpf(Pc);
                Kt[t * QP + d_] = f2bf(kt[i]);
            }
            PC[c2_ * 128 + d_] = Pc;
            u32x4 u0, u1;
            u0.x = cvt_pk_bf16(kt[0] * Pc, kt[1] * Pc); u0.y = cvt_pk_bf16(kt[2] * Pc, kt[3] * Pc); u0.z = cvt_pk_bf16(kt[4] * Pc, kt[5] * Pc); u0.w = cvt_pk_bf16(kt[6] * Pc, kt[7] * Pc);
            u1.x = cvt_pk_bf16(kt[8] * Pc, kt[9] * Pc); u1.y = cvt_pk_bf16(kt[10] * Pc, kt[11] * Pc); u1.z = cvt_pk_bf16(kt[12] * Pc, kt[13] * Pc); u1.w = cvt_pk_bf16(kt[14] * Pc, kt[15] * Pc);
            *(u32x4*)(KhT + (c2_ * 128 + d_) * 16) = u0; *(u32x4*)(KhT + (c2_ * 128 + d_) * 16 + 8) = u1;
        } else {
            float vv[16];
#pragma unroll
            for (int i = 0; i < 16; ++i) {
                const int t = c2_ * 16 + i; const bf16_t* rr = raw + t * RP;
                vv[i] = bf2f(rr[256 + d_]);
                Gt[t * 128 + d_] = siluf_(bf2f(rr[384 + d_]));
            }
            u32x4 u0, u1;
            u0.x = cvt_pk_bf16(vv[0], vv[1]); u0.y = cvt_pk_bf16(vv[2], vv[3]); u0.z = cvt_pk_bf16(vv[4], vv[5]); u0.w = cvt_pk_bf16(vv[6], vv[7]);
            u1.x = cvt_pk_bf16(vv[8], vv[9]); u1.y = cvt_pk_bf16(vv[10], vv[11]); u1.z = cvt_pk_bf16(vv[12], vv[13]); u1.w = cvt_pk_bf16(vv[14], vv[15]);
            *(u32x4*)(VT + (c2_ * 128 + d_) * 16) = u0; *(u32x4*)(VT + (c2_ * 128 + d_) * 16 + 8) = u1;
        }
        __syncthreads();
        for (int c2 = 0; c2 < 2; ++c2) {
            if (c2 * 16 >= ns) break;
            const bf16_t* qrow = Qt + (c2 * 16 + fn) * QP; const bf16_t* krow = Kt + (c2 * 16 + fn) * QP;
            f32x4 at4 = {0.f, 0.f, 0.f, 0.f};
#pragma unroll
            for (int ks = 0; ks < 4; ++ks) at4 = __builtin_amdgcn_mfma_f32_16x16x32_bf16(*(const bf16x8*)(krow + ks * 32 + g * 8), *(const bf16x8*)(qrow + ks * 32 + g * 8), at4, 0, 0, 0);
            u32x4 ua; ua.x = cvt_pk_bf16((4 * g + 0 <= fn) ? at4[0] : 0.f, (4 * g + 1 <= fn) ? at4[1] : 0.f); ua.y = cvt_pk_bf16((4 * g + 2 <= fn) ? at4[2] : 0.f, (4 * g + 3 <= fn) ? at4[3] : 0.f); ua.z = 0u; ua.w = 0u;
            const u32x2 vlo = *(const u32x2*)(VT + (c2 * 128 + vs + fn) * 16 + 4 * g);
            u32x4 uv; uv.x = vlo.x; uv.y = vlo.y; uv.z = 0u; uv.w = 0u;
            const bf16x8 vb = __builtin_bit_cast(bf16x8, uv);
            f32x4 oacc = __builtin_amdgcn_mfma_f32_16x16x32_bf16(__builtin_bit_cast(bf16x8, ua), vb, (f32x4){0.f, 0.f, 0.f, 0.f}, 0, 0, 0);
#pragma unroll
            for (int ks = 0; ks < 4; ++ks) {
                const u32x2 qa = *(const u32x2*)(qrow + (2 * ks) * 16 + 4 * g), qb = *(const u32x2*)(qrow + (2 * ks + 1) * 16 + 4 * g);
                u32x4 uq; uq.x = qa.x; uq.y = qa.y; uq.z = qb.x; uq.w = qb.y;
                u32x4 us; us.x = cvt_pk_bf16(S[2 * ks][0], S[2 * ks][1]); us.y = cvt_pk_bf16(S[2 * ks][2], S[2 * ks][3]); us.z = cvt_pk_bf16(S[2 * ks + 1][0], S[2 * ks + 1][1]); us.w = cvt_pk_bf16(S[2 * ks + 1][2], S[2 * ks + 1][3]);
                oacc = __builtin_amdgcn_mfma_f32_16x16x32_bf16(__builtin_bit_cast(bf16x8, uq), __builtin_bit_cast(bf16x8, us), oacc, 0, 0, 0);
            }
#pragma unroll
            for (int jj = 0; jj < 4; ++jj) O[(c2 * 16 + 4 * g + jj) * 128 + vs + fn] = oacc[jj];
#pragma unroll
            for (int T = 0; T < 8; ++T) {
                const float4 pc4 = *(const float4*)(PC + c2 * 128 + T * 16 + 4 * g);
                const u32x2 kh = *(const u32x2*)(KhT + (c2 * 128 + T * 16 + fn) * 16 + 4 * g);
                u32x4 uk; uk.x = kh.x; uk.y = kh.y; uk.z = 0u; uk.w = 0u;
                f32x4 sc = S[T]; sc[0] *= pc4.x; sc[1] *= pc4.y; sc[2] *= pc4.z; sc[3] *= pc4.w;
                S[T] = __builtin_amdgcn_mfma_f32_16x16x32_bf16(__builtin_bit_cast(bf16x8, uk), vb, sc, 0, 0, 0);
            }
        }
        if (more) raw_store<PPR, NROW, NLD>(rg, raw, tid);
        __syncthreads();
        for (int t = w; t < ns; t += 8) {
            const size_t row = brow + t0 + t;
            const float2 o2 = *(const float2*)(O + t * 128 + lane * 2);
            const float2 g2 = *(const float2*)(Gt + t * 128 + lane * 2);
            const int v = lane * 2;
            if (!HG) {
                const float mean = wave_sum(o2.x + o2.y) * (1.0f / 128.0f);
                const float x0 = o2.x - mean, x1 = o2.y - mean;
                const float var = wave_sum(x0 * x0 + x1 * x1) * (1.0f / 128.0f);
                const float rs = rsqrtf(var + EPS);
                *(unsigned*)(Y + row * D + h * 128 + v) = cvt_pk_bf16(x0 * rs * g2.x, x1 * rs * g2.y);
            } else {
                const float ms = wave_sum(o2.x * o2.x + o2.y * o2.y) * (1.0f / 128.0f);
                const float rs = rsqrtf(ms + EPS);
                *(unsigned*)(Y + row * D + 512 + h * 128 + v) = cvt_pk_bf16(o2.x * rs * hgn.x * g2.x, o2.y * rs * hgn.y * g2.y);
            }
        }
    }
}
__device__ __forceinline__ void even_scan_phase(const Params& p, float* lds) {
    for (int item = obid(); item < 256; item += gridDim.x) {
        const int idx = item & 127, b = idx >> 2, h = idx & 3;
        if (item < 128) even_item<false>(p, lds, b, h); else even_item<true>(p, lds, b, h);
        __syncthreads();
    }
}

typedef float f32x2 __attribute__((ext_vector_type(2)));
constexpr int TCR = 16;
constexpr int RW_ITEM_FLOATS = 16256;
__device__ __forceinline__ void rwkv_half(const Params& p, float* lds, int b, int h, int half) {
    const bf16_t* P = (const bf16_t*)(p.ws + WS_BIG);
    bf16_t* Y = (bf16_t*)(p.ws + WS_A1);
    float* R = lds; float* W = R + TCR * 64; float* Kk = W + TCR * 64; float* Vv = Kk + TCR * 64; float* A = Vv + TCR * 64; float* Bb = A + TCR * 64;
    float* O = Bb + TCR * 64; float* G = O + TCR * 64; float* RK = G + TCR * 64; float* WP = RK + 64; float* AP = WP + TCR * 64;
    constexpr int LAP = 264;
    bf16_t* LAb = (bf16_t*)(AP + TCR * 64);
    bf16_t* LAbS = (bf16_t*)((lds - half * RW_ITEM_FLOATS) + (8 * TCR * 64 + 64 + 2 * TCR * 64));
    bf16_t* raw = LAb + TCR * LAP;
    constexpr int PPR = 56, NROW = 17, NLD = 4, RP = 448;
    const float* mu = p.in[9]; const float* w2 = p.in[11]; const float* a2 = p.in[13]; const float* g2 = p.in[14];
    const int tid = otid() & 255, lane = tid & 63, lw = tid >> 6;
    const int kg = lane & 7, vp = lw * 8 + (lane >> 3);
    const int hc = h * 64 + lane;
    auto col = [&](int pc) { return pc < 24 ? (pc >> 3) * 512 + h * 64 + (pc & 7) * 8 : 1536 + (pc - 24) * 8; };
    const size_t brow = (size_t)b * L;
    const int j1 = tid; const float mu1 = mu[1536 + j1];
    const int tq = tid >> 4, cl = tid & 15, hc4 = h * 64 + 4 * cl;
    const float4 mu_r = *(const float4*)(mu + hc4), mu_k = *(const float4*)(mu + 512 + hc4), mu_v = *(const float4*)(mu + 1024 + hc4);
    const float4 w0c = *(const float4*)(p.in[10] + hc4), a0c = *(const float4*)(p.in[12] + hc4), kksc = *(const float4*)(p.in[15] + hc4), kasc = *(const float4*)(p.in[16] + hc4);
    const float4 rkc = *(const float4*)(p.in[17] + hc4), lnwc = *(const float4*)(p.in[18] + hc4), lnbc = *(const float4*)(p.in[19] + hc4);
    f32x2 S[8];
#pragma unroll
    for (int i = 0; i < 8; ++i) S[i] = (f32x2){0.f, 0.f};
    const int fn = lane & 15, fkq = lane >> 4;
    bf16x8 bw[2], ba[2], bg[4];
    {
        const int cc = h * 64 + lw * 16 + fn;
#pragma unroll
        for (int ks = 0; ks < 2; ++ks) {
            float e[8], f[8];
#pragma unroll
            for (int j = 0; j < 8; ++j) { e[j] = w2[(ks * 32 + fkq * 8 + j) * 512 + cc]; f[j] = a2[(ks * 32 + fkq * 8 + j) * 512 + cc]; }
            u32x4 u; u.x = cvt_pk_bf16(e[0], e[1]); u.y = cvt_pk_bf16(e[2], e[3]); u.z = cvt_pk_bf16(e[4], e[5]); u.w = cvt_pk_bf16(e[6], e[7]); bw[ks] = __builtin_bit_cast(bf16x8, u);
            u.x = cvt_pk_bf16(f[0], f[1]); u.y = cvt_pk_bf16(f[2], f[3]); u.z = cvt_pk_bf16(f[4], f[5]); u.w = cvt_pk_bf16(f[6], f[7]); ba[ks] = __builtin_bit_cast(bf16x8, u);
        }
#pragma unroll
        for (int ks = 0; ks < 4; ++ks) {
            float e[8];
#pragma unroll
            for (int j = 0; j < 8; ++j) e[j] = g2[(ks * 32 + fkq * 8 + j) * 512 + cc];
            u32x4 u; u.x = cvt_pk_bf16(e[0], e[1]); u.y = cvt_pk_bf16(e[2], e[3]); u.z = cvt_pk_bf16(e[4], e[5]); u.w = cvt_pk_bf16(e[6], e[7]); bg[ks] = __builtin_bit_cast(bf16x8, u);
        }
    }
    u32x4 rg[NLD];
    __syncthreads();
    raw_fetch<PPR, NROW, NLD, 256>(rg, P, tid, brow, -1, col); raw_store<PPR, NROW, NLD, 256>(rg, raw, tid);
    for (int t0 = 0; t0 < L; t0 += TCR) {
        const bool more = (t0 + TCR < L);
        if (t0 == 0) __syncthreads();
#pragma unroll 4
        for (int t = half * 8; t < half * 8 + 8; ++t) {
            const float cur = bf2f(raw[(t + 1) * RP + 192 + j1]), prev = bf2f(raw[t * RP + 192 + j1]);
            const float x = cur + (prev - cur) * mu1;
            float y;
            if (j1 < 64) y = 1.0f - 2.0f * __builtin_amdgcn_rcpf(1.0f + __expf(2.0f * x)); else if (j1 < 128) y = x; else y = sigmoidf_(x);
            LAbS[t * LAP + j1] = f2bf(y);
        }
        __syncthreads();
        {
            const bf16_t* ap = LAbS + fn * LAP + fkq * 8;
            f32x4 cw4 = {0.f, 0.f, 0.f, 0.f}, ca4 = {0.f, 0.f, 0.f, 0.f}, cg4 = {0.f, 0.f, 0.f, 0.f};
#pragma unroll
            for (int ks = 0; ks < 2; ++ks) cw4 = __builtin_amdgcn_mfma_f32_16x16x32_bf16(*(const bf16x8*)(ap + ks * 32), bw[ks], cw4, 0, 0, 0);
#pragma unroll
            for (int ks = 0; ks < 2; ++ks) ca4 = __builtin_amdgcn_mfma_f32_16x16x32_bf16(*(const bf16x8*)(ap + 64 + ks * 32), ba[ks], ca4, 0, 0, 0);
#pragma unroll
            for (int ks = 0; ks < 4; ++ks) cg4 = __builtin_amdgcn_mfma_f32_16x16x32_bf16(*(const bf16x8*)(ap + 128 + ks * 32), bg[ks], cg4, 0, 0, 0);
#pragma unroll
            for (int j = 0; j < 4; ++j) { const int o = (fkq * 4 + j) * 64 + lw * 16 + fn; WP[o] = cw4[j]; AP[o] = ca4[j]; G[o] = cg4[j]; }
        }
        __syncthreads();
        {
            const int t = tq;
            const u32x2 c0 = *(const u32x2*)(raw + (t + 1) * RP + 4 * cl), c1 = *(const u32x2*)(raw + (t + 1) * RP + 64 + 4 * cl), c2v = *(const u32x2*)(raw + (t + 1) * RP + 128 + 4 * cl);
            const u32x2 p0 = *(const u32x2*)(raw + t * RP + 4 * cl), p1 = *(const u32x2*)(raw + t * RP + 64 + 4 * cl), p2 = *(const u32x2*)(raw + t * RP + 128 + 4 * cl);
            auto up4 = [](u32x2 u, float (&o)[4]) { o[0] = __uint_as_float(u.x << 16); o[1] = __uint_as_float(u.x & 0xffff0000u); o[2] = __uint_as_float(u.y << 16); o[3] = __uint_as_float(u.y & 0xffff0000u); };
            float cr[4], ck[4], cv[4], pr[4], pk[4], pv[4];
            up4(c0, cr); up4(c1, ck); up4(c2v, cv); up4(p0, pr); up4(p1, pk); up4(p2, pv);
            const float4 wp4 = *(const float4*)(WP + t * 64 + 4 * cl), ap4 = *(const float4*)(AP + t * 64 + 4 * cl);
            const float mur[4] = {mu_r.x, mu_r.y, mu_r.z, mu_r.w}, muk[4] = {mu_k.x, mu_k.y, mu_k.z, mu_k.w}, muv[4] = {mu_v.x, mu_v.y, mu_v.z, mu_v.w};
            const float w0a[4] = {w0c.x, w0c.y, w0c.z, w0c.w}, a0a[4] = {a0c.x, a0c.y, a0c.z, a0c.w}, kksa[4] = {kksc.x, kksc.y, kksc.z, kksc.w}, kasa[4] = {kasc.x, kasc.y, kasc.z, kasc.w}, rka[4] = {rkc.x, rkc.y, rkc.z, rkc.w};
            const float wpa[4] = {wp4.x, wp4.y, wp4.z, wp4.w}, apa[4] = {ap4.x, ap4.y, ap4.z, ap4.w};
            float rr[4], kr[4], vr[4], dec[4], av[4], kkr[4], kmod[4]; float ssq = 0.f, rks = 0.f;
#pragma unroll
            for (int e = 0; e < 4; ++e) {
                rr[e] = cr[e] + (pr[e] - cr[e]) * mur[e]; kr[e] = ck[e] + (pk[e] - ck[e]) * muk[e]; vr[e] = cv[e] + (pv[e] - cv[e]) * muv[e];
                dec[e] = __expf(-0.60653065971263342f * sigmoidf_(w0a[e] + wpa[e]));
                av[e] = sigmoidf_(a0a[e] + apa[e]);
                kkr[e] = kr[e] * kksa[e]; ssq += kkr[e] * kkr[e];
                kmod[e] = kr[e] * (1.0f + (av[e] - 1.0f) * kasa[e]);
                rks += rr[e] * kmod[e] * rka[e];
            }
            ssq = allreduce16(ssq); rks = allreduce16(rks);
            const float rn = rsqrtf(ssq + EPS);
            *(float4*)(R + t * 64 + 4 * cl) = make_float4(rr[0], rr[1], rr[2], rr[3]);
            *(float4*)(W + t * 64 + 4 * cl) = make_float4(dec[0], dec[1], dec[2], dec[3]);
            *(float4*)(Kk + t * 64 + 4 * cl) = make_float4(kmod[0], kmod[1], kmod[2], kmod[3]);
            *(float4*)(Vv + t * 64 + 4 * cl) = make_float4(vr[0], vr[1], vr[2], vr[3]);
            *(float4*)(A + t * 64 + 4 * cl) = make_float4(-kkr[0] * rn, -kkr[1] * rn, -kkr[2] * rn, -kkr[3] * rn);
            *(float4*)(Bb + t * 64 + 4 * cl) = make_float4(kkr[0] * rn * av[0], kkr[1] * rn * av[1], kkr[2] * rn * av[2], kkr[3] * rn * av[3]);
            if (cl == 0) RK[t] = rks;
        }
        __syncthreads();
        if (more) raw_fetch<PPR, NROW, NLD, 256>(rg, P, tid, brow, t0 + TCR - 1, col);
        {
            struct Ops { float4 aa, ab, wa, wb, ba, bb, ka, kb, ra, rb; float2 vv; };
            auto ld = [&](Ops& o, int t) {
                o.aa = *(const float4*)(A + t * 64 + kg * 8); o.ab = *(const float4*)(A + t * 64 + kg * 8 + 4);
                o.wa = *(const float4*)(W + t * 64 + kg * 8); o.wb = *(const float4*)(W + t * 64 + kg * 8 + 4);
                o.ba = *(const float4*)(Bb + t * 64 + kg * 8); o.bb = *(const float4*)(Bb + t * 64 + kg * 8 + 4);
                o.ka = *(const float4*)(Kk + t * 64 + kg * 8); o.kb = *(const float4*)(Kk + t * 64 + kg * 8 + 4);
                o.ra = *(const float4*)(R + t * 64 + kg * 8); o.rb = *(const float4*)(R + t * 64 + kg * 8 + 4);
                o.vv = *(const float2*)(Vv + t * 64 + 2 * vp);
            };
            auto step = [&](const Ops& x, int t) {
                const float a8[8] = {x.aa.x, x.aa.y, x.aa.z, x.aa.w, x.ab.x, x.ab.y, x.ab.z, x.ab.w};
                const float w8[8] = {x.wa.x, x.wa.y, x.wa.z, x.wa.w, x.wb.x, x.wb.y, x.wb.z, x.wb.w};
                const float b8[8] = {x.ba.x, x.ba.y, x.ba.z, x.ba.w, x.bb.x, x.bb.y, x.bb.z, x.bb.w};
                const float k8[8] = {x.ka.x, x.ka.y, x.ka.z, x.ka.w, x.kb.x, x.kb.y, x.kb.z, x.kb.w};
                const float r8[8] = {x.ra.x, x.ra.y, x.ra.z, x.ra.w, x.rb.x, x.rb.y, x.rb.z, x.rb.w};
                const f32x2 vv2 = {x.vv.x, x.vv.y};
                f32x2 sa0 = {0.f, 0.f}, sa1 = {0.f, 0.f};
#pragma unroll
                for (int i = 0; i < 8; i += 2) { sa0 += S[i] * a8[i]; sa1 += S[i + 1] * a8[i + 1]; }
                f32x2 sa = sa0 + sa1; sa.x = allreduce8(sa.x); sa.y = allreduce8(sa.y);
                f32x2 y0 = {0.f, 0.f}, y1 = {0.f, 0.f};
#pragma unroll
                for (int i = 0; i < 8; i += 2) {
                    S[i] = S[i] * w8[i] + sa * b8[i] + vv2 * k8[i]; y0 += S[i] * r8[i];
                    S[i + 1] = S[i + 1] * w8[i + 1] + sa * b8[i + 1] + vv2 * k8[i + 1]; y1 += S[i + 1] * r8[i + 1];
                }
                f32x2 y = y0 + y1; y.x = allreduce8(y.x); y.y = allreduce8(y.y);
                if (kg == 0) *(float2*)(O + t * 64 + 2 * vp) = make_float2(y.x, y.y);
            };
            Ops A_, B_; ld(A_, 0);
#pragma unroll
            for (int t = 0; t < TCR; t += 2) {
                ld(B_, t + 1); step(A_, t);
                if (t + 2 < TCR) ld(A_, t + 2);
                step(B_, t + 1);
            }
        }
        if (more) raw_store<PPR, NROW, NLD, 256>(rg, raw, tid);
        __syncthreads();
        {
            const int t = tq; const size_t row = brow + t0 + t;
            const float4 y4 = *(const float4*)(O + t * 64 + 4 * cl), v4 = *(const float4*)(Vv + t * 64 + 4 * cl), g4 = *(const float4*)(G + t * 64 + 4 * cl);
            const float mean = allreduce16((y4.x + y4.y) + (y4.z + y4.w)) * (1.0f / 64.0f);
            const float x0 = y4.x - mean, x1 = y4.y - mean, x2 = y4.z - mean, x3 = y4.w - mean;
            const float var = allreduce16((x0 * x0 + x1 * x1) + (x2 * x2 + x3 * x3)) * (1.0f / 64.0f);
            const float rs = rsqrtf(var + 64e-5f), rkt = RK[t];
            const float o0 = (x0 * rs * lnwc.x + lnbc.x + rkt * v4.x) * g4.x, o1 = (x1 * rs * lnwc.y + lnbc.y + rkt * v4.y) * g4.y;
            const float o2 = (x2 * rs * lnwc.z + lnbc.z + rkt * v4.z) * g4.z, o3 = (x3 * rs * lnwc.w + lnbc.w + rkt * v4.w) * g4.w;
            u32x2 ow; ow.x = cvt_pk_bf16(o0, o1); ow.y = cvt_pk_bf16(o2, o3);
            *(u32x2*)(Y + row * D + hc4) = ow;
        }
    }
}
template <int CTRL> __device__ __forceinline__ float dpp0f(float x) { return __int_as_float(__builtin_amdgcn_update_dpp(0, __float_as_int(x), CTRL, 0xF, 0xF, true)); }
__device__ __forceinline__ void gdn_item(const Params& p, float* lds, int b, int h) {
    const bf16_t* P = (const bf16_t*)(p.ws + WS_BIG);
    bf16_t* Y = (bf16_t*)(p.ws + WS_A1);
    constexpr int QP = 136, MP = 24;
    float* O = lds; float* Gt = O + TCH * 128; float* GB = Gt + TCH * 128; float* CG = GB + 64;
    bf16_t* MinvB = (bf16_t*)(CG + 64); bf16_t* MinvE = MinvB + 2 * 16 * MP;
    bf16_t* Qb = MinvE + 2 * 16 * MP; bf16_t* Kb = Qb + TCH * QP; bf16_t* Wb = Kb + TCH * QP;
    bf16_t* KT = Wb + TCH * QP; bf16_t* VT = KT + 2 * 128 * 16;
    bf16_t* raw = VT + 2 * 128 * 16;
    constexpr int PPR = 65, NROW = 35, NLD = 5, RP = 520;
    const float* cw = p.in[20];
    const int tid = otid(), lane = tid & 63, w = tid >> 6;
    const int fn = lane & 15, g = lane >> 4, vs = w * 16;
    auto col = [&](int pc) { return pc < 48 ? 1792 + (pc >> 4) * 512 + h * 128 + (pc & 15) * 8 : (pc < 64 ? 3328 + h * 128 + (pc - 48) * 8 : 3840); };
    const size_t brow = (size_t)b * L;
    const float Aneg = -__expf(p.in[21][h]); const float dtb = p.in[22][h];
    const float2 gn = *(const float2*)(p.in[23] + 2 * lane);
    float cwr[3][4][2];
#pragma unroll
    for (int x = 0; x < 3; ++x)
#pragma unroll
        for (int j = 0; j < 4; ++j) { cwr[x][j][0] = cw[j * 1536 + x * 512 + h * 128 + 2 * lane]; cwr[x][j][1] = cw[j * 1536 + x * 512 + h * 128 + 2 * lane + 1]; }
    f32x4 S[8];
#pragma unroll
    for (int T = 0; T < 8; ++T) S[T] = (f32x4){0.f, 0.f, 0.f, 0.f};
    u32x4 rg[NLD];
    __syncthreads();
    raw_fetch<PPR, NROW, NLD>(rg, P, tid, brow, -3, col); raw_store<PPR, NROW, NLD>(rg, raw, tid);
    for (int t0 = 0; t0 < L; t0 += TCH) {
        const int ns = (L - t0) < TCH ? (L - t0) : TCH;
        const bool more = (t0 + TCH < L);
        __syncthreads();
        if (more) raw_fetch<PPR, NROW, NLD>(rg, P, tid, brow, t0 + TCH - 3, col);
        for (int t = w; t < ns; t += 8) {
            float xs[3][2];
#pragma unroll
            for (int x = 0; x < 3; ++x) {
                float a0 = 0.f, a1 = 0.f;
#pragma unroll
                for (int j = 0; j < 4; ++j) {
                    const unsigned wv = *(const unsigned*)(raw + (t + j) * RP + x * 128 + 2 * lane);
                    a0 += cwr[x][j][0] * __uint_as_float(wv << 16); a1 += cwr[x][j][1] * __uint_as_float(wv & 0xffff0000u);
                }
                xs[x][0] = siluf_(a0); xs[x][1] = siluf_(a1);
            }
            const float sq = wave_sum(xs[0][0] * xs[0][0] + xs[0][1] * xs[0][1]);
            const float sk = wave_sum(xs[1][0] * xs[1][0] + xs[1][1] * xs[1][1]);
            const float rq = rsqrtf(sq + EPS) * 0.08838834764831845f, rk = rsqrtf(sk + EPS);
            const int c2 = t >> 4, i = t & 15;
            *(unsigned*)(Qb + t * QP + 2 * lane) = cvt_pk_bf16(xs[0][0] * rq, xs[0][1] * rq);
            const unsigned kw = cvt_pk_bf16(xs[1][0] * rk, xs[1][1] * rk);
            *(unsigned*)(Kb + t * QP + 2 * lane) = kw;
            KT[(c2 * 128 + 2 * lane) * 16 + i] = (bf16_t)(kw & 0xffffu); KT[(c2 * 128 + 2 * lane + 1) * 16 + i] = (bf16_t)(kw >> 16);
            const unsigned vw = cvt_pk_bf16(xs[2][0], xs[2][1]);
            VT[(c2 * 128 + 2 * lane) * 16 + i] = (bf16_t)(vw & 0xffffu); VT[(c2 * 128 + 2 * lane + 1) * 16 + i] = (bf16_t)(vw >> 16);
            const unsigned gw = *(const unsigned*)(raw + (t + 3) * RP + 384 + 2 * lane);
            *(float2*)(Gt + t * 128 + 2 * lane) = make_float2(siluf_(__uint_as_float(gw << 16)), siluf_(__uint_as_float(gw & 0xffff0000u)));
            if (lane == 0) {
                const float al = bf2f(raw[(t + 3) * RP + 512 + h]), be = bf2f(raw[(t + 3) * RP + 516 + h]);
                GB[t * 2] = Aneg * softplusf_(al + dtb); GB[t * 2 + 1] = sigmoidf_(be);
            }
        }
        __syncthreads();
        if (w < 2 && w * 16 < ns) {
            const int c2 = w;
            float cgf = GB[(c2 * 16 + fn) * 2]; const float betf = GB[(c2 * 16 + fn) * 2 + 1];
            cgf += dpp0f<0x111>(cgf); cgf += dpp0f<0x112>(cgf); cgf += dpp0f<0x114>(cgf); cgf += dpp0f<0x118>(cgf);
            if (g == 0) CG[c2 * 16 + fn] = cgf;
            const bf16_t* krow = Kb + (c2 * 16 + fn) * QP;
            f32x4 kk4 = {0.f, 0.f, 0.f, 0.f};
#pragma unroll
            for (int ks = 0; ks < 4; ++ks) { const bf16x8 kf = *(const bf16x8*)(krow + ks * 32 + g * 8); kk4 = __builtin_amdgcn_mfma_f32_16x16x32_bf16(kf, kf, kk4, 0, 0, 0); }
            const float4 cga = *(const float4*)(CG + c2 * 16 + 4 * g);
            const float cga4[4] = {cga.x, cga.y, cga.z, cga.w};
            float m4[4];
#pragma unroll
            for (int jj = 0; jj < 4; ++jj) { const float ba = GB[(c2 * 16 + 4 * g + jj) * 2 + 1]; m4[jj] = (fn < 4 * g + jj) ? ba * kk4[jj] * __expf(cga4[jj] - cgf) : 0.f; }
            float x[16];
#pragma unroll
            for (int i = 0; i < 16; ++i) {
                float acc = (fn == i) ? 1.f : 0.f;
#pragma unroll
                for (int j = 0; j < i; ++j) {
                    const float mij = __int_as_float(__builtin_amdgcn_readlane(__float_as_int(m4[i & 3]), j + 16 * (i >> 2)));
                    acc -= mij * x[j];
                }
                x[i] = acc;
            }
            if (g == 0) {
                const float eb = betf * __expf(cgf);
#pragma unroll
                for (int i = 0; i < 16; ++i) { MinvB[(c2 * 16 + i) * MP + fn] = f2bf(x[i] * betf); MinvE[(c2 * 16 + i) * MP + fn] = f2bf(x[i] * eb); }
            }
        }
        __syncthreads();
        for (int c2 = 0; c2 < 2; ++c2) {
            if (c2 * 16 >= ns) break;
            const u32x2 ma = *(const u32x2*)(MinvE + (c2 * 16 + fn) * MP + 4 * g); const u32x2 kt = *(const u32x2*)(KT + (c2 * 128 + vs + fn) * 16 + 4 * g);
            u32x4 ua; ua.x = ma.x; ua.y = ma.y; ua.z = 0u; ua.w = 0u; u32x4 ub; ub.x = kt.x; ub.y = kt.y; ub.z = 0u; ub.w = 0u;
            const f32x4 c4 = __builtin_amdgcn_mfma_f32_16x16x32_bf16(__builtin_bit_cast(bf16x8, ua), __builtin_bit_cast(bf16x8, ub), (f32x4){0.f, 0.f, 0.f, 0.f}, 0, 0, 0);
#pragma unroll
            for (int jj = 0; jj < 4; ++jj) Wb[(c2 * 16 + 4 * g + jj) * QP + vs + fn] = f2bf(c4[jj]);
        }
        __syncthreads();
        for (int c2 = 0; c2 < 2; ++c2) {
            if (c2 * 16 >= ns) break;
            const float4 cgt = *(const float4*)(CG + c2 * 16 + 4 * g); const float cgt4[4] = {cgt.x, cgt.y, cgt.z, cgt.w};
            const float cgf = CG[c2 * 16 + fn], cg15 = CG[c2 * 16 + 15];
            const bf16_t* qrow = Qb + (c2 * 16 + fn) * QP; const bf16_t* krow = Kb + (c2 * 16 + fn) * QP; const bf16_t* wrow = Wb + (c2 * 16 + fn) * QP;
            f32x4 at4 = {0.f, 0.f, 0.f, 0.f};
#pragma unroll
            for (int ks = 0; ks < 4; ++ks) at4 = __builtin_amdgcn_mfma_f32_16x16x32_bf16(*(const bf16x8*)(krow + ks * 32 + g * 8), *(const bf16x8*)(qrow + ks * 32 + g * 8), at4, 0, 0, 0);
            float qv[4];
#pragma unroll
            for (int jj = 0; jj < 4; ++jj) qv[jj] = (4 * g + jj <= fn) ? at4[jj] * __expf(cgf - cgt4[jj]) : 0.f;
            u32x4 uqk; uqk.x = cvt_pk_bf16(qv[0], qv[1]); uqk.y = cvt_pk_bf16(qv[2], qv[3]); uqk.z = 0u; uqk.w = 0u;
            const u32x2 mb = *(const u32x2*)(MinvB + (c2 * 16 + fn) * MP + 4 * g); const u32x2 vt = *(const u32x2*)(VT + (c2 * 128 + vs + fn) * 16 + 4 * g);
            u32x4 uma; uma.x = mb.x; uma.y = mb.y; uma.z = 0u; uma.w = 0u; u32x4 uvt; uvt.x = vt.x; uvt.y = vt.y; uvt.z = 0u; uvt.w = 0u;
            const f32x4 u4 = __builtin_amdgcn_mfma_f32_16x16x32_bf16(__builtin_bit_cast(bf16x8, uma), __builtin_bit_cast(bf16x8, uvt), (f32x4){0.f, 0.f, 0.f, 0.f}, 0, 0, 0);
            f32x4 ws4 = {0.f, 0.f, 0.f, 0.f}, qs4 = {0.f, 0.f, 0.f, 0.f};
#pragma unroll
            for (int ks = 0; ks < 4; ++ks) {
                u32x4 us; us.x = cvt_pk_bf16(S[2 * ks][0], S[2 * ks][1]); us.y = cvt_pk_bf16(S[2 * ks][2], S[2 * ks][3]); us.z = cvt_pk_bf16(S[2 * ks + 1][0], S[2 * ks + 1][1]); us.w = cvt_pk_bf16(S[2 * ks + 1][2], S[2 * ks + 1][3]);
                const bf16x8 sb = __builtin_bit_cast(bf16x8, us);
                const u32x2 wa = *(const u32x2*)(wrow + (2 * ks) * 16 + 4 * g), wb2 = *(const u32x2*)(wrow + (2 * ks + 1) * 16 + 4 * g);
                u32x4 uw; uw.x = wa.x; uw.y = wa.y; uw.z = wb2.x; uw.w = wb2.y;
                ws4 = __builtin_amdgcn_mfma_f32_16x16x32_bf16(__builtin_bit_cast(bf16x8, uw), sb, ws4, 0, 0, 0);
                const u32x2 qa = *(const u32x2*)(qrow + (2 * ks) * 16 + 4 * g), qb2 = *(const u32x2*)(qrow + (2 * ks + 1) * 16 + 4 * g);
                u32x4 uq; uq.x = qa.x; uq.y = qa.y; uq.z = qb2.x; uq.w = qb2.y;
                qs4 = __builtin_amdgcn_mfma_f32_16x16x32_bf16(__builtin_bit_cast(bf16x8, uq), sb, qs4, 0, 0, 0);
            }
            float vn[4];
#pragma unroll
            for (int jj = 0; jj < 4; ++jj) { vn[jj] = u4[jj] - ws4[jj]; qs4[jj] *= __expf(cgt4[jj]); }
            u32x4 uvn; uvn.x = cvt_pk_bf16(vn[0], vn[1]); uvn.y = cvt_pk_bf16(vn[2], vn[3]); uvn.z = 0u; uvn.w = 0u;
            const f32x4 o4 = __builtin_amdgcn_mfma_f32_16x16x32_bf16(__builtin_bit_cast(bf16x8, uqk), __builtin_bit_cast(bf16x8, uvn), qs4, 0, 0, 0);
#pragma unroll
            for (int jj = 0; jj < 4; ++jj) O[(c2 * 16 + 4 * g + jj) * 128 + vs + fn] = o4[jj];
            u32x4 uvd; uvd.x = cvt_pk_bf16(vn[0] * __expf(cg15 - cgt4[0]), vn[1] * __expf(cg15 - cgt4[1])); uvd.y = cvt_pk_bf16(vn[2] * __expf(cg15 - cgt4[2]), vn[3] * __expf(cg15 - cgt4[3])); uvd.z = 0u; uvd.w = 0u;
            const bf16x8 vdb = __builtin_bit_cast(bf16x8, uvd);
            const float e15 = __expf(cg15);
#pragma unroll
            for (int T = 0; T < 8; ++T) {
                const u32x2 kh = *(const u32x2*)(KT + (c2 * 128 + T * 16 + fn) * 16 + 4 * g);
                u32x4 uk; uk.x = kh.x; uk.y = kh.y; uk.z = 0u; uk.w = 0u;
                f32x4 sc = S[T]; sc[0] *= e15; sc[1] *= e15; sc[2] *= e15; sc[3] *= e15;
                S[T] = __builtin_amdgcn_mfma_f32_16x16x32_bf16(__builtin_bit_cast(bf16x8, uk), vdb, sc, 0, 0, 0);
            }
        }
        if (more) raw_store<PPR, NROW, NLD>(rg, raw, tid);
        __syncthreads();
        for (int t = w; t < ns; t += 8) {
            const size_t row = brow + t0 + t;
            const float2 o2 = *(const float2*)(O + t * 128 + lane * 2);
            const float2 g2 = *(const float2*)(Gt + t * 128 + lane * 2);
            const int v = lane * 2;
            const float ms = wave_sum(o2.x * o2.x + o2.y * o2.y) * (1.0f / 128.0f);
            const float rs = rsqrtf(ms + EPS);
            *(unsigned*)(Y + row * D + 512 + h * 128 + v) = cvt_pk_bf16(o2.x * rs * gn.x * g2.x, o2.y * rs * gn.y * g2.y);
        }
    }
}
__device__ __forceinline__ void odd_scan_phase(const Params& p, float* lds) {
    for (int item = obid(); item < 256; item += gridDim.x) {
        if (item < 128) { gdn_item(p, lds, item >> 2, item & 3); __syncthreads(); }
        else {
            const int half = otid() >> 8; const int i0 = (item - 128) * 2 + half;
            rwkv_half(p, lds + half * RW_ITEM_FLOATS, i0 >> 3, i0 & 7, half); __syncthreads();
        }
    }
}

#define XB_TMO      128
#define XB_XCNT(j)  (256  + 64 * (j))
#define XB_XSUB(j)  (1280 + 64 * (j))
#define XB_XGEN(j)  (2304 + 64 * (j))
#define XB_TOP      3328
#define XB_TOPGEN   3392
#define XCD_BAR_WORDS 3456
#define XB_SPIN_CAP (1u << 18)
__device__ __forceinline__ unsigned xb_ld(unsigned* p)              { return __hip_atomic_load(p, __ATOMIC_RELAXED, __HIP_MEMORY_SCOPE_AGENT); }
__device__ __forceinline__ unsigned xb_add(unsigned* p, unsigned v) { return __hip_atomic_fetch_add(p, v, __ATOMIC_RELAXED, __HIP_MEMORY_SCOPE_AGENT); }
__device__ __forceinline__ unsigned xb_xcc_id() { return (unsigned)__builtin_amdgcn_s_getreg((3 << 11) | 20) & 0xFu; }
#define XB_SPIN(cond, bar) do { unsigned _sp = 0; while (cond) { __builtin_amdgcn_s_sleep(1); \
    if ((++_sp & 255u) == 0u) { if (xb_ld(&(bar)[XB_TMO])) break; if (_sp > XB_SPIN_CAP) { atomicAdd(&(bar)[XB_TMO], 1u); break; } } } } while (0)
struct XcdBarrier { unsigned* bar; unsigned x; volatile LAS unsigned* st; };
__device__ __forceinline__ XcdBarrier xcd_barrier_post(unsigned* bar, volatile LAS unsigned* st) {
    XcdBarrier b; b.bar = bar; b.x = xb_xcc_id(); b.st = st;
    if (threadIdx.x == 0) (void)xb_add(&bar[XB_XCNT(b.x)], 1u);
    return b;
}
__device__ __forceinline__ void xcd_barrier_complete(unsigned* bar, unsigned x, unsigned& nloc, unsigned& nx) {
    const unsigned G = gridDim.x * gridDim.y * gridDim.z;
    unsigned sum, cnt, mine, sp = 0u;
    for (;;) {
        sum = 0u; cnt = 0u; mine = 0u;
#pragma unroll
        for (unsigned j = 0; j < 16; ++j) { const unsigned c = xb_ld(&bar[XB_XCNT(j)]); sum += c; cnt += (c > 0u) ? 1u : 0u; mine = (j == x) ? c : mine; }
        if (sum == G) break;
        __builtin_amdgcn_s_sleep(1);
        if ((++sp & 255u) == 0u) { if (xb_ld(&bar[XB_TMO])) break; if (sp > XB_SPIN_CAP) { atomicAdd(&bar[XB_TMO], 1u); break; } }
    }
    nloc = mine > 0u ? mine : 1u; nx = cnt > 0u ? cnt : 1u;
}
__device__ __forceinline__ void xcd_barrier(const XcdBarrier& b) {
    asm volatile("s_waitcnt vmcnt(0)" ::: "memory");
    __syncthreads();
    if (threadIdx.x == 0) {
        unsigned* bar = b.bar;
        __builtin_amdgcn_s_waitcnt(0);
        unsigned nloc = b.st[0], nx = b.st[1];
        if (nloc == 0u) { xcd_barrier_complete(bar, b.x, nloc, nx); b.st[0] = nloc; b.st[1] = nx; }
        const unsigned old = xb_add(&bar[XB_XSUB(b.x)], 1u);
        const unsigned gen = old / nloc;
        if (old + 1u == (gen + 1u) * nloc) {
            __builtin_amdgcn_fence(__ATOMIC_RELEASE, "agent");
            asm volatile("s_waitcnt vmcnt(0)" ::: "memory");
            const unsigned og = xb_add(&bar[XB_TOP], 1u);
            const unsigned tg = og / nx;
            if (og + 1u == (tg + 1u) * nx) xb_add(&bar[XB_TOPGEN], 1u);
            else XB_SPIN(xb_ld(&bar[XB_TOPGEN]) == tg, bar);
            __builtin_amdgcn_fence(__ATOMIC_ACQUIRE, "agent");
            xb_add(&bar[XB_XGEN(b.x)], 1u);
            asm volatile("s_waitcnt vmcnt(0)" ::: "memory");
        } else {
            XB_SPIN(xb_ld(&bar[XB_XGEN(b.x)]) == gen, bar);
            __builtin_amdgcn_fence(__ATOMIC_ACQUIRE, "agent");
            asm volatile("s_waitcnt vmcnt(0)" ::: "memory");
        }
    }
    __syncthreads();
}

constexpr int NPHASE = 21;
__global__ void __launch_bounds__(512, 2) hybrid_fwd(Params p) {
    extern __shared__ __attribute__((aligned(16))) unsigned char lds_raw[];
    cg::grid_group grid = cg::this_grid();
    unsigned char* ws = p.ws;
    __shared__ uint4 xb_words;
    if (threadIdx.x == 0) xb_words = make_uint4(0u, 0u, 0u, 0u);
    __syncthreads();
    const XcdBarrier xbar = xcd_barrier_post((unsigned*)(ws + WS_BAR), (volatile LAS unsigned*)&xb_words);
    bf16_t* A1 = (bf16_t*)(ws + WS_A1); bf16_t* BIG = (bf16_t*)(ws + WS_BIG);
    const float* NG = p.in[2];
    for (int ph = p.ph_lo; ph < p.ph_hi; ++ph) {
        int kind = 0;
        pg8::Gemm g{nullptr, nullptr, 0, 0, 0}; pg8::EpiBf16 E{nullptr, 0, 0, nullptr, nullptr, nullptr, (LAS float*)((LAS unsigned char*)lds_raw + 131072)};
        int nmode = 1; const bf16_t* nsrc = nullptr; const float* gA = nullptr; const float* gB = nullptr; int layer = 0;
        const int lyr = ph >= 11 ? 1 : 0; const int q = ph - lyr * 10;
        const bf16_t* Wup = (const bf16_t*)(ws + WS_WB + (lyr ? WB_UP1 : WB_UP0)); const bf16_t* Wdn = (const bf16_t*)(ws + WS_WB + (lyr ? WB_DN1 : WB_DN0));
        const bf16_t* Wout = (const bf16_t*)(ws + WS_WB + (lyr ? WB_OUTO : WB_OUTE));
        bf16_t* ACTF = (bf16_t*)(ws + WS_BIG); bf16_t* HALO = (bf16_t*)(ws + WS_BIG + BIG_HALO);
        int gG = gridDim.x, tailnorm = 0, nlo = 0, nhi = M;
        if (ph == 0) kind = 0;
        else if (q == 1) { kind = 1; g = pg8::Gemm{A1, (const bf16_t*)(ws + WS_WB + (lyr ? WB_INO : WB_INE)), M, PW, D}; E.O = BIG; E.ldc = PW; }
        else if (q == 2) { kind = lyr ? 3 : 2; }
        else if (q == 3) { kind = 1; g = pg8::Gemm{A1, Wout, MHEAD, D, D}; E.O = BIG; E.ldc = D; }
        else if (q == 4) { kind = 1; gG = 8; tailnorm = 1; g = pg8::Gemm{A1 + (size_t)MHEAD * D, Wout, M - MHEAD, D, D}; E.O = BIG + (size_t)MHEAD * D; E.ldc = D;
            nmode = 1; nsrc = BIG; gA = NG + (lyr * 4 + 1) * D; gB = NG + (lyr * 4 + 2) * D; nhi = MHEAD; }
        else if (q == 5) { kind = 4; nmode = 1; nsrc = BIG; gA = NG + (lyr * 4 + 1) * D; gB = NG + (lyr * 4 + 2) * D; nlo = MHEAD; }
        else if (q == 6) {
            kind = 1; g = pg8::Gemm{A1, Wup, M, DFF2, D}; E.O = ACTF; E.ldc = DFF; E.mode = 1; E.cw = p.in[25] + (size_t)lyr * 3 * DFF2; E.cb = p.in[26] + (size_t)lyr * DFF2; E.halo = HALO; }
        else if (q == 7) { kind = 5; layer = lyr; }
        else if (q == 8) { kind = 1; g = pg8::Gemm{ACTF, Wdn, MHEAD, D, DFF}; E.O = A1; E.ldc = D; }
        else {
            nsrc = A1; gA = NG + (lyr * 4 + 3) * D; if (lyr) nmode = 2; else { nmode = 1; gB = NG + (1 * 4 + 0) * D; }
            if (q == 9) { kind = 1; gG = 8; tailnorm = 1; g = pg8::Gemm{ACTF + (size_t)MHEAD * DFF, Wdn, M - MHEAD, D, DFF}; E.O = A1 + (size_t)MHEAD * D; E.ldc = D; nhi = MHEAD; }
            else { kind = 4; nlo = MHEAD; } }

#ifndef PROBE_KIND
#define PROBE_KIND -1
#endif
        for (int rep = 0; rep < ((kind == PROBE_KIND) ? 2 : 1); ++rep) {
        if (rep) xcd_barrier(xbar);
        if (kind == 0) {
            float* tile = (float*)lds_raw;
            bf16_t* wb = (bf16_t*)(ws + WS_WB);
            transpose_job(tile, p.in[3], (bf16_t*)((char*)wb + WB_INE), D, 4096, 4096, 0);
            transpose_job(tile, p.in[4], (bf16_t*)((char*)wb + WB_OUTE), D, D, D, 0);
            transpose_job(tile, p.in[7], (bf16_t*)((char*)wb + WB_INO), D, ODD_IN, 4096, 0);
            transpose_job(tile, p.in[8], (bf16_t*)((char*)wb + WB_OUTO), D, D, D, 0);
            transpose_job(tile, p.in[24], (bf16_t*)((char*)wb + WB_UP0), D, DFF2, DFF2, 1);
            transpose_job(tile, p.in[24] + (size_t)D * DFF2, (bf16_t*)((char*)wb + WB_UP1), D, DFF2, DFF2, 1);
            transpose_job(tile, p.in[27], (bf16_t*)((char*)wb + WB_DN0), DFF, D, D, 0);
            transpose_job(tile, p.in[27] + (size_t)DFF * D, (bf16_t*)((char*)wb + WB_DN1), DFF, D, D, 0);
            norm_phase(p, 0, nullptr, nullptr, NG, A1, 0, M, 0);
        } else if (kind == 1) {
            pg8::StaticOrder S; S.init(g.M, g.N, gG, obid());
            pg8::gemm_phase((LAS unsigned char*)lds_raw, g, S, E);
            if (tailnorm) norm_phase(p, nmode, nsrc, gA, gB, A1, nlo, nhi, 8);
        } else if (kind == 2) {
            even_scan_phase(p, (float*)lds_raw);
        } else if (kind == 3) {
            odd_scan_phase(p, (float*)lds_raw);
        } else if (kind == 4) {
            norm_phase(p, nmode, nsrc, gA, gB, A1, nlo, nhi, 0);
        } else {
            ffn_fixup_phase(p, layer);
        }
        }
        if (ph + 1 < p.ph_hi) { if (p.ph_hi > 1000) grid.sync(); else xcd_barrier(xbar); }
    }
}

extern "C" void kernel_launch(void* const* d_in, const int* in_sizes, int n_in, void* d_out, int out_size, void* d_ws, size_t ws_size, hipStream_t stream) {
    static int grid_blocks = 0;
    if (grid_blocks == 0) {
        if (n_in != 28 || ws_size < WS_END) { fprintf(stderr, "kernel_launch: need 28 inputs and %zu bytes of workspace (got %d, %zu)\n", (size_t)WS_END, n_in, ws_size); grid_blocks = -1; return; }
        int dev = 0, cus = 0, per_cu = 0;
        hipGetDevice(&dev);
        hipDeviceGetAttribute(&cus, hipDeviceAttributeMultiprocessorCount, dev);
        if (hipFuncSetAttribute((const void*)hybrid_fwd, hipFuncAttributeMaxDynamicSharedMemorySize, LDS_BYTES) != hipSuccess) { fprintf(stderr, "kernel_launch: hipFuncSetAttribute failed\n"); grid_blocks = -1; return; }
        if (hipOccupancyMaxActiveBlocksPerMultiprocessor(&per_cu, (const void*)hybrid_fwd, 512, LDS_BYTES) != hipSuccess || per_cu < 1) { fprintf(stderr, "kernel_launch: occupancy query says %d\n", per_cu); per_cu = 1; }
        (void)hipGetLastError();
        grid_blocks = cus;
    }
    if (grid_blocks < 0) return;
    if (hipMemsetAsync((char*)d_ws + WS_BAR, 0, XCD_BAR_WORDS * 4, stream) != hipSuccess) { fprintf(stderr, "kernel_launch: hipMemsetAsync of the barrier words failed\n"); return; }
    Params p{};
    for (int i = 0; i < 28; ++i) p.in[i] = (const float*)d_in[i];
    p.out = (float*)d_out; p.ws = (unsigned char*)d_ws;
#if defined(MK_PER_PHASE)
    for (int ph = 0; ph < NPHASE; ++ph) { p.ph_lo = ph; p.ph_hi = ph + 1; hipLaunchKernelGGL(hybrid_fwd, dim3(grid_blocks), dim3(512), LDS_BYTES, stream, p); }
#else
    p.ph_lo = 0; p.ph_hi = NPHASE;
    void* args[] = {&p};
    hipError_t e = hipLaunchCooperativeKernel((const void*)hybrid_fwd, dim3(grid_blocks), dim3(512), args, LDS_BYTES, stream);
    if (e != hipSuccess) fprintf(stderr, "kernel_launch: cooperative launch failed: %s (grid %d)\n", hipGetErrorString(e), grid_blocks);
#endif
}
```

```cpp
#include <hip/hip_runtime.h>
#include <hip/hip_cooperative_groups.h>
#include <cstdio>
namespace cg = cooperative_groups;

#define LAS __attribute__((address_space(3)))
typedef unsigned short bf16_t;
typedef short bf16x8 __attribute__((ext_vector_type(8)));
typedef float f32x4 __attribute__((ext_vector_type(4)));
typedef unsigned u32x4 __attribute__((ext_vector_type(4)));
typedef unsigned u32x2 __attribute__((ext_vector_type(2)));

constexpr int NB = 32, SEQ = 2048, NMETA = 16, L = 2064, D = 1024, M = NB * L;
constexpr int DFF = 2816, DFF2 = 5632;
constexpr int PW = 4096;
constexpr int ODD_IN = 3848;
constexpr int SLAB = 33024;
constexpr int MHEAD = 65536;
constexpr float EPS = 1e-6f;

constexpr size_t WS_H = 0;
constexpr size_t WS_Y2 = WS_H + (size_t)M * D * 2;
constexpr size_t WS_A1 = WS_H + (size_t)M * D * 4;
constexpr size_t WS_BIG = WS_A1 + (size_t)M * D * 2;
constexpr size_t BIG_ZUP = 0, BIG_ACT = (size_t)SLAB * DFF2 * 2;
constexpr size_t BIG_BYTES = BIG_ACT + (size_t)SLAB * DFF * 2;
constexpr size_t WS_WB = WS_BIG + BIG_BYTES;
constexpr size_t WB_INE = 0, WB_OUTE = WB_INE + (size_t)4096 * 1024 * 2, WB_INO = WB_OUTE + (size_t)1024 * 1024 * 2, WB_OUTO = WB_INO + (size_t)4096 * 1024 * 2;
constexpr size_t WB_UP0 = WB_OUTO + (size_t)1024 * 1024 * 2, WB_UP1 = WB_UP0 + (size_t)DFF2 * 1024 * 2, WB_DN0 = WB_UP1 + (size_t)DFF2 * 1024 * 2, WB_DN1 = WB_DN0 + (size_t)1024 * DFF * 2;
constexpr size_t WS_BAR = WS_WB + WB_DN1 + (size_t)1024 * DFF * 2;
constexpr size_t WS_END = WS_BAR + 16384;
static_assert(BIG_BYTES >= (size_t)M * PW * 2, "BIG holds the projection");

constexpr int LDS_BYTES = 131072 + 4096;

struct Params { const float* in[28]; float* out; unsigned char* ws; int ph_lo, ph_hi; };

__device__ __forceinline__ float bf2f(bf16_t v) { return __uint_as_float(((unsigned)v) << 16); }
typedef __bf16 bf16x2_t __attribute__((ext_vector_type(2)));
typedef float f32x2_t __attribute__((ext_vector_type(2)));
__device__ __forceinline__ unsigned cvt_pk_bf16(float lo, float hi) { const f32x2_t f = {lo, hi}; const bf16x2_t v = __builtin_convertvector(f, bf16x2_t); return __builtin_bit_cast(unsigned, v); }
__device__ __forceinline__ bf16_t f2bf(float f) { return (bf16_t)(cvt_pk_bf16(f, 0.f) & 0xffffu); }
__device__ __forceinline__ float sigmoidf_(float x) { return __builtin_amdgcn_rcpf(1.0f + __expf(-x)); }
__device__ __forceinline__ float siluf_(float x) { return x * sigmoidf_(x); }
__device__ __forceinline__ float softplusf_(float x) { return fmaxf(x, 0.f) + __logf(1.0f + __expf(-fabsf(x))); }
__device__ __forceinline__ int otid() { int t = threadIdx.x; asm volatile("" : "+v"(t)); return t; }
__device__ __forceinline__ int obid() { int b = blockIdx.x; asm volatile("" : "+s"(b)); return b; }
template <int CTRL> __device__ __forceinline__ float dppf(float x) { return __int_as_float(__builtin_amdgcn_update_dpp(0, __float_as_int(x), CTRL, 0xF, 0xF, true)); }
__device__ __forceinline__ float allreduce8(float x) { x += dppf<0xB1>(x); x += dppf<0x4E>(x); x += dppf<0x141>(x); return x; }
__device__ __forceinline__ float allreduce16(float x) { x = allreduce8(x); x += dppf<0x140>(x); return x; }
__device__ __forceinline__ float wave_sum(float x) {
    x = allreduce16(x);
    const int xi = __float_as_int(x);
    const float r0 = __int_as_float(__builtin_amdgcn_readlane(xi, 0)), r1 = __int_as_float(__builtin_amdgcn_readlane(xi, 16));
    const float r2 = __int_as_float(__builtin_amdgcn_readlane(xi, 32)), r3 = __int_as_float(__builtin_amdgcn_readlane(xi, 48));
    return (r0 + r1) + (r2 + r3);
}

namespace pg8 {
constexpr int BM = 256, BK = 64, HALF = 128, HTB = HALF * BK * 2, STAGE_BYTES = 8 * HTB, NXCD = 8, WGM = 8;
__host__ __device__ __forceinline__ int lds_byte(int r, int c) { const int st = (r >> 4) * 2 + (c >> 5), rr = r & 15, cc = c & 31, ob = rr * 64 + cc * 2; return st * 1024 + (ob ^ (((ob >> 9) & 1) << 5)); }
__host__ __device__ __forceinline__ void stage_rc(int b, int& R, int& C) { const int st = b / 1024, sb = b % 1024, swz = sb ^ (((sb >> 9) & 1) << 5); R = (st >> 1) * 16 + swz / 64; C = (st & 1) * 32 + (swz % 64) / 2; }
__host__ __device__ __forceinline__ int perm32(int rho) { const int n = rho >> 4, i = rho & 15; return 8 * (i >> 2) + 4 * n + (i & 3); }
struct Unit { int pm, pn; };
struct Gemm { const bf16_t* A; const bf16_t* Bt; int M, N, K; };
struct StaticOrder {
    int nM, nN, nwg, G, c;
    __device__ void init(int M_, int N_, int G_, int c_) { nM = M_ / BM; nN = N_ / BM; nwg = nM * nN; G = G_; c = c_; }
    __device__ bool next(int i, Unit& u) const {
        const long Lx = (long)i * G + c; if (Lx >= nwg) return false;
        int wgid = (int)Lx; { const int q = nwg / NXCD, r = nwg % NXCD, xcd = wgid % NXCD, off = wgid / NXCD; wgid = (xcd < r ? xcd * (q + 1) : r * (q + 1) + (xcd - r) * q) + off; }
        const int nig = WGM * nN, gid = wgid / nig, fm = gid * WGM, gsz = (nM - fm) < WGM ? (nM - fm) : WGM;
        u.pm = fm + ((wgid % nig) % gsz); u.pn = (wgid % nig) / gsz; return true;
    }
};
struct EpiBf16 {
    bf16_t* O; int ldc; int mode; const float* cw; const float* cb; bf16_t* halo; LAS float* wlds;
    __device__ __forceinline__ void operator()(const f32x4 (&acc)[2][2][4][2], const Unit& u, int wr, int wc, int fr, int fq) const {
        if (mode == 0) {
            const int row0 = u.pm * BM + wr * 64 + fr; const int col0 = u.pn * BM + wc * 32 + 8 * fq;
#pragma unroll
            for (int ai = 0; ai < 2; ++ai)
#pragma unroll
                for (int m = 0; m < 4; ++m) { bf16_t* rowp = O + (size_t)(row0 + ai * HALF + m * 16) * ldc + col0;
#pragma unroll
                    for (int bj = 0; bj < 2; ++bj) { const f32x4 v0 = acc[ai][bj][m][0], v1 = acc[ai][bj][m][1];
                        u32x4 w; w.x = cvt_pk_bf16(v0[0], v0[1]); w.y = cvt_pk_bf16(v0[2], v0[3]); w.z = cvt_pk_bf16(v1[0], v1[1]); w.w = cvt_pk_bf16(v1[2], v1[3]);
                        *(u32x4*)(rowp + bj * HALF) = w; } }
            return;
        }
        const int ch0 = u.pn * 128 + wc * 32 + 8 * fq;
        const bool l15 = (fr == 15), l14 = (fr >= 14);
        LAS float* wsc = wlds + ((wr * 4 + wc) * 4 + fq) * 32;
        {
            f32x4 t[8];
#pragma unroll
            for (int j = 0; j < 3; ++j) { t[j] = *(const f32x4*)(cw + j * DFF2 + ch0 + 4); t[3 + j] = *(const f32x4*)(cw + j * DFF2 + DFF + ch0 + 4); }
            t[6] = *(const f32x4*)(cb + ch0 + 4); t[7] = *(const f32x4*)(cb + DFF + ch0 + 4);
#pragma unroll
            for (int j = 0; j < 8; ++j) *(LAS f32x4*)(wsc + 4 * j) = t[j];
        }
#pragma unroll
        for (int n = 0; n < 2; ++n) {
            float wg[3][4], wv[3][4], bg[4], bv[4];
            if (n == 0) {
#pragma unroll
                for (int j = 0; j < 3; ++j) {
                    const float4 a = *(const float4*)(cw + j * DFF2 + ch0), c = *(const float4*)(cw + j * DFF2 + DFF + ch0);
                    wg[j][0] = a.x; wg[j][1] = a.y; wg[j][2] = a.z; wg[j][3] = a.w; wv[j][0] = c.x; wv[j][1] = c.y; wv[j][2] = c.z; wv[j][3] = c.w;
                }
                const float4 a = *(const float4*)(cb + ch0), c = *(const float4*)(cb + DFF + ch0);
                bg[0] = a.x; bg[1] = a.y; bg[2] = a.z; bg[3] = a.w; bv[0] = c.x; bv[1] = c.y; bv[2] = c.z; bv[3] = c.w;
            } else {
#pragma unroll
                for (int j = 0; j < 3; ++j) {
                    const f32x4 a = *(const LAS f32x4*)(wsc + 4 * j), c = *(const LAS f32x4*)(wsc + 4 * (3 + j));
                    wg[j][0] = a[0]; wg[j][1] = a[1]; wg[j][2] = a[2]; wg[j][3] = a[3]; wv[j][0] = c[0]; wv[j][1] = c[1]; wv[j][2] = c[2]; wv[j][3] = c[3];
                }
                const f32x4 a = *(const LAS f32x4*)(wsc + 24), c = *(const LAS f32x4*)(wsc + 28);
                bg[0] = a[0]; bg[1] = a[1]; bg[2] = a[2]; bg[3] = a[3]; bv[0] = c[0]; bv[1] = c[1]; bv[2] = c[2]; bv[3] = c[3];
            }
#pragma unroll
            for (int ai = 0; ai < 2; ++ai)
#pragma unroll
                for (int m = 0; m < 4; ++m) {
                    const int r = u.pm * BM + ai * HALF + wr * 64 + m * 16 + fr; const int tb = r % L;
                    const bool k1 = (tb >= 1), k2 = (tb >= 2);
                    float o[4];
#pragma unroll
                    for (int e = 0; e < 4; ++e) {
                        const float g0 = acc[ai][0][m][n][e], v0 = acc[ai][1][m][n][e];
                        const float gm = (m > 0) ? acc[ai][0][m > 0 ? m - 1 : 0][n][e] : 0.f, vm = (m > 0) ? acc[ai][1][m > 0 ? m - 1 : 0][n][e] : 0.f;
                        float g1 = dppf<0x121>(l15 ? gm : g0), g2 = dppf<0x122>(l14 ? gm : g0), v1 = dppf<0x121>(l15 ? vm : v0), v2 = dppf<0x122>(l14 ? vm : v0);
                        g1 = k1 ? g1 : 0.f; v1 = k1 ? v1 : 0.f; g2 = k2 ? g2 : 0.f; v2 = k2 ? v2 : 0.f;
                        const float zg = fmaf(wg[0][e], g2, fmaf(wg[1][e], g1, fmaf(wg[2][e], g0, bg[e])));
                        const float zv = fmaf(wv[0][e], v2, fmaf(wv[1][e], v1, fmaf(wv[2][e], v0, bv[e])));
                        o[e] = siluf_(zg) * zv;
                    }
                    if (!(m == 0 && fr < 2)) {
                        u32x2 w; w.x = cvt_pk_bf16(o[0], o[1]); w.y = cvt_pk_bf16(o[2], o[3]);
                        *(u32x2*)(O + (size_t)r * ldc + ch0 + 4 * n) = w;
                    }
                }
        }
#pragma unroll
        for (int ai = 0; ai < 2; ++ai)
#pragma unroll
            for (int m = 0; m < 4; m += 3) {
                if ((m == 3 && fr >= 14) || (m == 0 && fr < 2)) {
                    const int r = u.pm * BM + ai * HALF + wr * 64 + m * 16 + fr;
                    const int slot = (m == 3) ? (fr - 14) : (2 + fr);
                    bf16_t* hp = halo + ((size_t)(r >> 6) * 4 + slot) * DFF2 + u.pn * 256 + wc * 32 + 8 * fq;
#pragma unroll
                    for (int bj = 0; bj < 2; ++bj) { const f32x4 a0 = acc[ai][bj][m][0], a1 = acc[ai][bj][m][1];
                        u32x4 w; w.x = cvt_pk_bf16(a0[0], a0[1]); w.y = cvt_pk_bf16(a0[2], a0[3]); w.z = cvt_pk_bf16(a1[0], a1[1]); w.w = cvt_pk_bf16(a1[2], a1[3]);
                        *(u32x4*)(hp + bj * 128) = w; }
                }
            }
    }
};

__device__ __forceinline__ void gemm_phase(LAS unsigned char* lds, const Gemm g, const StaticOrder& S, const EpiBf16& E) {
    const int tid = otid(), wid = __builtin_amdgcn_readfirstlane(tid >> 6), lane = tid & 63, wr = wid >> 2, wc = wid & 3, fr = lane & 15, fq = lane >> 4;
    const int K = g.K, nt = K / BK;
    unsigned voffA[2], voffB[2];
#pragma unroll
    for (int i = 0; i < 2; ++i) { int R, C; stage_rc(tid * 16 + i * 8192, R, C); const int Rb = (R & ~31) + perm32(R & 31);
        voffA[i] = (unsigned)(R * K + C) * 2u; voffB[i] = (unsigned)(Rb * K + C) * 2u; }
    const size_t kstep = (size_t)(BK * 2);
    const size_t hstep = (size_t)HALF * K * 2;
    const size_t tstep = 2 * hstep;
    const unsigned ldsw = (unsigned)wid * 1024u;
    const int aoff = lds_byte(wr * 64 + fr, fq * 8), boff = lds_byte(wc * 32 + fr, fq * 8);
#define PG8_SA(b, h) (((b) * 2 + (h)) * HTB)
#define PG8_SB(b, h) ((4 + (b) * 2 + (h)) * HTB)
#define PG8_STAGE(bufoff, gbase, voff) do { _Pragma("unroll") for (int _i = 0; _i < 2; ++_i) \
        __builtin_amdgcn_global_load_lds((const unsigned*)((const char*)(gbase) + (voff)[_i]), (LAS unsigned*)(lds + (bufoff) + ldsw + _i * 8192), 16, 0, 0); } while (0)
#define PG8_LDA(dst, b, h) do { _Pragma("unroll") for (int m = 0; m < 4; ++m) _Pragma("unroll") for (int k = 0; k < 2; ++k) dst[m][k] = *(const LAS bf16x8*)(lds + PG8_SA(b, h) + aoff + m * 2048 + k * 1024); } while (0)
#define PG8_LDB(dst, b, h) do { _Pragma("unroll") for (int n = 0; n < 2; ++n) _Pragma("unroll") for (int k = 0; k < 2; ++k) dst[n][k] = *(const LAS bf16x8*)(lds + PG8_SB(b, h) + boff + n * 2048 + k * 1024); } while (0)
#define PG8_MMA(ai, bj, At, Bt) do { __builtin_amdgcn_s_setprio(1); _Pragma("unroll") for (int m = 0; m < 4; ++m) _Pragma("unroll") for (int n = 0; n < 2; ++n) _Pragma("unroll") for (int k = 0; k < 2; ++k) \
        acc[ai][bj][m][n] = __builtin_amdgcn_mfma_f32_16x16x32_bf16(Bt[n][k], At[m][k], acc[ai][bj][m][n], 0, 0, 0); __builtin_amdgcn_s_setprio(0); } while (0)
#define PG8_WAIT_V(n) asm volatile("s_waitcnt vmcnt(" #n ")" ::: "memory")
#define PG8_WAIT_L(n) asm volatile("s_waitcnt lgkmcnt(" #n ")" ::: "memory")
#define PG8_BAR __builtin_amdgcn_s_barrier()
#define PG8_SCHED __builtin_amdgcn_sched_barrier(0)
    Unit cur, nxt; int ui = 0;
    if (!S.next(0, cur)) return;
    f32x4 acc[2][2][4][2];
#pragma unroll
    for (int a = 0; a < 2; ++a)
#pragma unroll
        for (int b = 0; b < 2; ++b)
#pragma unroll
            for (int m = 0; m < 4; ++m)
#pragma unroll
                for (int n = 0; n < 2; ++n) acc[a][b][m][n] = (f32x4){0.f, 0.f, 0.f, 0.f};
    bf16x8 At[4][2], B0[2][2], B1[2][2];
    const char* cA = (const char*)g.A + (size_t)cur.pm * tstep; const char* cB = (const char*)g.Bt + (size_t)cur.pn * tstep;
    PG8_STAGE(PG8_SB(0, 0), cB, voffB); PG8_STAGE(PG8_SA(0, 0), cA, voffA); PG8_STAGE(PG8_SB(0, 1), cB + hstep, voffB); PG8_STAGE(PG8_SA(0, 1), cA + hstep, voffA);
    if (wr == 1) PG8_BAR;
    PG8_WAIT_V(4); PG8_BAR;
    PG8_STAGE(PG8_SB(1, 0), cB + kstep, voffB); PG8_STAGE(PG8_SA(1, 0), cA + kstep, voffA); PG8_STAGE(PG8_SB(1, 1), cB + hstep + kstep, voffB);
    PG8_WAIT_V(6); PG8_BAR;
    for (;;) {
        const bool has_next = S.next(ui + 1, nxt);
        const char* nA = has_next ? (const char*)g.A + (size_t)nxt.pm * tstep : cA; const char* nB = has_next ? (const char*)g.Bt + (size_t)nxt.pn * tstep : cB;
        for (int t = 0; t < nt; t += 2) {
            const bool last = (t == nt - 2);
            const char* a1 = cA + (size_t)(t + 1) * kstep;
            const char* a2 = last ? nA : cA + (size_t)(t + 2) * kstep; const char* b2 = last ? nB : cB + (size_t)(t + 2) * kstep;
            const char* a3 = a2 + kstep; const char* b3 = b2 + kstep;
            PG8_LDB(B0, 0, 0); PG8_SCHED; PG8_LDA(At, 0, 0); PG8_STAGE(PG8_SA(1, 1), a1 + hstep, voffA);
            PG8_WAIT_L(8); PG8_BAR; PG8_WAIT_L(0); PG8_MMA(0, 0, At, B0); PG8_BAR; PG8_SCHED;
            PG8_LDB(B1, 0, 1); PG8_STAGE(PG8_SB(0, 0), b2, voffB);
            PG8_BAR; PG8_WAIT_L(0); PG8_MMA(0, 1, At, B1); PG8_BAR;
            PG8_LDA(At, 0, 1); PG8_STAGE(PG8_SA(0, 0), a2, voffA);
            PG8_BAR; PG8_WAIT_L(0); PG8_MMA(1, 0, At, B0); PG8_BAR; PG8_SCHED;
            PG8_STAGE(PG8_SB(0, 1), b2 + hstep, voffB);
            PG8_WAIT_V(6); PG8_BAR; PG8_MMA(1, 1, At, B1); PG8_BAR;
            PG8_LDB(B0, 1, 0); PG8_SCHED; PG8_LDA(At, 1, 0); PG8_STAGE(PG8_SA(0, 1), a2 + hstep, voffA);
            PG8_WAIT_L(8); PG8_BAR; PG8_WAIT_L(0); PG8_MMA(0, 0, At, B0); PG8_BAR; PG8_SCHED;
            PG8_LDB(B1, 1, 1); PG8_STAGE(PG8_SB(1, 0), b3, voffB);
            PG8_BAR; PG8_WAIT_L(0); PG8_MMA(0, 1, At, B1); PG8_BAR;
            PG8_LDA(At, 1, 1); PG8_STAGE(PG8_SA(1, 0), a3, voffA);
            PG8_BAR; PG8_WAIT_L(0); PG8_MMA(1, 0, At, B0); PG8_BAR; PG8_SCHED;
            PG8_STAGE(PG8_SB(1, 1), b3 + hstep, voffB);
            PG8_WAIT_V(6); PG8_BAR; PG8_MMA(1, 1, At, B1); PG8_BAR;
        }
        E(acc, cur, wr, wc, fr, fq);
        if (!has_next) break;
#pragma unroll
        for (int a = 0; a < 2; ++a)
#pragma unroll
            for (int b = 0; b < 2; ++b)
#pragma unroll
                for (int m = 0; m < 4; ++m)
#pragma unroll
                    for (int n = 0; n < 2; ++n) acc[a][b][m][n] = (f32x4){0.f, 0.f, 0.f, 0.f};
        cur = nxt; cA = nA; cB = nB; ++ui;
    }
    PG8_WAIT_V(0);
    if (wr == 0) PG8_BAR;
    PG8_BAR;
#undef PG8_SA
#undef PG8_SB
#undef PG8_STAGE
#undef PG8_LDA
#undef PG8_LDB
#undef PG8_MMA
#undef PG8_WAIT_V
#undef PG8_WAIT_L
#undef PG8_BAR
#undef PG8_SCHED
}
}

__device__ __noinline__ void transpose_job(float* tile  , const float* __restrict__ src, bf16_t* __restrict__ dst, int K, int N, int Npad, int glu) {
    const int tid = otid();
    const int tk = K / 64, tn = Npad / 64, ntiles = tk * tn;
    const int kkA = tid >> 4, n4 = (tid & 15) * 4;
    float4 v[2];
    auto fetch = [&](int tl) {
        const int k0 = (tl % tk) * 64, n0 = (tl / tk) * 64;
#pragma unroll
        for (int it = 0; it < 2; ++it) { v[it] = make_float4(0.f, 0.f, 0.f, 0.f); if (n0 + n4 < N) v[it] = *(const float4*)(src + (size_t)(k0 + kkA + it * 32) * N + n0 + n4); }
    };
    int tl = obid();
    if (tl < ntiles) fetch(tl);
    while (tl < ntiles) {
        const int k0 = (tl % tk) * 64, n0 = (tl / tk) * 64;
        __syncthreads();
#pragma unroll
        for (int it = 0; it < 2; ++it) { float* tp = tile + (kkA + it * 32) * 65 + n4; tp[0] = v[it].x; tp[1] = v[it].y; tp[2] = v[it].z; tp[3] = v[it].w; }
        const int nxt = tl + (int)gridDim.x;
        if (nxt < ntiles) fetch(nxt);
        __syncthreads();
        const int nn = tid >> 3, k8 = (tid & 7) * 8;
        float e[8];
#pragma unroll
        for (int j = 0; j < 8; ++j) e[j] = tile[(k8 + j) * 65 + nn];
        u32x4 w; w.x = cvt_pk_bf16(e[0], e[1]); w.y = cvt_pk_bf16(e[2], e[3]); w.z = cvt_pk_bf16(e[4], e[5]); w.w = cvt_pk_bf16(e[6], e[7]);
        const int r0 = !glu ? n0 : (n0 < DFF ? (n0 >> 7) * 256 + (n0 & 127) : ((n0 - DFF) >> 7) * 256 + 128 + ((n0 - DFF) & 127));
        *(u32x4*)(dst + (size_t)(r0 + nn) * K + k0 + k8) = w;
        tl = nxt;
    }
}

__device__ void norm_phase(const Params& p, int mode, const bf16_t* msrc, const float* __restrict__ gA, const float* __restrict__ gB, bf16_t* udst, int row_lo, int row_hi, int blk_skip) {
    bf16_t* H = (bf16_t*)(p.ws + WS_H);
    const int tid_ = otid(); const int lane = tid_ & 63, w = tid_ >> 6;
    const int nw = ((int)gridDim.x - blk_skip) * 8; const int bid_ = obid() - blk_skip;
    if (bid_ < 0) return;
    float4 ga[4], gb[4];
#pragma unroll
    for (int i = 0; i < 4; ++i) { ga[i] = (mode != 0) ? *(const float4*)(gA + i * 256 + lane * 4) : make_float4(0.f, 0.f, 0.f, 0.f); gb[i] = (mode != 2) ? *(const float4*)(gB + i * 256 + lane * 4) : make_float4(0.f, 0.f, 0.f, 0.f); }
    float4 xr[4]; u32x2 hr[4], mr[4];
    auto fetch = [&](int row) {
        if (mode == 0) {
            const int b = row / L, t = row - b * L;
            const float* src = (t < NMETA) ? (p.in[1] + (size_t)t * D) : (p.in[0] + ((size_t)b * SEQ + (t - NMETA)) * D);
#pragma unroll
            for (int i = 0; i < 4; ++i) xr[i] = *(const float4*)(src + i * 256 + lane * 4);
        } else {
#pragma unroll
            for (int i = 0; i < 4; ++i) { hr[i] = *(const u32x2*)(H + (size_t)row * D + i * 256 + lane * 4); mr[i] = *(const u32x2*)(msrc + (size_t)row * D + i * 256 + lane * 4); }
        }
    };
    int row = row_lo + bid_ * 8 + w;
    if (row < row_hi) fetch(row);
    while (row < row_hi) {
        const int b = row / L, t = row - b * L;
        float4 hv[4];
        float mv[4][4]; float ssm = 0.f;
        if (mode == 0) {
#pragma unroll
            for (int i = 0; i < 4; ++i) hv[i] = xr[i];
        } else {
#pragma unroll
            for (int i = 0; i < 4; ++i) {
                hv[i] = make_float4(__uint_as_float(hr[i].x << 16), __uint_as_float(hr[i].x & 0xffff0000u), __uint_as_float(hr[i].y << 16), __uint_as_float(hr[i].y & 0xffff0000u));
                mv[i][0] = __uint_as_float(mr[i].x << 16); mv[i][1] = __uint_as_float(mr[i].x & 0xffff0000u); mv[i][2] = __uint_as_float(mr[i].y << 16); mv[i][3] = __uint_as_float(mr[i].y & 0xffff0000u);
                ssm += mv[i][0] * mv[i][0] + mv[i][1] * mv[i][1] + mv[i][2] * mv[i][2] + mv[i][3] * mv[i][3];
            }
        }
        const int nxt = row + nw;
        if (nxt < row_hi) fetch(nxt);
        if (mode != 0) {
            ssm = wave_sum(ssm);
            const float rs = rsqrtf(ssm * (1.0f / D) + EPS);
#pragma unroll
            for (int i = 0; i < 4; ++i) { hv[i].x += mv[i][0] * rs * ga[i].x; hv[i].y += mv[i][1] * rs * ga[i].y; hv[i].z += mv[i][2] * rs * ga[i].z; hv[i].w += mv[i][3] * rs * ga[i].w; }
        }
        if (mode == 2) {
            if (t >= NMETA) {
                float* o = p.out + ((size_t)b * SEQ + (t - NMETA)) * D;
#pragma unroll
                for (int i = 0; i < 4; ++i) *(float4*)(o + i * 256 + lane * 4) = hv[i];
            }
        } else {
            float ss = 0.f;
#pragma unroll
            for (int i = 0; i < 4; ++i) {
                { u32x2 hw; hw.x = cvt_pk_bf16(hv[i].x, hv[i].y); hw.y = cvt_pk_bf16(hv[i].z, hv[i].w); *(u32x2*)(H + (size_t)row * D + i * 256 + lane * 4) = hw; }
                ss += hv[i].x * hv[i].x + hv[i].y * hv[i].y + hv[i].z * hv[i].z + hv[i].w * hv[i].w;
            }
            ss = wave_sum(ss);
            const float rs = rsqrtf(ss * (1.0f / D) + EPS);
#pragma unroll
            for (int i = 0; i < 4; ++i) {
                u32x2 o; o.x = cvt_pk_bf16(hv[i].x * rs * gb[i].x, hv[i].y * rs * gb[i].y); o.y = cvt_pk_bf16(hv[i].z * rs * gb[i].z, hv[i].w * rs * gb[i].w);
                *(u32x2*)(udst + (size_t)row * D + i * 256 + lane * 4) = o;
            }
        }
        row = nxt;
    }
}

constexpr size_t BIG_HALO = (size_t)M * DFF * 2;
static_assert(BIG_HALO + (size_t)(M / 64) * 4 * DFF2 * 2 <= BIG_BYTES, "activation + halo fit");
__device__ void ffn_fixup_phase(const Params& p, int layer) {
    bf16_t* act = (bf16_t*)(p.ws + WS_BIG);
    const bf16_t* halo = (const bf16_t*)(p.ws + WS_BIG + BIG_HALO);
    const float* cw = p.in[25] + (size_t)layer * 3 * DFF2;
    const float* cb = p.in[26] + (size_t)layer * DFF2;
    constexpr int NCG = DFF / 8, NBLK = M / 64;
    const int nitems = NCG * NBLK;
    for (int item = obid() * 512 + otid(); item < nitems; item += gridDim.x * 512) {
        const int cgp = item % NCG, blk = item / NCG;
        const int c0 = cgp * 8;
        const int gcol = (c0 >> 7) * 256 + (c0 & 127);
        float wg[3][8], wv[3][8], bg[8], bv[8];
#pragma unroll
        for (int j = 0; j < 3; ++j)
#pragma unroll
            for (int e = 0; e < 8; ++e) { wg[j][e] = cw[j * DFF2 + c0 + e]; wv[j][e] = cw[j * DFF2 + DFF + c0 + e]; }
#pragma unroll
        for (int e = 0; e < 8; ++e) { bg[e] = cb[c0 + e]; bv[e] = cb[DFF + c0 + e]; }
        auto ldrow = [&](int bk, int slot, float (&g)[8], float (&v)[8]) {
            const bf16_t* hp = halo + ((size_t)bk * 4 + slot) * DFF2 + gcol;
            const u32x4 a = *(const u32x4*)hp, c = *(const u32x4*)(hp + 128);
#pragma unroll
            for (int e = 0; e < 4; ++e) { g[2 * e] = __uint_as_float(a[e] << 16); g[2 * e + 1] = __uint_as_float(a[e] & 0xffff0000u); v[2 * e] = __uint_as_float(c[e] << 16); v[2 * e + 1] = __uint_as_float(c[e] & 0xffff0000u); }
        };
        float gz[4][8], vz[4][8];
#pragma unroll
        for (int e = 0; e < 8; ++e) { gz[0][e] = 0.f; gz[1][e] = 0.f; vz[0][e] = 0.f; vz[1][e] = 0.f; }
        if (blk > 0) { ldrow(blk - 1, 0, gz[0], vz[0]); ldrow(blk - 1, 1, gz[1], vz[1]); }
        ldrow(blk, 2, gz[2], vz[2]); ldrow(blk, 3, gz[3], vz[3]);
#pragma unroll
        for (int q = 0; q < 2; ++q) {
            const int r = blk * 64 + q; const int tb = r % L;
            const float k1 = (tb >= 1) ? 1.f : 0.f, k2 = (tb >= 2) ? 1.f : 0.f;
            float o[8];
#pragma unroll
            for (int e = 0; e < 8; ++e) {
                const float zg = wg[0][e] * (k2 * gz[q][e]) + wg[1][e] * (k1 * gz[q + 1][e]) + wg[2][e] * gz[q + 2][e] + bg[e];
                const float zv = wv[0][e] * (k2 * vz[q][e]) + wv[1][e] * (k1 * vz[q + 1][e]) + wv[2][e] * vz[q + 2][e] + bv[e];
                o[e] = siluf_(zg) * zv;
            }
            u32x4 w; w.x = cvt_pk_bf16(o[0], o[1]); w.y = cvt_pk_bf16(o[2], o[3]); w.z = cvt_pk_bf16(o[4], o[5]); w.w = cvt_pk_bf16(o[6], o[7]);
            *(u32x4*)(act + (size_t)r * DFF + c0) = w;
        }
    }
}

constexpr int TCH = 32;
template <int PPR, int NROW, int NLD, int NT = 512, class ColFn>
__device__ __forceinline__ void raw_fetch(u32x4 (&reg)[NLD], const bf16_t* P, int tid, size_t brow, int tfirst, ColFn col) {
#pragma unroll
    for (int i = 0; i < NLD; ++i) {
        int idx = tid + i * NT;
        asm volatile("" : "+v"(idx));
        u32x4 v = {0u, 0u, 0u, 0u};
        if (idx < NROW * PPR) { const int r = idx / PPR, pc = idx - r * PPR; const int t = tfirst + r;
            if (t >= 0 && t < L) v = *(const u32x4*)(P + (brow + t) * PW + col(pc)); }
        reg[i] = v;
    }
}
template <int PPR, int NROW, int NLD, int NT = 512>
__device__ __forceinline__ void raw_store(const u32x4 (&reg)[NLD], bf16_t* raw, int tid) {
#pragma unroll
    for (int i = 0; i < NLD; ++i) { const int idx = tid + i * NT; if (idx < NROW * PPR) *(u32x4*)(raw + (size_t)idx * 8) = reg[i]; }
}

template <bool HG>
__device__ __forceinline__ void even_item(const Params& p, float* lds, int b, int h) {
    const bf16_t* P = (const bf16_t*)(p.ws + WS_BIG);
    bf16_t* Y = (bf16_t*)(p.ws + WS_A1);
    constexpr int QP = 136;
    float* O = lds; float* Gt = O + TCH * 128; float* PC = Gt + TCH * 128;
    bf16_t* Qt = (bf16_t*)(PC + 256); bf16_t* Kt = Qt + TCH * QP;
    bf16_t* KhT = Kt + TCH * QP; bf16_t* VT = KhT + 2 * 128 * 16;
    bf16_t* raw = VT + 2 * 128 * 16;
    constexpr int PPR = 64, NROW = 32, NLD = 4, RP = 512;
    const int tid = otid(), lane = tid & 63, w = tid >> 6;
    const int fn = lane & 15, g = lane >> 4, vs = w * 16;
    const int cbase = (HG ? 2048 : 0) + h * 128;
    auto col = [&](int pc) { return cbase + (pc >> 4) * 512 + (pc & 15) * 8; };
    const size_t brow = (size_t)b * L;
    const float gamma = 1.0f - exp2f(-5.0f - (float)h);
    const int d_ = tid & 127, c2_ = (tid >> 7) & 1, hf_ = tid >> 8;
    float lbv = 0.f; float2 hgn = make_float2(0.f, 0.f);
    if (HG) {
        const float* lg = p.in[5]; const int c = h * 128 + d_;
        const float l0 = lg[c], l1 = lg[512 + c], l2 = lg[1024 + c]; const float mx = fmaxf(l0, fmaxf(l1, l2));
        const float e0 = __expf(l0 - mx), e1 = __expf(l1 - mx), e2 = __expf(l2 - mx); lbv = e0 / (e0 + e1 + e2);
        hgn = *(const float2*)(p.in[6] + h * 128 + 2 * lane);
    }
    const float rinv = exp2f(-(float)(d_ & 63) * 0.20762050593046f) * 0.15915494309189535f;
    f32x4 S[8];
#pragma unroll
    for (int T = 0; T < 8; ++T) S[T] = (f32x4){0.f, 0.f, 0.f, 0.f};
    u32x4 rg[NLD];
    __syncthreads();
    raw_fetch<PPR, NROW, NLD>(rg, P, tid, brow, 0, col); raw_store<PPR, NROW, NLD>(rg, raw, tid);
    for (int t0 = 0; t0 < L; t0 += TCH) {
        const int ns = (L - t0) < TCH ? (L - t0) : TCH;
        const bool more = (t0 + TCH < L);
        __syncthreads();
        if (more) raw_fetch<PPR, NROW, NLD>(rg, P, tid, brow, t0 + TCH, col);
        if (hf_ == 0) {
            float Pc = 1.0f; float kt[16];
#pragma unroll
            for (int i = 0; i < 16; ++i) {
                const int t = c2_ * 16 + i; const bf16_t* rr = raw + t * RP;
                float q, k, f;
                if (!HG) {
                    const int dd = d_ & 63;
                    float r = (float)(t0 + t) * rinv; r -= floorf(r);
                    const float sn = __builtin_amdgcn_sinf(r), cs = __builtin_amdgcn_cosf(r);
                    const float q1 = bf2f(rr[dd]), q2 = bf2f(rr[64 + dd]), k1 = bf2f(rr[128 + dd]), k2 = bf2f(rr[192 + dd]);
                    q = (d_ < 64) ? (q1 * cs - q2 * sn) : (q1 * sn + q2 * cs);
                    k = ((d_ < 64) ? (k1 * cs - k2 * sn) : (k1 * sn + k2 * cs)) * 0.08838834764831845f;
                    f = gamma;
                } else {
                    q = bf2f(rr[d_]); const float sg = sigmoidf_(bf2f(rr[128 + d_]));
                    f = lbv + (1.0f - lbv) * sg; k = (1.0f - lbv) * (1.0f - sg);
                }
                Pc *= f;
                Qt[t * QP + d_] = f2bf(q * Pc);
                kt[i] = k * __builtin_amdgcn_rcpf(Pc);
                Kt[t * QP + d_] = f2bf(kt[i]);
            }
            PC[c2_ * 128 + d_] = Pc;
            u32x4 u0, u1;
            u0.x = cvt_pk_bf16(kt[0] * Pc, kt[1] * Pc); u0.y = cvt_pk_bf16(kt[2] * Pc, kt[3] * Pc); u0.z = cvt_pk_bf16(kt[4] * Pc, kt[5] * Pc); u0.w = cvt_pk_bf16(kt[6] * Pc, kt[7] * Pc);
            u1.x = cvt_pk_bf16(kt[8] * Pc, kt[9] * Pc); u1.y = cvt_pk_bf16(kt[10] * Pc, kt[11] * Pc); u1.z = cvt_pk_bf16(kt[12] * Pc, kt[13] * Pc); u1.w = cvt_pk_bf16(kt[14] * Pc, kt[15] * Pc);
            *(u32x4*)(KhT + (c2_ * 128 + d_) * 16) = u0; *(u32x4*)(KhT + (c2_ * 128 + d_) * 16 + 8) = u1;
        } else {
            float vv[16];
#pragma unroll
            for (int i = 0; i < 16; ++i) {
                const int t = c2_ * 16 + i; const bf16_t* rr = raw + t * RP;
                vv[i] = bf2f(rr[256 + d_]);
                Gt[t * 128 + d_] = siluf_(bf2f(rr[384 + d_]));
            }
            u32x4 u0, u1;
            u0.x = cvt_pk_bf16(vv[0], vv[1]); u0.y = cvt_pk_bf16(vv[2], vv[3]); u0.z = cvt_pk_bf16(vv[4], vv[5]); u0.w = cvt_pk_bf16(vv[6], vv[7]);
            u1.x = cvt_pk_bf16(vv[8], vv[9]); u1.y = cvt_pk_bf16(vv[10], vv[11]); u1.z = cvt_pk_bf16(vv[12], vv[13]); u1.w = cvt_pk_bf16(vv[14], vv[15]);
            *(u32x4*)(VT + (c2_ * 128 + d_) * 16) = u0; *(u32x4*)(VT + (c2_ * 128 + d_) * 16 + 8) = u1;
        }
        __syncthreads();
        for (int c2 = 0; c2 < 2; ++c2) {
            if (c2 * 16 >= ns) break;
            const bf16_t* qrow = Qt + (c2 * 16 + fn) * QP; const bf16_t* krow = Kt + (c2 * 16 + fn) * QP;
            f32x4 at4 = {0.f, 0.f, 0.f, 0.f};
#pragma unroll
            for (int ks = 0; ks < 4; ++ks) at4 = __builtin_amdgcn_mfma_f32_16x16x32_bf16(*(const bf16x8*)(krow + ks * 32 + g * 8), *(const bf16x8*)(qrow + ks * 32 + g * 8), at4, 0, 0, 0);
            u32x4 ua; ua.x = cvt_pk_bf16((4 * g + 0 <= fn) ? at4[0] : 0.f, (4 * g + 1 <= fn) ? at4[1] : 0.f); ua.y = cvt_pk_bf16((4 * g + 2 <= fn) ? at4[2] : 0.f, (4 * g + 3 <= fn) ? at4[3] : 0.f); ua.z = 0u; ua.w = 0u;
            const u32x2 vlo = *(const u32x2*)(VT + (c2 * 128 + vs + fn) * 16 + 4 * g);
            u32x4 uv; uv.x = vlo.x; uv.y = vlo.y; uv.z = 0u; uv.w = 0u;
            const bf16x8 vb = __builtin_bit_cast(bf16x8, uv);
            f32x4 oacc = __builtin_amdgcn_mfma_f32_16x16x32_bf16(__builtin_bit_cast(bf16x8, ua), vb, (f32x4){0.f, 0.f, 0.f, 0.f}, 0, 0, 0);
#pragma unroll
            for (int ks = 0; ks < 4; ++ks) {
                const u32x2 qa = *(const u32x2*)(qrow + (2 * ks) * 16 + 4 * g), qb = *(const u32x2*)(qrow + (2 * ks + 1) * 16 + 4 * g);
                u32x4 uq; uq.x = qa.x; uq.y = qa.y; uq.z = qb.x; uq.w = qb.y;
                u32x4 us; us.x = cvt_pk_bf16(S[2 * ks][0], S[2 * ks][1]); us.y = cvt_pk_bf16(S[2 * ks][2], S[2 * ks][3]); us.z = cvt_pk_bf16(S[2 * ks + 1][0], S[2 * ks + 1][1]); us.w = cvt_pk_bf16(S[2 * ks + 1][2], S[2 * ks + 1][3]);
                oacc = __builtin_amdgcn_mfma_f32_16x16x32_bf16(__builtin_bit_cast(bf16x8, uq), __builtin_bit_cast(bf16x8, us), oacc, 0, 0, 0);
            }
#pragma unroll
            for (int jj = 0; jj < 4; ++jj) O[(c2 * 16 + 4 * g + jj) * 128 + vs + fn] = oacc[jj];
#pragma unroll
            for (int T = 0; T < 8; ++T) {
                const float4 pc4 = *(const float4*)(PC + c2 * 128 + T * 16 + 4 * g);
                const u32x2 kh = *(const u32x2*)(KhT + (c2 * 128 + T * 16 + fn) * 16 + 4 * g);
                u32x4 uk; uk.x = kh.x; uk.y = kh.y; uk.z = 0u; uk.w = 0u;
                f32x4 sc = S[T]; sc[0] *= pc4.x; sc[1] *= pc4.y; sc[2] *= pc4.z; sc[3] *= pc4.w;
                S[T] = __builtin_amdgcn_mfma_f32_16x16x32_bf16(__builtin_bit_cast(bf16x8, uk), vb, sc, 0, 0, 0);
            }
        }
        if (more) raw_store<PPR, NROW, NLD>(rg, raw, tid);
        __syncthreads();
        for (int t = w; t < ns; t += 8) {
            const size_t row = brow + t0 + t;
            const float2 o2 = *(const float2*)(O + t * 128 + lane * 2);
            const float2 g2 = *(const float2*)(Gt + t * 128 + lane * 2);
            const int v = lane * 2;
            if (!HG) {
                const float mean = wave_sum(o2.x + o2.y) * (1.0f / 128.0f);
                const float x0 = o2.x - mean, x1 = o2.y - mean;
                const float var = wave_sum(x0 * x0 + x1 * x1) * (1.0f / 128.0f);
                const float rs = rsqrtf(var + EPS);
                *(unsigned*)(Y + row * D + h * 128 + v) = cvt_pk_bf16(x0 * rs * g2.x, x1 * rs * g2.y);
            } else {
                const float ms = wave_sum(o2.x * o2.x + o2.y * o2.y) * (1.0f / 128.0f);
                const float rs = rsqrtf(ms + EPS);
                *(unsigned*)(Y + row * D + 512 + h * 128 + v) = cvt_pk_bf16(o2.x * rs * hgn.x * g2.x, o2.y * rs * hgn.y * g2.y);
            }
        }
    }
}
__device__ __forceinline__ void even_scan_phase(const Params& p, float* lds) {
    for (int item = obid(); item < 256; item += gridDim.x) {
        const int idx = item & 127, b = idx >> 2, h = idx & 3;
        if (item < 128) even_item<false>(p, lds, b, h); else even_item<true>(p, lds, b, h);
        __syncthreads();
    }
}

typedef float f32x2 __attribute__((ext_vector_type(2)));
constexpr int TCR = 16;
constexpr int RW_ITEM_FLOATS = 16256;
__device__ __forceinline__ void rwkv_half(const Params& p, float* lds, int b, int h, int half) {
    const bf16_t* P = (const bf16_t*)(p.ws + WS_BIG);
    bf16_t* Y = (bf16_t*)(p.ws + WS_Y2);
    float* R = lds; float* W = R + TCR * 64; float* Kk = W + TCR * 64; float* Vv = Kk + TCR * 64; float* A = Vv + TCR * 64; float* Bb = A + TCR * 64;
    float* O = Bb + TCR * 64; float* G = O + TCR * 64; float* RK = G + TCR * 64; float* WP = RK + 64; float* AP = WP + TCR * 64;
    constexpr int LAP = 264;
    bf16_t* LAb = (bf16_t*)(AP + TCR * 64);
    bf16_t* LAbS = (bf16_t*)((lds - half * RW_ITEM_FLOATS) + (8 * TCR * 64 + 64 + 2 * TCR * 64));
    bf16_t* raw = LAb + TCR * LAP;
    constexpr int PPR = 56, NROW = 17, NLD = 4, RP = 448;
    const float* mu = p.in[9]; const float* w2 = p.in[11]; const float* a2 = p.in[13]; const float* g2 = p.in[14];
    const int tid = otid() & 255, lane = tid & 63, lw = tid >> 6;
    const int kg = lane & 7, vp = lw * 8 + (lane >> 3);
    const int hc = h * 64 + lane;
    auto col = [&](int pc) { return pc < 24 ? (pc >> 3) * 512 + h * 64 + (pc & 7) * 8 : 1536 + (pc - 24) * 8; };
    const size_t brow = (size_t)b * L;
    const int j1 = tid; const float mu1 = mu[1536 + j1];
    const int tq = tid >> 4, cl = tid & 15, hc4 = h * 64 + 4 * cl;
    const float4 mu_r = *(const float4*)(mu + hc4), mu_k = *(const float4*)(mu + 512 + hc4), mu_v = *(const float4*)(mu + 1024 + hc4);
    const float4 w0c = *(const float4*)(p.in[10] + hc4), a0c = *(const float4*)(p.in[12] + hc4), kksc = *(const float4*)(p.in[15] + hc4), kasc = *(const float4*)(p.in[16] + hc4);
    const float4 rkc = *(const float4*)(p.in[17] + hc4), lnwc = *(const float4*)(p.in[18] + hc4), lnbc = *(const float4*)(p.in[19] + hc4);
    f32x2 S[8];
#pragma unroll
    for (int i = 0; i < 8; ++i) S[i] = (f32x2){0.f, 0.f};
    const int fn = lane & 15, fkq = lane >> 4;
    bf16x8 bw[2], ba[2], bg[4];
    {
        const int cc = h * 64 + lw * 16 + fn;
#pragma unroll
        for (int ks = 0; ks < 2; ++ks) {
            float e[8], f[8];
#pragma unroll
            for (int j = 0; j < 8; ++j) { e[j] = w2[(ks * 32 + fkq * 8 + j) * 512 + cc]; f[j] = a2[(ks * 32 + fkq * 8 + j) * 512 + cc]; }
            u32x4 u; u.x = cvt_pk_bf16(e[0], e[1]); u.y = cvt_pk_bf16(e[2], e[3]); u.z = cvt_pk_bf16(e[4], e[5]); u.w = cvt_pk_bf16(e[6], e[7]); bw[ks] = __builtin_bit_cast(bf16x8, u);
            u.x = cvt_pk_bf16(f[0], f[1]); u.y = cvt_pk_bf16(f[2], f[3]); u.z = cvt_pk_bf16(f[4], f[5]); u.w = cvt_pk_bf16(f[6], f[7]); ba[ks] = __builtin_bit_cast(bf16x8, u);
        }
#pragma unroll
        for (int ks = 0; ks < 4; ++ks) {
            float e[8];
#pragma unroll
            for (int j = 0; j < 8; ++j) e[j] = g2[(ks * 32 + fkq * 8 + j) * 512 + cc];
            u32x4 u; u.x = cvt_pk_bf16(e[0], e[1]); u.y = cvt_pk_bf16(e[2], e[3]); u.z = cvt_pk_bf16(e[4], e[5]); u.w = cvt_pk_bf16(e[6], e[7]); bg[ks] = __builtin_bit_cast(bf16x8, u);
        }
    }
    u32x4 rg[NLD];
    __syncthreads();
    raw_fetch<PPR, NROW, NLD, 256>(rg, P, tid, brow, -1, col); raw_store<PPR, NROW, NLD, 256>(rg, raw, tid);
    for (int t0 = 0; t0 < L; t0 += TCR) {
        const bool more = (t0 + TCR < L);
        if (t0 == 0) __syncthreads();
#pragma unroll 4
        for (int t = half * 8; t < half * 8 + 8; ++t) {
            const float cur = bf2f(raw[(t + 1) * RP + 192 + j1]), prev = bf2f(raw[t * RP + 192 + j1]);
            const float x = cur + (prev - cur) * mu1;
            float y;
            if (j1 < 64) y = 1.0f - 2.0f * __builtin_amdgcn_rcpf(1.0f + __expf(2.0f * x)); else if (j1 < 128) y = x; else y = sigmoidf_(x);
            LAbS[t * LAP + j1] = f2bf(y);
        }
        __syncthreads();
        {
            const bf16_t* ap = LAbS + fn * LAP + fkq * 8;
            f32x4 cw4 = {0.f, 0.f, 0.f, 0.f}, ca4 = {0.f, 0.f, 0.f, 0.f}, cg4 = {0.f, 0.f, 0.f, 0.f};
#pragma unroll
            for (int ks = 0; ks < 2; ++ks) cw4 = __builtin_amdgcn_mfma_f32_16x16x32_bf16(*(const bf16x8*)(ap + ks * 32), bw[ks], cw4, 0, 0, 0);
#pragma unroll
            for (int ks = 0; ks < 2; ++ks) ca4 = __builtin_amdgcn_mfma_f32_16x16x32_bf16(*(const bf16x8*)(ap + 64 + ks * 32), ba[ks], ca4, 0, 0, 0);
#pragma unroll
            for (int ks = 0; ks < 4; ++ks) cg4 = __builtin_amdgcn_mfma_f32_16x16x32_bf16(*(const bf16x8*)(ap + 128 + ks * 32), bg[ks], cg4, 0, 0, 0);
#pragma unroll
            for (int j = 0; j < 4; ++j) { const int o = (fkq * 4 + j) * 64 + lw * 16 + fn; WP[o] = cw4[j]; AP[o] = ca4[j]; G[o] = cg4[j]; }
        }
        __syncthreads();
        {
            const int t = tq;
            const u32x2 c0 = *(const u32x2*)(raw + (t + 1) * RP + 4 * cl), c1 = *(const u32x2*)(raw + (t + 1) * RP + 64 + 4 * cl), c2v = *(const u32x2*)(raw + (t + 1) * RP + 128 + 4 * cl);
            const u32x2 p0 = *(const u32x2*)(raw + t * RP + 4 * cl), p1 = *(const u32x2*)(raw + t * RP + 64 + 4 * cl), p2 = *(const u32x2*)(raw + t * RP + 128 + 4 * cl);
            auto up4 = [](u32x2 u, float (&o)[4]) { o[0] = __uint_as_float(u.x << 16); o[1] = __uint_as_float(u.x & 0xffff0000u); o[2] = __uint_as_float(u.y << 16); o[3] = __uint_as_float(u.y & 0xffff0000u); };
            float cr[4], ck[4], cv[4], pr[4], pk[4], pv[4];
            up4(c0, cr); up4(c1, ck); up4(c2v, cv); up4(p0, pr); up4(p1, pk); up4(p2, pv);
            const float4 wp4 = *(const float4*)(WP + t * 64 + 4 * cl), ap4 = *(const float4*)(AP + t * 64 + 4 * cl);
            const float mur[4] = {mu_r.x, mu_r.y, mu_r.z, mu_r.w}, muk[4] = {mu_k.x, mu_k.y, mu_k.z, mu_k.w}, muv[4] = {mu_v.x, mu_v.y, mu_v.z, mu_v.w};
            const float w0a[4] = {w0c.x, w0c.y, w0c.z, w0c.w}, a0a[4] = {a0c.x, a0c.y, a0c.z, a0c.w}, kksa[4] = {kksc.x, kksc.y, kksc.z, kksc.w}, kasa[4] = {kasc.x, kasc.y, kasc.z, kasc.w}, rka[4] = {rkc.x, rkc.y, rkc.z, rkc.w};
            const float wpa[4] = {wp4.x, wp4.y, wp4.z, wp4.w}, apa[4] = {ap4.x, ap4.y, ap4.z, ap4.w};
            float rr[4], kr[4], vr[4], dec[4], av[4], kkr[4], kmod[4]; float ssq = 0.f, rks = 0.f;
#pragma unroll
            for (int e = 0; e < 4; ++e) {
                rr[e] = cr[e] + (pr[e] - cr[e]) * mur[e]; kr[e] = ck[e] + (pk[e] - ck[e]) * muk[e]; vr[e] = cv[e] + (pv[e] - cv[e]) * muv[e];
                const float lw_ = -softplusf_(-(w0a[e] + wpa[e])) - 0.5f;
                dec[e] = __expf(-__expf(lw_));
                av[e] = sigmoidf_(a0a[e] + apa[e]);
                kkr[e] = kr[e] * kksa[e]; ssq += kkr[e] * kkr[e];
                kmod[e] = kr[e] * (1.0f + (av[e] - 1.0f) * kasa[e]);
                rks += rr[e] * kmod[e] * rka[e];
            }
            ssq = allreduce16(ssq); rks = allreduce16(rks);
            const float rn = rsqrtf(ssq + EPS);
            *(float4*)(R + t * 64 + 4 * cl) = make_float4(rr[0], rr[1], rr[2], rr[3]);
            *(float4*)(W + t * 64 + 4 * cl) = make_float4(dec[0], dec[1], dec[2], dec[3]);
            *(float4*)(Kk + t * 64 + 4 * cl) = make_float4(kmod[0], kmod[1], kmod[2], kmod[3]);
            *(float4*)(Vv + t * 64 + 4 * cl) = make_float4(vr[0], vr[1], vr[2], vr[3]);
            *(float4*)(A + t * 64 + 4 * cl) = make_float4(-kkr[0] * rn, -kkr[1] * rn, -kkr[2] * rn, -kkr[3] * rn);
            *(float4*)(Bb + t * 64 + 4 * cl) = make_float4(kkr[0] * rn * av[0], kkr[1] * rn * av[1], kkr[2] * rn * av[2], kkr[3] * rn * av[3]);
            if (cl == 0) RK[t] = rks;
        }
        __syncthreads();
        if (more) raw_fetch<PPR, NROW, NLD, 256>(rg, P, tid, brow, t0 + TCR - 1, col);
        {
            struct Ops { float4 aa, ab, wa, wb, ba, bb, ka, kb, ra, rb; float2 vv; };
            auto ld = [&](Ops& o, int t) {
                o.aa = *(const float4*)(A + t * 64 + kg * 8); o.ab = *(const float4*)(A + t * 64 + kg * 8 + 4);
                o.wa = *(const float4*)(W + t * 64 + kg * 8); o.wb = *(const float4*)(W + t * 64 + kg * 8 + 4);
                o.ba = *(const float4*)(Bb + t * 64 + kg * 8); o.bb = *(const float4*)(Bb + t * 64 + kg * 8 + 4);
                o.ka = *(const float4*)(Kk + t * 64 + kg * 8); o.kb = *(const float4*)(Kk + t * 64 + kg * 8 + 4);
                o.ra = *(const float4*)(R + t * 64 + kg * 8); o.rb = *(const float4*)(R + t * 64 + kg * 8 + 4);
                o.vv = *(const float2*)(Vv + t * 64 + 2 * vp);
            };
            auto step = [&](const Ops& x, int t) {
                const float a8[8] = {x.aa.x, x.aa.y, x.aa.z, x.aa.w, x.ab.x, x.ab.y, x.ab.z, x.ab.w};
                const float w8[8] = {x.wa.x, x.wa.y, x.wa.z, x.wa.w, x.wb.x, x.wb.y, x.wb.z, x.wb.w};
                const float b8[8] = {x.ba.x, x.ba.y, x.ba.z, x.ba.w, x.bb.x, x.bb.y, x.bb.z, x.bb.w};
                const float k8[8] = {x.ka.x, x.ka.y, x.ka.z, x.ka.w, x.kb.x, x.kb.y, x.kb.z, x.kb.w};
                const float r8[8] = {x.ra.x, x.ra.y, x.ra.z, x.ra.w, x.rb.x, x.rb.y, x.rb.z, x.rb.w};
                const f32x2 vv2 = {x.vv.x, x.vv.y};
                f32x2 sa0 = {0.f, 0.f}, sa1 = {0.f, 0.f};
#pragma unroll
                for (int i = 0; i < 8; i += 2) { sa0 += S[i] * a8[i]; sa1 += S[i + 1] * a8[i + 1]; }
                f32x2 sa = sa0 + sa1; sa.x = allreduce8(sa.x); sa.y = allreduce8(sa.y);
                f32x2 y0 = {0.f, 0.f}, y1 = {0.f, 0.f};
#pragma unroll
                for (int i = 0; i < 8; i += 2) {
                    S[i] = S[i] * w8[i] + sa * b8[i] + vv2 * k8[i]; y0 += S[i] * r8[i];
                    S[i + 1] = S[i + 1] * w8[i + 1] + sa * b8[i + 1] + vv2 * k8[i + 1]; y1 += S[i + 1] * r8[i + 1];
                }
                f32x2 y = y0 + y1; y.x = allreduce8(y.x); y.y = allreduce8(y.y);
                if (kg == 0) *(float2*)(O + t * 64 + 2 * vp) = make_float2(y.x, y.y);
            };
            Ops A_, B_; ld(A_, 0);
#pragma unroll
            for (int t = 0; t < TCR; t += 2) {
                ld(B_, t + 1); step(A_, t);
                if (t + 2 < TCR) ld(A_, t + 2);
                step(B_, t + 1);
            }
        }
        if (more) raw_store<PPR, NROW, NLD, 256>(rg, raw, tid);
        __syncthreads();
        {
            const int t = tq; const size_t row = brow + t0 + t;
            const float4 y4 = *(const float4*)(O + t * 64 + 4 * cl), v4 = *(const float4*)(Vv + t * 64 + 4 * cl), g4 = *(const float4*)(G + t * 64 + 4 * cl);
            const float mean = allreduce16((y4.x + y4.y) + (y4.z + y4.w)) * (1.0f / 64.0f);
            const float x0 = y4.x - mean, x1 = y4.y - mean, x2 = y4.z - mean, x3 = y4.w - mean;
            const float var = allreduce16((x0 * x0 + x1 * x1) + (x2 * x2 + x3 * x3)) * (1.0f / 64.0f);
            const float rs = rsqrtf(var + 64e-5f), rkt = RK[t];
            const float o0 = (x0 * rs * lnwc.x + lnbc.x + rkt * v4.x) * g4.x, o1 = (x1 * rs * lnwc.y + lnbc.y + rkt * v4.y) * g4.y;
            const float o2 = (x2 * rs * lnwc.z + lnbc.z + rkt * v4.z) * g4.z, o3 = (x3 * rs * lnwc.w + lnbc.w + rkt * v4.w) * g4.w;
            u32x2 ow; ow.x = cvt_pk_bf16(o0, o1); ow.y = cvt_pk_bf16(o2, o3);
            *(u32x2*)(Y + row * D + hc4) = ow;
        }
    }
}
template <int CTRL> __device__ __forceinline__ float dpp0f(float x) { return __int_as_float(__builtin_amdgcn_update_dpp(0, __float_as_int(x), CTRL, 0xF, 0xF, true)); }
__device__ __forceinline__ void gdn_item(const Params& p, float* lds, int b, int h) {
    const bf16_t* P = (const bf16_t*)(p.ws + WS_BIG);
    bf16_t* Y = (bf16_t*)(p.ws + WS_Y2);
    constexpr int QP = 136, MP = 24;
    float* O = lds; float* Gt = O + TCH * 128; float* GB = Gt + TCH * 128; float* CG = GB + 64;
    bf16_t* MinvB = (bf16_t*)(CG + 64); bf16_t* MinvE = MinvB + 2 * 16 * MP;
    bf16_t* Qb = MinvE + 2 * 16 * MP; bf16_t* Kb = Qb + TCH * QP; bf16_t* Wb = Kb + TCH * QP;
    bf16_t* KT = Wb + TCH * QP; bf16_t* VT = KT + 2 * 128 * 16;
    bf16_t* raw = VT + 2 * 128 * 16;
    constexpr int PPR = 65, NROW = 35, NLD = 5, RP = 520;
    const float* cw = p.in[20];
    const int tid = otid(), lane = tid & 63, w = tid >> 6;
    const int fn = lane & 15, g = lane >> 4, vs = w * 16;
    auto col = [&](int pc) { return pc < 48 ? 1792 + (pc >> 4) * 512 + h * 128 + (pc & 15) * 8 : (pc < 64 ? 3328 + h * 128 + (pc - 48) * 8 : 3840); };
    const size_t brow = (size_t)b * L;
    const float Aneg = -__expf(p.in[21][h]); const float dtb = p.in[22][h];
    const float2 gn = *(const float2*)(p.in[23] + 2 * lane);
    float cwr[3][4][2];
#pragma unroll
    for (int x = 0; x < 3; ++x)
#pragma unroll
        for (int j = 0; j < 4; ++j) { cwr[x][j][0] = cw[j * 1536 + x * 512 + h * 128 + 2 * lane]; cwr[x][j][1] = cw[j * 1536 + x * 512 + h * 128 + 2 * lane + 1]; }
    f32x4 S[8];
#pragma unroll
    for (int T = 0; T < 8; ++T) S[T] = (f32x4){0.f, 0.f, 0.f, 0.f};
    u32x4 rg[NLD];
    __syncthreads();
    raw_fetch<PPR, NROW, NLD>(rg, P, tid, brow, -3, col); raw_store<PPR, NROW, NLD>(rg, raw, tid);
    for (int t0 = 0; t0 < L; t0 += TCH) {
        const int ns = (L - t0) < TCH ? (L - t0) : TCH;
        const bool more = (t0 + TCH < L);
        __syncthreads();
        if (more) raw_fetch<PPR, NROW, NLD>(rg, P, tid, brow, t0 + TCH - 3, col);
        for (int t = w; t < ns; t += 8) {
            float xs[3][2];
#pragma unroll
            for (int x = 0; x < 3; ++x) {
                float a0 = 0.f, a1 = 0.f;
#pragma unroll
                for (int j = 0; j < 4; ++j) {
                    const unsigned wv = *(const unsigned*)(raw + (t + j) * RP + x * 128 + 2 * lane);
                    a0 += cwr[x][j][0] * __uint_as_float(wv << 16); a1 += cwr[x][j][1] * __uint_as_float(wv & 0xffff0000u);
                }
                xs[x][0] = siluf_(a0); xs[x][1] = siluf_(a1);
            }
            const float sq = wave_sum(xs[0][0] * xs[0][0] + xs[0][1] * xs[0][1]);
            const float sk = wave_sum(xs[1][0] * xs[1][0] + xs[1][1] * xs[1][1]);
            const float rq = rsqrtf(sq + EPS) * 0.08838834764831845f, rk = rsqrtf(sk + EPS);
            const int c2 = t >> 4, i = t & 15;
            *(unsigned*)(Qb + t * QP + 2 * lane) = cvt_pk_bf16(xs[0][0] * rq, xs[0][1] * rq);
            const unsigned kw = cvt_pk_bf16(xs[1][0] * rk, xs[1][1] * rk);
            *(unsigned*)(Kb + t * QP + 2 * lane) = kw;
            KT[(c2 * 128 + 2 * lane) * 16 + i] = (bf16_t)(kw & 0xffffu); KT[(c2 * 128 + 2 * lane + 1) * 16 + i] = (bf16_t)(kw >> 16);
            const unsigned vw = cvt_pk_bf16(xs[2][0], xs[2][1]);
            VT[(c2 * 128 + 2 * lane) * 16 + i] = (bf16_t)(vw & 0xffffu); VT[(c2 * 128 + 2 * lane + 1) * 16 + i] = (bf16_t)(vw >> 16);
            const unsigned gw = *(const unsigned*)(raw + (t + 3) * RP + 384 + 2 * lane);
            *(float2*)(Gt + t * 128 + 2 * lane) = make_float2(siluf_(__uint_as_float(gw << 16)), siluf_(__uint_as_float(gw & 0xffff0000u)));
            if (lane == 0) {
                const float al = bf2f(raw[(t + 3) * RP + 512 + h]), be = bf2f(raw[(t + 3) * RP + 516 + h]);
                GB[t * 2] = Aneg * softplusf_(al + dtb); GB[t * 2 + 1] = sigmoidf_(be);
            }
        }
        __syncthreads();
        if (w < 2 && w * 16 < ns) {
            const int c2 = w;
            float cgf = GB[(c2 * 16 + fn) * 2]; const float betf = GB[(c2 * 16 + fn) * 2 + 1];
            cgf += dpp0f<0x111>(cgf); cgf += dpp0f<0x112>(cgf); cgf += dpp0f<0x114>(cgf); cgf += dpp0f<0x118>(cgf);
            if (g == 0) CG[c2 * 16 + fn] = cgf;
            const bf16_t* krow = Kb + (c2 * 16 + fn) * QP;
            f32x4 kk4 = {0.f, 0.f, 0.f, 0.f};
#pragma unroll
            for (int ks = 0; ks < 4; ++ks) { const bf16x8 kf = *(const bf16x8*)(krow + ks * 32 + g * 8); kk4 = __builtin_amdgcn_mfma_f32_16x16x32_bf16(kf, kf, kk4, 0, 0, 0); }
            const float4 cga = *(const float4*)(CG + c2 * 16 + 4 * g);
            const float cga4[4] = {cga.x, cga.y, cga.z, cga.w};
            float m4[4];
#pragma unroll
            for (int jj = 0; jj < 4; ++jj) { const float ba = GB[(c2 * 16 + 4 * g + jj) * 2 + 1]; m4[jj] = (fn < 4 * g + jj) ? ba * kk4[jj] * __expf(cga4[jj] - cgf) : 0.f; }
            float x[16];
#pragma unroll
            for (int i = 0; i < 16; ++i) {
                float acc = (fn == i) ? 1.f : 0.f;
#pragma unroll
                for (int j = 0; j < i; ++j) {
                    const float mij = __int_as_float(__builtin_amdgcn_readlane(__float_as_int(m4[i & 3]), j + 16 * (i >> 2)));
                    acc -= mij * x[j];
                }
                x[i] = acc;
            }
            if (g == 0) {
                const float eb = betf * __expf(cgf);
#pragma unroll
                for (int i = 0; i < 16; ++i) { MinvB[(c2 * 16 + i) * MP + fn] = f2bf(x[i] * betf); MinvE[(c2 * 16 + i) * MP + fn] = f2bf(x[i] * eb); }
            }
        }
        __syncthreads();
        for (int c2 = 0; c2 < 2; ++c2) {
            if (c2 * 16 >= ns) break;
            const u32x2 ma = *(const u32x2*)(MinvE + (c2 * 16 + fn) * MP + 4 * g); const u32x2 kt = *(const u32x2*)(KT + (c2 * 128 + vs + fn) * 16 + 4 * g);
            u32x4 ua; ua.x = ma.x; ua.y = ma.y; ua.z = 0u; ua.w = 0u; u32x4 ub; ub.x = kt.x; ub.y = kt.y; ub.z = 0u; ub.w = 0u;
            const f32x4 c4 = __builtin_amdgcn_mfma_f32_16x16x32_bf16(__builtin_bit_cast(bf16x8, ua), __builtin_bit_cast(bf16x8, ub), (f32x4){0.f, 0.f, 0.f, 0.f}, 0, 0, 0);
#pragma unroll
            for (int jj = 0; jj < 4; ++jj) Wb[(c2 * 16 + 4 * g + jj) * QP + vs + fn] = f2bf(c4[jj]);
        }
        __syncthreads();
        for (int c2 = 0; c2 < 2; ++c2) {
            if (c2 * 16 >= ns) break;
            const float4 cgt = *(const float4*)(CG + c2 * 16 + 4 * g); const float cgt4[4] = {cgt.x, cgt.y, cgt.z, cgt.w};
            const float cgf = CG[c2 * 16 + fn], cg15 = CG[c2 * 16 + 15];
            const bf16_t* qrow = Qb + (c2 * 16 + fn) * QP; const bf16_t* krow = Kb + (c2 * 16 + fn) * QP; const bf16_t* wrow = Wb + (c2 * 16 + fn) * QP;
            f32x4 at4 = {0.f, 0.f, 0.f, 0.f};
#pragma unroll
            for (int ks = 0; ks < 4; ++ks) at4 = __builtin_amdgcn_mfma_f32_16x16x32_bf16(*(const bf16x8*)(krow + ks * 32 + g * 8), *(const bf16x8*)(qrow + ks * 32 + g * 8), at4, 0, 0, 0);
            float qv[4];
#pragma unroll
            for (int jj = 0; jj < 4; ++jj) qv[jj] = (4 * g + jj <= fn) ? at4[jj] * __expf(cgf - cgt4[jj]) : 0.f;
            u32x4 uqk; uqk.x = cvt_pk_bf16(qv[0], qv[1]); uqk.y = cvt_pk_bf16(qv[2], qv[3]); uqk.z = 0u; uqk.w = 0u;
            const u32x2 mb = *(const u32x2*)(MinvB + (c2 * 16 + fn) * MP + 4 * g); const u32x2 vt = *(const u32x2*)(VT + (c2 * 128 + vs + fn) * 16 + 4 * g);
            u32x4 uma; uma.x = mb.x; uma.y = mb.y; uma.z = 0u; uma.w = 0u; u32x4 uvt; uvt.x = vt.x; uvt.y = vt.y; uvt.z = 0u; uvt.w = 0u;
            const f32x4 u4 = __builtin_amdgcn_mfma_f32_16x16x32_bf16(__builtin_bit_cast(bf16x8, uma), __builtin_bit_cast(bf16x8, uvt), (f32x4){0.f, 0.f, 0.f, 0.f}, 0, 0, 0);
            f32x4 ws4 = {0.f, 0.f, 0.f, 0.f}, qs4 = {0.f, 0.f, 0.f, 0.f};
#pragma unroll
            for (int ks = 0; ks < 4; ++ks) {
                u32x4 us; us.x = cvt_pk_bf16(S[2 * ks][0], S[2 * ks][1]); us.y = cvt_pk_bf16(S[2 * ks][2], S[2 * ks][3]); us.z = cvt_pk_bf16(S[2 * ks + 1][0], S[2 * ks + 1][1]); us.w = cvt_pk_bf16(S[2 * ks + 1][2], S[2 * ks + 1][3]);
                const bf16x8 sb = __builtin_bit_cast(bf16x8, us);
                const u32x2 wa = *(const u32x2*)(wrow + (2 * ks) * 16 + 4 * g), wb2 = *(const u32x2*)(wrow + (2 * ks + 1) * 16 + 4 * g);
                u32x4 uw; uw.x = wa.x; uw.y = wa.y; uw.z = wb2.x; uw.w = wb2.y;
                ws4 = __builtin_amdgcn_mfma_f32_16x16x32_bf16(__builtin_bit_cast(bf16x8, uw), sb, ws4, 0, 0, 0);
                const u32x2 qa = *(const u32x2*)(qrow + (2 * ks) * 16 + 4 * g), qb2 = *(const u32x2*)(qrow + (2 * ks + 1) * 16 + 4 * g);
                u32x4 uq; uq.x = qa.x; uq.y = qa.y; uq.z = qb2.x; uq.w = qb2.y;
                qs4 = __builtin_amdgcn_mfma_f32_16x16x32_bf16(__builtin_bit_cast(bf16x8, uq), sb, qs4, 0, 0, 0);
            }
            float vn[4];
#pragma unroll
            for (int jj = 0; jj < 4; ++jj) { vn[jj] = u4[jj] - ws4[jj]; qs4[jj] *= __expf(cgt4[jj]); }
            u32x4 uvn; uvn.x = cvt_pk_bf16(vn[0], vn[1]); uvn.y = cvt_pk_bf16(vn[2], vn[3]); uvn.z = 0u; uvn.w = 0u;
            const f32x4 o4 = __builtin_amdgcn_mfma_f32_16x16x32_bf16(__builtin_bit_cast(bf16x8, uqk), __builtin_bit_cast(bf16x8, uvn), qs4, 0, 0, 0);
#pragma unroll
            for (int jj = 0; jj < 4; ++jj) O[(c2 * 16 + 4 * g + jj) * 128 + vs + fn] = o4[jj];
            u32x4 uvd; uvd.x = cvt_pk_bf16(vn[0] * __expf(cg15 - cgt4[0]), vn[1] * __expf(cg15 - cgt4[1])); uvd.y = cvt_pk_bf16(vn[2] * __expf(cg15 - cgt4[2]), vn[3] * __expf(cg15 - cgt4[3])); uvd.z = 0u; uvd.w = 0u;
            const bf16x8 vdb = __builtin_bit_cast(bf16x8, uvd);
            const float e15 = __expf(cg15);
#pragma unroll
            for (int T = 0; T < 8; ++T) {
                const u32x2 kh = *(const u32x2*)(KT + (c2 * 128 + T * 16 + fn) * 16 + 4 * g);
                u32x4 uk; uk.x = kh.x; uk.y = kh.y; uk.z = 0u; uk.w = 0u;
                f32x4 sc = S[T]; sc[0] *= e15; sc[1] *= e15; sc[2] *= e15; sc[3] *= e15;
                S[T] = __builtin_amdgcn_mfma_f32_16x16x32_bf16(__builtin_bit_cast(bf16x8, uk), vdb, sc, 0, 0, 0);
            }
        }
        if (more) raw_store<PPR, NROW, NLD>(rg, raw, tid);
        __syncthreads();
        for (int t = w; t < ns; t += 8) {
            const size_t row = brow + t0 + t;
            const float2 o2 = *(const float2*)(O + t * 128 + lane * 2);
            const float2 g2 = *(const float2*)(Gt + t * 128 + lane * 2);
            const int v = lane * 2;
            const float ms = wave_sum(o2.x * o2.x + o2.y * o2.y) * (1.0f / 128.0f);
            const float rs = rsqrtf(ms + EPS);
            *(unsigned*)(Y + row * D + 512 + h * 128 + v) = cvt_pk_bf16(o2.x * rs * gn.x * g2.x, o2.y * rs * gn.y * g2.y);
        }
    }
}
__device__ __forceinline__ void odd_scan_phase(const Params& p, float* lds) {
    for (int item = obid(); item < 256; item += gridDim.x) {
        if (item < 128) { gdn_item(p, lds, item >> 2, item & 3); __syncthreads(); }
        else {
            const int half = otid() >> 8; const int i0 = (item - 128) * 2 + half;
            rwkv_half(p, lds + half * RW_ITEM_FLOATS, i0 >> 3, i0 & 7, half); __syncthreads();
        }
    }
}

#define XB_TMO      128
#define XB_XCNT(j)  (256  + 64 * (j))
#define XB_XSUB(j)  (1280 + 64 * (j))
#define XB_XGEN(j)  (2304 + 64 * (j))
#define XB_TOP      3328
#define XB_TOPGEN   3392
#define XCD_BAR_WORDS 3456
#define XB_SPIN_CAP (1u << 18)
__device__ __forceinline__ unsigned xb_ld(unsigned* p)              { return __hip_atomic_load(p, __ATOMIC_RELAXED, __HIP_MEMORY_SCOPE_AGENT); }
__device__ __forceinline__ unsigned xb_add(unsigned* p, unsigned v) { return __hip_atomic_fetch_add(p, v, __ATOMIC_RELAXED, __HIP_MEMORY_SCOPE_AGENT); }
__device__ __forceinline__ unsigned xb_xcc_id() { return (unsigned)__builtin_amdgcn_s_getreg((3 << 11) | 20) & 0xFu; }
#define XB_SPIN(cond, bar) do { unsigned _sp = 0; while (cond) { __builtin_amdgcn_s_sleep(1); \
    if ((++_sp & 255u) == 0u) { if (xb_ld(&(bar)[XB_TMO])) break; if (_sp > XB_SPIN_CAP) { atomicAdd(&(bar)[XB_TMO], 1u); break; } } } } while (0)
struct XcdBarrier { unsigned* bar; unsigned x; volatile LAS unsigned* st; };
__device__ __forceinline__ XcdBarrier xcd_barrier_post(unsigned* bar, volatile LAS unsigned* st) {
    XcdBarrier b; b.bar = bar; b.x = xb_xcc_id(); b.st = st;
    if (threadIdx.x == 0) (void)xb_add(&bar[XB_XCNT(b.x)], 1u);
    return b;
}
__device__ __forceinline__ void xcd_barrier_complete(unsigned* bar, unsigned x, unsigned& nloc, unsigned& nx) {
    const unsigned G = gridDim.x * gridDim.y * gridDim.z;
    unsigned sum, cnt, mine, sp = 0u;
    for (;;) {
        sum = 0u; cnt = 0u; mine = 0u;
#pragma unroll
        for (unsigned j = 0; j < 16; ++j) { const unsigned c = xb_ld(&bar[XB_XCNT(j)]); sum += c; cnt += (c > 0u) ? 1u : 0u; mine = (j == x) ? c : mine; }
        if (sum == G) break;
        __builtin_amdgcn_s_sleep(1);
        if ((++sp & 255u) == 0u) { if (xb_ld(&bar[XB_TMO])) break; if (sp > XB_SPIN_CAP) { atomicAdd(&bar[XB_TMO], 1u); break; } }
    }
    nloc = mine > 0u ? mine : 1u; nx = cnt > 0u ? cnt : 1u;
}
__device__ __forceinline__ void xcd_barrier(const XcdBarrier& b) {
    asm volatile("s_waitcnt vmcnt(0)" ::: "memory");
    __syncthreads();
    if (threadIdx.x == 0) {
        unsigned* bar = b.bar;
        __builtin_amdgcn_s_waitcnt(0);
        unsigned nloc = b.st[0], nx = b.st[1];
        if (nloc == 0u) { xcd_barrier_complete(bar, b.x, nloc, nx); b.st[0] = nloc; b.st[1] = nx; }
        const unsigned old = xb_add(&bar[XB_XSUB(b.x)], 1u);
        const unsigned gen = old / nloc;
        if (old + 1u == (gen + 1u) * nloc) {
            __builtin_amdgcn_fence(__ATOMIC_RELEASE, "agent");
            asm volatile("s_waitcnt vmcnt(0)" ::: "memory");
            const unsigned og = xb_add(&bar[XB_TOP], 1u);
            const unsigned tg = og / nx;
            if (og + 1u == (tg + 1u) * nx) xb_add(&bar[XB_TOPGEN], 1u);
            else XB_SPIN(xb_ld(&bar[XB_TOPGEN]) == tg, bar);
            __builtin_amdgcn_fence(__ATOMIC_ACQUIRE, "agent");
            xb_add(&bar[XB_XGEN(b.x)], 1u);
            asm volatile("s_waitcnt vmcnt(0)" ::: "memory");
        } else {
            XB_SPIN(xb_ld(&bar[XB_XGEN(b.x)]) == gen, bar);
            __builtin_amdgcn_fence(__ATOMIC_ACQUIRE, "agent");
            asm volatile("s_waitcnt vmcnt(0)" ::: "memory");
        }
    }
    __syncthreads();
}

__device__ __forceinline__ void sub_barrier(unsigned* word, unsigned nblk) {
    asm volatile("s_waitcnt vmcnt(0)" ::: "memory");
    __syncthreads();
    if (threadIdx.x == 0) {
        __builtin_amdgcn_fence(__ATOMIC_RELEASE, "agent");
        asm volatile("s_waitcnt vmcnt(0)" ::: "memory");
        (void)xb_add(word, 1u);
        unsigned sp = 0;
        while (xb_ld(word) < nblk) { __builtin_amdgcn_s_sleep(2); if (++sp > (1u << 22)) break; }
        __builtin_amdgcn_fence(__ATOMIC_ACQUIRE, "agent");
        asm volatile("s_waitcnt vmcnt(0)" ::: "memory");
    }
    __syncthreads();
}

constexpr int NPHASE = 21;
__global__ void __launch_bounds__(512, 2) hybrid_fwd(Params p) {
    extern __shared__ __attribute__((aligned(16))) unsigned char lds_raw[];
    cg::grid_group grid = cg::this_grid();
    unsigned char* ws = p.ws;
    __shared__ uint4 xb_words;
    if (threadIdx.x == 0) xb_words = make_uint4(0u, 0u, 0u, 0u);
    __syncthreads();
    const XcdBarrier xbar = xcd_barrier_post((unsigned*)(ws + WS_BAR), (volatile LAS unsigned*)&xb_words);
    bf16_t* A1 = (bf16_t*)(ws + WS_A1); bf16_t* BIG = (bf16_t*)(ws + WS_BIG);
    const float* NG = p.in[2];
    for (int ph = p.ph_lo; ph < p.ph_hi; ++ph) {
        int kind = 0;
        pg8::Gemm g{nullptr, nullptr, 0, 0, 0}; pg8::EpiBf16 E{nullptr, 0, 0, nullptr, nullptr, nullptr, (LAS float*)((LAS unsigned char*)lds_raw + 131072)};
        int nmode = 1; const bf16_t* nsrc = nullptr; const float* gA = nullptr; const float* gB = nullptr; int layer = 0;
        const int lyr = ph >= 11 ? 1 : 0; const int q = ph - lyr * 10;
        const bf16_t* Wup = (const bf16_t*)(ws + WS_WB + (lyr ? WB_UP1 : WB_UP0)); const bf16_t* Wdn = (const bf16_t*)(ws + WS_WB + (lyr ? WB_DN1 : WB_DN0));
        const bf16_t* Wout = (const bf16_t*)(ws + WS_WB + (lyr ? WB_OUTO : WB_OUTE));
        bf16_t* ACTF = (bf16_t*)(ws + WS_BIG); bf16_t* HALO = (bf16_t*)(ws + WS_BIG + BIG_HALO);
        int gG = gridDim.x, tailnorm = 0, nlo = 0, nhi = M, then_odd = 0; const bool split = (gridDim.x == 256); bf16_t* Y2 = (bf16_t*)(ws + WS_Y2);
        if (ph == 0) kind = 0;
        else if (q == 1) { kind = 1; g = pg8::Gemm{A1, (const bf16_t*)(ws + WS_WB + (lyr ? WB_INO : WB_INE)), M, (lyr && split) ? 1792 : PW, D}; E.O = BIG; E.ldc = PW; }
        else if (q == 2) { if (!lyr) kind = 2; else { kind = 1; then_odd = 1; gG = split ? 128 : 0; g = pg8::Gemm{A1, (const bf16_t*)(ws + WS_WB + WB_INO) + (size_t)1792 * D, M, 2304, D}; E.O = BIG + 1792; E.ldc = PW; } }
        else if (q == 3) { kind = 1; g = pg8::Gemm{lyr ? Y2 : A1, Wout, MHEAD, D, D}; E.O = BIG; E.ldc = D; }
        else if (q == 4) { kind = 1; gG = 8; tailnorm = 1; g = pg8::Gemm{(lyr ? Y2 : A1) + (size_t)MHEAD * D, Wout, M - MHEAD, D, D}; E.O = BIG + (size_t)MHEAD * D; E.ldc = D;
            nmode = 1; nsrc = BIG; gA = NG + (lyr * 4 + 1) * D; gB = NG + (lyr * 4 + 2) * D; nhi = MHEAD; }
        else if (q == 5) { kind = 4; nmode = 1; nsrc = BIG; gA = NG + (lyr * 4 + 1) * D; gB = NG + (lyr * 4 + 2) * D; nlo = MHEAD; }
        else if (q == 6) {
            kind = 1; g = pg8::Gemm{A1, Wup, M, DFF2, D}; E.O = ACTF; E.ldc = DFF; E.mode = 1; E.cw = p.in[25] + (size_t)lyr * 3 * DFF2; E.cb = p.in[26] + (size_t)lyr * DFF2; E.halo = HALO; }
        else if (q == 7) { kind = 5; layer = lyr; }
        else if (q == 8) { kind = 1; g = pg8::Gemm{ACTF, Wdn, MHEAD, D, DFF}; E.O = A1; E.ldc = D; }
        else {
            nsrc = A1; gA = NG + (lyr * 4 + 3) * D; if (lyr) nmode = 2; else { nmode = 1; gB = NG + (1 * 4 + 0) * D; }
            if (q == 9) { kind = 1; gG = 8; tailnorm = 1; g = pg8::Gemm{ACTF + (size_t)MHEAD * DFF, Wdn, M - MHEAD, D, DFF}; E.O = A1 + (size_t)MHEAD * D; E.ldc = D; nhi = MHEAD; }
            else { kind = 4; nlo = MHEAD; } }

#ifndef PROBE_KIND
#define PROBE_KIND -1
#endif
        for (int rep = 0; rep < ((kind == PROBE_KIND) ? 2 : 1); ++rep) {
        if (rep) xcd_barrier(xbar);
        if (kind == 0) {
            float* tile = (float*)lds_raw;
            bf16_t* wb = (bf16_t*)(ws + WS_WB);
            transpose_job(tile, p.in[3], (bf16_t*)((char*)wb + WB_INE), D, 4096, 4096, 0);
            transpose_job(tile, p.in[4], (bf16_t*)((char*)wb + WB_OUTE), D, D, D, 0);
            transpose_job(tile, p.in[7], (bf16_t*)((char*)wb + WB_INO), D, ODD_IN, 4096, 0);
            transpose_job(tile, p.in[8], (bf16_t*)((char*)wb + WB_OUTO), D, D, D, 0);
            transpose_job(tile, p.in[24], (bf16_t*)((char*)wb + WB_UP0), D, DFF2, DFF2, 1);
            transpose_job(tile, p.in[24] + (size_t)D * DFF2, (bf16_t*)((char*)wb + WB_UP1), D, DFF2, DFF2, 1);
            transpose_job(tile, p.in[27], (bf16_t*)((char*)wb + WB_DN0), DFF, D, D, 0);
            transpose_job(tile, p.in[27] + (size_t)DFF * D, (bf16_t*)((char*)wb + WB_DN1), DFF, D, D, 0);
            norm_phase(p, 0, nullptr, nullptr, NG, A1, 0, M, 0);
        } else if (kind == 1) {
            const int bid_g = obid();
            if (bid_g < gG) { pg8::StaticOrder S; S.init(g.M, g.N, gG, bid_g); pg8::gemm_phase((LAS unsigned char*)lds_raw, g, S, E); }
            if (tailnorm) norm_phase(p, nmode, nsrc, gA, gB, A1, nlo, nhi, 8);
            if (then_odd) {
                if (split && bid_g < 128) sub_barrier((unsigned*)(ws + WS_BAR) + 3600, 128u);
                odd_scan_phase(p, (float*)lds_raw);
            }
        } else if (kind == 2) {
            even_scan_phase(p, (float*)lds_raw);
        } else if (kind == 3) {
            odd_scan_phase(p, (float*)lds_raw);
        } else if (kind == 4) {
            norm_phase(p, nmode, nsrc, gA, gB, A1, nlo, nhi, 0);
        } else {
            ffn_fixup_phase(p, layer);
        }
        }
        if (ph + 1 < p.ph_hi) { if (p.ph_hi > 1000) grid.sync(); else xcd_barrier(xbar); }
    }
}

extern "C" void kernel_launch(void* const* d_in, const int* in_sizes, int n_in, void* d_out, int out_size, void* d_ws, size_t ws_size, hipStream_t stream) {
    static int grid_blocks = 0;
    if (grid_blocks == 0) {
        if (n_in != 28 || ws_size < WS_END) { fprintf(stderr, "kernel_launch: need 28 inputs and %zu bytes of workspace (got %d, %zu)\n", (size_t)WS_END, n_in, ws_size); grid_blocks = -1; return; }
        int dev = 0, cus = 0, per_cu = 0;
        hipGetDevice(&dev);
        hipDeviceGetAttribute(&cus, hipDeviceAttributeMultiprocessorCount, dev);
        if (hipFuncSetAttribute((const void*)hybrid_fwd, hipFuncAttributeMaxDynamicSharedMemorySize, LDS_BYTES) != hipSuccess) { fprintf(stderr, "kernel_launch: hipFuncSetAttribute failed\n"); grid_blocks = -1; return; }
        if (hipOccupancyMaxActiveBlocksPerMultiprocessor(&per_cu, (const void*)hybrid_fwd, 512, LDS_BYTES) != hipSuccess || per_cu < 1) { fprintf(stderr, "kernel_launch: occupancy query says %d\n", per_cu); per_cu = 1; }
        (void)hipGetLastError();
        grid_blocks = cus;
    }
    if (grid_blocks < 0) return;
    if (hipMemsetAsync((char*)d_ws + WS_BAR, 0, 16384, stream) != hipSuccess) { fprintf(stderr, "kernel_launch: hipMemsetAsync of the barrier words failed\n"); return; }
    Params p{};
    for (int i = 0; i < 28; ++i) p.in[i] = (const float*)d_in[i];
    p.out = (float*)d_out; p.ws = (unsigned char*)d_ws;
#if defined(MK_PER_PHASE)
    for (int ph = 0; ph < NPHASE; ++ph) { p.ph_lo = ph; p.ph_hi = ph + 1; hipLaunchKernelGGL(hybrid_fwd, dim3(grid_blocks), dim3(512), LDS_BYTES, stream, p); }
#else
    p.ph_lo = 0; p.ph_hi = NPHASE;
    void* args[] = {&p};
    hipError_t e = hipLaunchCooperativeKernel((const void*)hybrid_fwd, dim3(grid_blocks), dim3(512), args, LDS_BYTES, stream);
    if (e != hipSuccess) fprintf(stderr, "kernel_launch: cooperative launch failed: %s (grid %d)\n", hipGetErrorString(e), grid_blocks);
#endif
}
```

```cpp
#include <hip/hip_runtime.h>
#include <hip/hip_cooperative_groups.h>
#include <cstdio>
namespace cg = cooperative_groups;

#define LAS __attribute__((address_space(3)))
typedef unsigned short bf16_t;
typedef short bf16x8 __attribute__((ext_vector_type(8)));
typedef float f32x4 __attribute__((ext_vector_type(4)));
typedef unsigned u32x4 __attribute__((ext_vector_type(4)));
typedef unsigned u32x2 __attribute__((ext_vector_type(2)));

constexpr int NB = 32, SEQ = 2048, NMETA = 16, L = 2064, D = 1024, M = NB * L;
constexpr int DFF = 2816, DFF2 = 5632;
constexpr int PW = 4096;
constexpr int ODD_IN = 3848;
constexpr int SLAB = 33024;
constexpr int MHEAD = 65536;
constexpr float EPS = 1e-6f;

constexpr size_t WS_H = 0;
constexpr size_t WS_Y2 = WS_H + (size_t)M * D * 2;
constexpr size_t WS_A1 = WS_H + (size_t)M * D * 4;
constexpr size_t WS_BIG = WS_A1 + (size_t)M * D * 2;
constexpr size_t BIG_ZUP = 0, BIG_ACT = (size_t)SLAB * DFF2 * 2;
constexpr size_t BIG_BYTES = BIG_ACT + (size_t)SLAB * DFF * 2;
constexpr size_t WS_WB = WS_BIG + BIG_BYTES;
constexpr size_t WB_INE = 0, WB_OUTE = WB_INE + (size_t)4096 * 1024 * 2, WB_INO = WB_OUTE + (size_t)1024 * 1024 * 2, WB_OUTO = WB_INO + (size_t)4096 * 1024 * 2;
constexpr size_t WB_UP0 = WB_OUTO + (size_t)1024 * 1024 * 2, WB_UP1 = WB_UP0 + (size_t)DFF2 * 1024 * 2, WB_DN0 = WB_UP1 + (size_t)DFF2 * 1024 * 2, WB_DN1 = WB_DN0 + (size_t)1024 * DFF * 2;
constexpr size_t WS_BAR = WS_WB + WB_DN1 + (size_t)1024 * DFF * 2;
constexpr size_t WS_END = WS_BAR + 16384;
static_assert(BIG_BYTES >= (size_t)M * PW * 2, "BIG holds the projection");

constexpr int LDS_BYTES = 131072 + 4096;

struct Params { const float* in[28]; float* out; unsigned char* ws; int ph_lo, ph_hi; };

__device__ __forceinline__ float bf2f(bf16_t v) { return __uint_as_float(((unsigned)v) << 16); }
typedef __bf16 bf16x2_t __attribute__((ext_vector_type(2)));
typedef float f32x2_t __attribute__((ext_vector_type(2)));
__device__ __forceinline__ unsigned cvt_pk_bf16(float lo, float hi) { const f32x2_t f = {lo, hi}; const bf16x2_t v = __builtin_convertvector(f, bf16x2_t); return __builtin_bit_cast(unsigned, v); }
__device__ __forceinline__ bf16_t f2bf(float f) { return (bf16_t)(cvt_pk_bf16(f, 0.f) & 0xffffu); }
__device__ __forceinline__ float sigmoidf_(float x) { return __builtin_amdgcn_rcpf(1.0f + __expf(-x)); }
__device__ __forceinline__ float siluf_(float x) { return x * sigmoidf_(x); }
__device__ __forceinline__ float softplusf_(float x) { return fmaxf(x, 0.f) + __logf(1.0f + __expf(-fabsf(x))); }
__device__ __forceinline__ int otid() { int t = threadIdx.x; asm volatile("" : "+v"(t)); return t; }
__device__ __forceinline__ int obid() { int b = blockIdx.x; asm volatile("" : "+s"(b)); return b; }
template <int CTRL> __device__ __forceinline__ float dppf(float x) { return __int_as_float(__builtin_amdgcn_update_dpp(0, __float_as_int(x), CTRL, 0xF, 0xF, true)); }
__device__ __forceinline__ float allreduce8(float x) { x += dppf<0xB1>(x); x += dppf<0x4E>(x); x += dppf<0x141>(x); return x; }
__device__ __forceinline__ float allreduce16(float x) { x = allreduce8(x); x += dppf<0x140>(x); return x; }
__device__ __forceinline__ float wave_sum(float x) {
    x = allreduce16(x);
    const int xi = __float_as_int(x);
    const float r0 = __int_as_float(__builtin_amdgcn_readlane(xi, 0)), r1 = __int_as_float(__builtin_amdgcn_readlane(xi, 16));
    const float r2 = __int_as_float(__builtin_amdgcn_readlane(xi, 32)), r3 = __int_as_float(__builtin_amdgcn_readlane(xi, 48));
    return (r0 + r1) + (r2 + r3);
}

namespace pg8 {
constexpr int BM = 256, BK = 64, HALF = 128, HTB = HALF * BK * 2, STAGE_BYTES = 8 * HTB, NXCD = 8, WGM = 8;
__host__ __device__ __forceinline__ int lds_byte(int r, int c) { const int st = (r >> 4) * 2 + (c >> 5), rr = r & 15, cc = c & 31, ob = rr * 64 + cc * 2; return st * 1024 + (ob ^ (((ob >> 9) & 1) << 5)); }
__host__ __device__ __forceinline__ void stage_rc(int b, int& R, int& C) { const int st = b / 1024, sb = b % 1024, swz = sb ^ (((sb >> 9) & 1) << 5); R = (st >> 1) * 16 + swz / 64; C = (st & 1) * 32 + (swz % 64) / 2; }
__host__ __device__ __forceinline__ int perm32(int rho) { const int n = rho >> 4, i = rho & 15; return 8 * (i >> 2) + 4 * n + (i & 3); }
struct Unit { int pm, pn; };
struct Gemm { const bf16_t* A; const bf16_t* Bt; int M, N, K; };
struct StaticOrder {
    int nM, nN, nwg, G, c;
    __device__ void init(int M_, int N_, int G_, int c_) { nM = M_ / BM; nN = N_ / BM; nwg = nM * nN; G = G_; c = c_; }
    __device__ bool next(int i, Unit& u) const {
        const long Lx = (long)i * G + c; if (Lx >= nwg) return false;
        int wgid = (int)Lx; { const int q = nwg / NXCD, r = nwg % NXCD, xcd = wgid % NXCD, off = wgid / NXCD; wgid = (xcd < r ? xcd * (q + 1) : r * (q + 1) + (xcd - r) * q) + off; }
        const int nig = WGM * nN, gid = wgid / nig, fm = gid * WGM, gsz = (nM - fm) < WGM ? (nM - fm) : WGM;
        u.pm = fm + ((wgid % nig) % gsz); u.pn = (wgid % nig) / gsz; return true;
    }
};
struct EpiBf16 {
    bf16_t* O; int ldc; int mode; const float* cw; const float* cb; bf16_t* halo; LAS float* wlds;
    __device__ __forceinline__ void operator()(const f32x4 (&acc)[2][2][4][2], const Unit& u, int wr, int wc, int fr, int fq) const {
        if (mode == 0) {
            const int row0 = u.pm * BM + wr * 64 + fr; const int col0 = u.pn * BM + wc * 32 + 8 * fq;
#pragma unroll
            for (int ai = 0; ai < 2; ++ai)
#pragma unroll
                for (int m = 0; m < 4; ++m) { bf16_t* rowp = O + (size_t)(row0 + ai * HALF + m * 16) * ldc + col0;
#pragma unroll
                    for (int bj = 0; bj < 2; ++bj) { const f32x4 v0 = acc[ai][bj][m][0], v1 = acc[ai][bj][m][1];
                        u32x4 w; w.x = cvt_pk_bf16(v0[0], v0[1]); w.y = cvt_pk_bf16(v0[2], v0[3]); w.z = cvt_pk_bf16(v1[0], v1[1]); w.w = cvt_pk_bf16(v1[2], v1[3]);
                        *(u32x4*)(rowp + bj * HALF) = w; } }
            return;
        }
        const int ch0 = u.pn * 128 + wc * 32 + 8 * fq;
        const bool l15 = (fr == 15), l14 = (fr >= 14);
        LAS float* wsc = wlds + ((wr * 4 + wc) * 4 + fq) * 32;
        {
            f32x4 t[8];
#pragma unroll
            for (int j = 0; j < 3; ++j) { t[j] = *(const f32x4*)(cw + j * DFF2 + ch0 + 4); t[3 + j] = *(const f32x4*)(cw + j * DFF2 + DFF + ch0 + 4); }
            t[6] = *(const f32x4*)(cb + ch0 + 4); t[7] = *(const f32x4*)(cb + DFF + ch0 + 4);
#pragma unroll
            for (int j = 0; j < 8; ++j) *(LAS f32x4*)(wsc + 4 * j) = t[j];
        }
#pragma unroll
        for (int n = 0; n < 2; ++n) {
            float wg[3][4], wv[3][4], bg[4], bv[4];
            if (n == 0) {
#pragma unroll
                for (int j = 0; j < 3; ++j) {
                    const float4 a = *(const float4*)(cw + j * DFF2 + ch0), c = *(const float4*)(cw + j * DFF2 + DFF + ch0);
                    wg[j][0] = a.x; wg[j][1] = a.y; wg[j][2] = a.z; wg[j][3] = a.w; wv[j][0] = c.x; wv[j][1] = c.y; wv[j][2] = c.z; wv[j][3] = c.w;
                }
                const float4 a = *(const float4*)(cb + ch0), c = *(const float4*)(cb + DFF + ch0);
                bg[0] = a.x; bg[1] = a.y; bg[2] = a.z; bg[3] = a.w; bv[0] = c.x; bv[1] = c.y; bv[2] = c.z; bv[3] = c.w;
            } else {
#pragma unroll
                for (int j = 0; j < 3; ++j) {
                    const f32x4 a = *(const LAS f32x4*)(wsc + 4 * j), c = *(const LAS f32x4*)(wsc + 4 * (3 + j));
                    wg[j][0] = a[0]; wg[j][1] = a[1]; wg[j][2] = a[2]; wg[j][3] = a[3]; wv[j][0] = c[0]; wv[j][1] = c[1]; wv[j][2] = c[2]; wv[j][3] = c[3];
                }
                const f32x4 a = *(const LAS f32x4*)(wsc + 24), c = *(const LAS f32x4*)(wsc + 28);
                bg[0] = a[0]; bg[1] = a[1]; bg[2] = a[2]; bg[3] = a[3]; bv[0] = c[0]; bv[1] = c[1]; bv[2] = c[2]; bv[3] = c[3];
            }
#pragma unroll
            for (int ai = 0; ai < 2; ++ai)
#pragma unroll
                for (int m = 0; m < 4; ++m) {
                    const int r = u.pm * BM + ai * HALF + wr * 64 + m * 16 + fr; const int tb = r % L;
                    const bool k1 = (tb >= 1), k2 = (tb >= 2);
                    float o[4];
#pragma unroll
                    for (int e = 0; e < 4; ++e) {
                        const float g0 = acc[ai][0][m][n][e], v0 = acc[ai][1][m][n][e];
                        const float gm = (m > 0) ? acc[ai][0][m > 0 ? m - 1 : 0][n][e] : 0.f, vm = (m > 0) ? acc[ai][1][m > 0 ? m - 1 : 0][n][e] : 0.f;
                        float g1 = dppf<0x121>(l15 ? gm : g0), g2 = dppf<0x122>(l14 ? gm : g0), v1 = dppf<0x121>(l15 ? vm : v0), v2 = dppf<0x122>(l14 ? vm : v0);
                        g1 = k1 ? g1 : 0.f; v1 = k1 ? v1 : 0.f; g2 = k2 ? g2 : 0.f; v2 = k2 ? v2 : 0.f;
                        const float zg = fmaf(wg[0][e], g2, fmaf(wg[1][e], g1, fmaf(wg[2][e], g0, bg[e])));
                        const float zv = fmaf(wv[0][e], v2, fmaf(wv[1][e], v1, fmaf(wv[2][e], v0, bv[e])));
                        o[e] = siluf_(zg) * zv;
                    }
                    if (!(m == 0 && fr < 2)) {
                        u32x2 w; w.x = cvt_pk_bf16(o[0], o[1]); w.y = cvt_pk_bf16(o[2], o[3]);
                        *(u32x2*)(O + (size_t)r * ldc + ch0 + 4 * n) = w;
                    }
                }
        }
#pragma unroll
        for (int ai = 0; ai < 2; ++ai)
#pragma unroll
            for (int m = 0; m < 4; m += 3) {
                if ((m == 3 && fr >= 14) || (m == 0 && fr < 2)) {
                    const int r = u.pm * BM + ai * HALF + wr * 64 + m * 16 + fr;
                    const int slot = (m == 3) ? (fr - 14) : (2 + fr);
                    bf16_t* hp = halo + ((size_t)(r >> 6) * 4 + slot) * DFF2 + u.pn * 256 + wc * 32 + 8 * fq;
#pragma unroll
                    for (int bj = 0; bj < 2; ++bj) { const f32x4 a0 = acc[ai][bj][m][0], a1 = acc[ai][bj][m][1];
                        u32x4 w; w.x = cvt_pk_bf16(a0[0], a0[1]); w.y = cvt_pk_bf16(a0[2], a0[3]); w.z = cvt_pk_bf16(a1[0], a1[1]); w.w = cvt_pk_bf16(a1[2], a1[3]);
                        *(u32x4*)(hp + bj * 128) = w; }
                }
            }
    }
};

__device__ __forceinline__ void gemm_phase(LAS unsigned char* lds, const Gemm g, const StaticOrder& S, const EpiBf16& E) {
    const int tid = otid(), wid = __builtin_amdgcn_readfirstlane(tid >> 6), lane = tid & 63, wr = wid >> 2, wc = wid & 3, fr = lane & 15, fq = lane >> 4;
    const int K = g.K, nt = K / BK;
    unsigned voffA[2], voffB[2];
#pragma unroll
    for (int i = 0; i < 2; ++i) { int R, C; stage_rc(tid * 16 + i * 8192, R, C); const int Rb = (R & ~31) + perm32(R & 31);
        voffA[i] = (unsigned)(R * K + C) * 2u; voffB[i] = (unsigned)(Rb * K + C) * 2u; }
    const size_t kstep = (size_t)(BK * 2);
    const size_t hstep = (size_t)HALF * K * 2;
    const size_t tstep = 2 * hstep;
    const unsigned ldsw = (unsigned)wid * 1024u;
    const int aoff = lds_byte(wr * 64 + fr, fq * 8), boff = lds_byte(wc * 32 + fr, fq * 8);
#define PG8_SA(b, h) (((b) * 2 + (h)) * HTB)
#define PG8_SB(b, h) ((4 + (b) * 2 + (h)) * HTB)
#define PG8_STAGE(bufoff, gbase, voff) do { _Pragma("unroll") for (int _i = 0; _i < 2; ++_i) \
        __builtin_amdgcn_global_load_lds((const unsigned*)((const char*)(gbase) + (voff)[_i]), (LAS unsigned*)(lds + (bufoff) + ldsw + _i * 8192), 16, 0, 0); } while (0)
#define PG8_LDA(dst, b, h) do { _Pragma("unroll") for (int m = 0; m < 4; ++m) _Pragma("unroll") for (int k = 0; k < 2; ++k) dst[m][k] = *(const LAS bf16x8*)(lds + PG8_SA(b, h) + aoff + m * 2048 + k * 1024); } while (0)
#define PG8_LDB(dst, b, h) do { _Pragma("unroll") for (int n = 0; n < 2; ++n) _Pragma("unroll") for (int k = 0; k < 2; ++k) dst[n][k] = *(const LAS bf16x8*)(lds + PG8_SB(b, h) + boff + n * 2048 + k * 1024); } while (0)
#define PG8_MMA(ai, bj, At, Bt) do { __builtin_amdgcn_s_setprio(1); _Pragma("unroll") for (int m = 0; m < 4; ++m) _Pragma("unroll") for (int n = 0; n < 2; ++n) _Pragma("unroll") for (int k = 0; k < 2; ++k) \
        acc[ai][bj][m][n] = __builtin_amdgcn_mfma_f32_16x16x32_bf16(Bt[n][k], At[m][k], acc[ai][bj][m][n], 0, 0, 0); __builtin_amdgcn_s_setprio(0); } while (0)
#define PG8_WAIT_V(n) asm volatile("s_waitcnt vmcnt(" #n ")" ::: "memory")
#define PG8_WAIT_L(n) asm volatile("s_waitcnt lgkmcnt(" #n ")" ::: "memory")
#define PG8_BAR __builtin_amdgcn_s_barrier()
#define PG8_SCHED __builtin_amdgcn_sched_barrier(0)
    Unit cur, nxt; int ui = 0;
    if (!S.next(0, cur)) return;
    f32x4 acc[2][2][4][2];
#pragma unroll
    for (int a = 0; a < 2; ++a)
#pragma unroll
        for (int b = 0; b < 2; ++b)
#pragma unroll
            for (int m = 0; m < 4; ++m)
#pragma unroll
                for (int n = 0; n < 2; ++n) acc[a][b][m][n] = (f32x4){0.f, 0.f, 0.f, 0.f};
    bf16x8 At[4][2], B0[2][2], B1[2][2];
    const char* cA = (const char*)g.A + (size_t)cur.pm * tstep; const char* cB = (const char*)g.Bt + (size_t)cur.pn * tstep;
    PG8_STAGE(PG8_SB(0, 0), cB, voffB); PG8_STAGE(PG8_SA(0, 0), cA, voffA); PG8_STAGE(PG8_SB(0, 1), cB + hstep, voffB); PG8_STAGE(PG8_SA(0, 1), cA + hstep, voffA);
    if (wr == 1) PG8_BAR;
    PG8_WAIT_V(4); PG8_BAR;
    PG8_STAGE(PG8_SB(1, 0), cB + kstep, voffB); PG8_STAGE(PG8_SA(1, 0), cA + kstep, voffA); PG8_STAGE(PG8_SB(1, 1), cB + hstep + kstep, voffB);
    PG8_WAIT_V(6); PG8_BAR;
    for (;;) {
        const bool has_next = S.next(ui + 1, nxt);
        const char* nA = has_next ? (const char*)g.A + (size_t)nxt.pm * tstep : cA; const char* nB = has_next ? (const char*)g.Bt + (size_t)nxt.pn * tstep : cB;
        for (int t = 0; t < nt; t += 2) {
            const bool last = (t == nt - 2);
            const char* a1 = cA + (size_t)(t + 1) * kstep;
            const char* a2 = last ? nA : cA + (size_t)(t + 2) * kstep; const char* b2 = last ? nB : cB + (size_t)(t + 2) * kstep;
            const char* a3 = a2 + kstep; const char* b3 = b2 + kstep;
            PG8_LDB(B0, 0, 0); PG8_SCHED; PG8_LDA(At, 0, 0); PG8_STAGE(PG8_SA(1, 1), a1 + hstep, voffA);
            PG8_WAIT_L(8); PG8_BAR; PG8_WAIT_L(0); PG8_MMA(0, 0, At, B0); PG8_BAR; PG8_SCHED;
            PG8_LDB(B1, 0, 1); PG8_STAGE(PG8_SB(0, 0), b2, voffB);
            PG8_BAR; PG8_WAIT_L(0); PG8_MMA(0, 1, At, B1); PG8_BAR;
            PG8_LDA(At, 0, 1); PG8_STAGE(PG8_SA(0, 0), a2, voffA);
            PG8_BAR; PG8_WAIT_L(0); PG8_MMA(1, 0, At, B0); PG8_BAR; PG8_SCHED;
            PG8_STAGE(PG8_SB(0, 1), b2 + hstep, voffB);
            PG8_WAIT_V(6); PG8_BAR; PG8_MMA(1, 1, At, B1); PG8_BAR;
            PG8_LDB(B0, 1, 0); PG8_SCHED; PG8_LDA(At, 1, 0); PG8_STAGE(PG8_SA(0, 1), a2 + hstep, voffA);
            PG8_WAIT_L(8); PG8_BAR; PG8_WAIT_L(0); PG8_MMA(0, 0, At, B0); PG8_BAR; PG8_SCHED;
            PG8_LDB(B1, 1, 1); PG8_STAGE(PG8_SB(1, 0), b3, voffB);
            PG8_BAR; PG8_WAIT_L(0); PG8_MMA(0, 1, At, B1); PG8_BAR;
            PG8_LDA(At, 1, 1); PG8_STAGE(PG8_SA(1, 0), a3, voffA);
            PG8_BAR; PG8_WAIT_L(0); PG8_MMA(1, 0, At, B0); PG8_BAR; PG8_SCHED;
            PG8_STAGE(PG8_SB(1, 1), b3 + hstep, voffB);
            PG8_WAIT_V(6); PG8_BAR; PG8_MMA(1, 1, At, B1); PG8_BAR;
        }
        E(acc, cur, wr, wc, fr, fq);
        if (!has_next) break;
#pragma unroll
        for (int a = 0; a < 2; ++a)
#pragma unroll
            for (int b = 0; b < 2; ++b)
#pragma unroll
                for (int m = 0; m < 4; ++m)
#pragma unroll
                    for (int n = 0; n < 2; ++n) acc[a][b][m][n] = (f32x4){0.f, 0.f, 0.f, 0.f};
        cur = nxt; cA = nA; cB = nB; ++ui;
    }
    PG8_WAIT_V(0);
    if (wr == 0) PG8_BAR;
    PG8_BAR;
#undef PG8_SA
#undef PG8_SB
#undef PG8_STAGE
#undef PG8_LDA
#undef PG8_LDB
#undef PG8_MMA
#undef PG8_WAIT_V
#undef PG8_WAIT_L
#undef PG8_BAR
#undef PG8_SCHED
}
}

__device__ __noinline__ void transpose_job(float* tile  , const float* __restrict__ src, bf16_t* __restrict__ dst, int K, int N, int Npad, int glu) {
    const int tid = otid();
    const int tk = K / 64, tn = Npad / 64, ntiles = tk * tn;
    const int kkA = tid >> 4, n4 = (tid & 15) * 4;
    float4 v[2];
    auto fetch = [&](int tl) {
        const int k0 = (tl % tk) * 64, n0 = (tl / tk) * 64;
#pragma unroll
        for (int it = 0; it < 2; ++it) { v[it] = make_float4(0.f, 0.f, 0.f, 0.f); if (n0 + n4 < N) v[it] = *(const float4*)(src + (size_t)(k0 + kkA + it * 32) * N + n0 + n4); }
    };
    int tl = obid();
    if (tl < ntiles) fetch(tl);
    while (tl < ntiles) {
        const int k0 = (tl % tk) * 64, n0 = (tl / tk) * 64;
        __syncthreads();
#pragma unroll
        for (int it = 0; it < 2; ++it) { float* tp = tile + (kkA + it * 32) * 65 + n4; tp[0] = v[it].x; tp[1] = v[it].y; tp[2] = v[it].z; tp[3] = v[it].w; }
        const int nxt = tl + (int)gridDim.x;
        if (nxt < ntiles) fetch(nxt);
        __syncthreads();
        const int nn = tid >> 3, k8 = (tid & 7) * 8;
        float e[8];
#pragma unroll
        for (int j = 0; j < 8; ++j) e[j] = tile[(k8 + j) * 65 + nn];
        u32x4 w; w.x = cvt_pk_bf16(e[0], e[1]); w.y = cvt_pk_bf16(e[2], e[3]); w.z = cvt_pk_bf16(e[4], e[5]); w.w = cvt_pk_bf16(e[6], e[7]);
        const int r0 = !glu ? n0 : (n0 < DFF ? (n0 >> 7) * 256 + (n0 & 127) : ((n0 - DFF) >> 7) * 256 + 128 + ((n0 - DFF) & 127));
        *(u32x4*)(dst + (size_t)(r0 + nn) * K + k0 + k8) = w;
        tl = nxt;
    }
}

__device__ void norm_phase(const Params& p, int mode, const bf16_t* msrc, const float* __restrict__ gA, const float* __restrict__ gB, bf16_t* udst, int row_lo, int row_hi, int blk_first, int blk_cnt) {
    bf16_t* H = (bf16_t*)(p.ws + WS_H);
    const int tid_ = otid(); const int lane = tid_ & 63, w = tid_ >> 6;
    const int nw = blk_cnt * 8; const int bid_ = obid() - blk_first;
    if (bid_ < 0 || bid_ >= blk_cnt) return;
    float4 ga[4], gb[4];
#pragma unroll
    for (int i = 0; i < 4; ++i) { ga[i] = (mode != 0) ? *(const float4*)(gA + i * 256 + lane * 4) : make_float4(0.f, 0.f, 0.f, 0.f); gb[i] = (mode != 2) ? *(const float4*)(gB + i * 256 + lane * 4) : make_float4(0.f, 0.f, 0.f, 0.f); }
    float4 xr[4]; u32x2 hr[4], mr[4];
    auto fetch = [&](int row) {
        if (mode == 0) {
            const int b = row / L, t = row - b * L;
            const float* src = (t < NMETA) ? (p.in[1] + (size_t)t * D) : (p.in[0] + ((size_t)b * SEQ + (t - NMETA)) * D);
#pragma unroll
            for (int i = 0; i < 4; ++i) xr[i] = *(const float4*)(src + i * 256 + lane * 4);
        } else {
#pragma unroll
            for (int i = 0; i < 4; ++i) { hr[i] = *(const u32x2*)(H + (size_t)row * D + i * 256 + lane * 4); mr[i] = *(const u32x2*)(msrc + (size_t)row * D + i * 256 + lane * 4); }
        }
    };
    int row = row_lo + bid_ * 8 + w;
    if (row < row_hi) fetch(row);
    while (row < row_hi) {
        const int b = row / L, t = row - b * L;
        float4 hv[4];
        float mv[4][4]; float ssm = 0.f;
        if (mode == 0) {
#pragma unroll
            for (int i = 0; i < 4; ++i) hv[i] = xr[i];
        } else {
#pragma unroll
            for (int i = 0; i < 4; ++i) {
                hv[i] = make_float4(__uint_as_float(hr[i].x << 16), __uint_as_float(hr[i].x & 0xffff0000u), __uint_as_float(hr[i].y << 16), __uint_as_float(hr[i].y & 0xffff0000u));
                mv[i][0] = __uint_as_float(mr[i].x << 16); mv[i][1] = __uint_as_float(mr[i].x & 0xffff0000u); mv[i][2] = __uint_as_float(mr[i].y << 16); mv[i][3] = __uint_as_float(mr[i].y & 0xffff0000u);
                ssm += mv[i][0] * mv[i][0] + mv[i][1] * mv[i][1] + mv[i][2] * mv[i][2] + mv[i][3] * mv[i][3];
            }
        }
        const int nxt = row + nw;
        if (nxt < row_hi) fetch(nxt);
        if (mode != 0) {
            ssm = wave_sum(ssm);
            const float rs = rsqrtf(ssm * (1.0f / D) + EPS);
#pragma unroll
            for (int i = 0; i < 4; ++i) { hv[i].x += mv[i][0] * rs * ga[i].x; hv[i].y += mv[i][1] * rs * ga[i].y; hv[i].z += mv[i][2] * rs * ga[i].z; hv[i].w += mv[i][3] * rs * ga[i].w; }
        }
        if (mode == 2) {
            if (t >= NMETA) {
                float* o = p.out + ((size_t)b * SEQ + (t - NMETA)) * D;
#pragma unroll
                for (int i = 0; i < 4; ++i) *(float4*)(o + i * 256 + lane * 4) = hv[i];
            }
        } else {
            float ss = 0.f;
#pragma unroll
            for (int i = 0; i < 4; ++i) {
                { u32x2 hw; hw.x = cvt_pk_bf16(hv[i].x, hv[i].y); hw.y = cvt_pk_bf16(hv[i].z, hv[i].w); *(u32x2*)(H + (size_t)row * D + i * 256 + lane * 4) = hw; }
                ss += hv[i].x * hv[i].x + hv[i].y * hv[i].y + hv[i].z * hv[i].z + hv[i].w * hv[i].w;
            }
            ss = wave_sum(ss);
            const float rs = rsqrtf(ss * (1.0f / D) + EPS);
#pragma unroll
            for (int i = 0; i < 4; ++i) {
                u32x2 o; o.x = cvt_pk_bf16(hv[i].x * rs * gb[i].x, hv[i].y * rs * gb[i].y); o.y = cvt_pk_bf16(hv[i].z * rs * gb[i].z, hv[i].w * rs * gb[i].w);
                *(u32x2*)(udst + (size_t)row * D + i * 256 + lane * 4) = o;
            }
        }
        row = nxt;
    }
}

constexpr size_t BIG_HALO = (size_t)M * DFF * 2;
static_assert(BIG_HALO + (size_t)(M / 64) * 4 * DFF2 * 2 <= BIG_BYTES, "activation + halo fit");
__device__ void ffn_fixup_phase(const Params& p, int layer) {
    bf16_t* act = (bf16_t*)(p.ws + WS_BIG);
    const bf16_t* halo = (const bf16_t*)(p.ws + WS_BIG + BIG_HALO);
    const float* cw = p.in[25] + (size_t)layer * 3 * DFF2;
    const float* cb = p.in[26] + (size_t)layer * DFF2;
    constexpr int NCG = DFF / 8, NBLK = M / 64;
    const int nitems = NCG * NBLK;
    for (int item = obid() * 512 + otid(); item < nitems; item += gridDim.x * 512) {
        const int cgp = item % NCG, blk = item / NCG;
        const int c0 = cgp * 8;
        const int gcol = (c0 >> 7) * 256 + (c0 & 127);
        float wg[3][8], wv[3][8], bg[8], bv[8];
#pragma unroll
        for (int j = 0; j < 3; ++j)
#pragma unroll
            for (int e = 0; e < 8; ++e) { wg[j][e] = cw[j * DFF2 + c0 + e]; wv[j][e] = cw[j * DFF2 + DFF + c0 + e]; }
#pragma unroll
        for (int e = 0; e < 8; ++e) { bg[e] = cb[c0 + e]; bv[e] = cb[DFF + c0 + e]; }
        auto ldrow = [&](int bk, int slot, float (&g)[8], float (&v)[8]) {
            const bf16_t* hp = halo + ((size_t)bk * 4 + slot) * DFF2 + gcol;
            const u32x4 a = *(const u32x4*)hp, c = *(const u32x4*)(hp + 128);
#pragma unroll
            for (int e = 0; e < 4; ++e) { g[2 * e] = __uint_as_float(a[e] << 16); g[2 * e + 1] = __uint_as_float(a[e] & 0xffff0000u); v[2 * e] = __uint_as_float(c[e] << 16); v[2 * e + 1] = __uint_as_float(c[e] & 0xffff0000u); }
        };
        float gz[4][8], vz[4][8];
#pragma unroll
        for (int e = 0; e < 8; ++e) { gz[0][e] = 0.f; gz[1][e] = 0.f; vz[0][e] = 0.f; vz[1][e] = 0.f; }
        if (blk > 0) { ldrow(blk - 1, 0, gz[0], vz[0]); ldrow(blk - 1, 1, gz[1], vz[1]); }
        ldrow(blk, 2, gz[2], vz[2]); ldrow(blk, 3, gz[3], vz[3]);
#pragma unroll
        for (int q = 0; q < 2; ++q) {
            const int r = blk * 64 + q; const int tb = r % L;
            const float k1 = (tb >= 1) ? 1.f : 0.f, k2 = (tb >= 2) ? 1.f : 0.f;
            float o[8];
#pragma unroll
            for (int e = 0; e < 8; ++e) {
                const float zg = wg[0][e] * (k2 * gz[q][e]) + wg[1][e] * (k1 * gz[q + 1][e]) + wg[2][e] * gz[q + 2][e] + bg[e];
                const float zv = wv[0][e] * (k2 * vz[q][e]) + wv[1][e] * (k1 * vz[q + 1][e]) + wv[2][e] * vz[q + 2][e] + bv[e];
                o[e] = siluf_(zg) * zv;
            }
            u32x4 w; w.x = cvt_pk_bf16(o[0], o[1]); w.y = cvt_pk_bf16(o[2], o[3]); w.z = cvt_pk_bf16(o[4], o[5]); w.w = cvt_pk_bf16(o[6], o[7]);
            *(u32x4*)(act + (size_t)r * DFF + c0) = w;
        }
    }
}

constexpr int TCH = 32;
template <int PPR, int NROW, int NLD, int NT = 512, class ColFn>
__device__ __forceinline__ void raw_fetch(u32x4 (&reg)[NLD], const bf16_t* P, int tid, size_t brow, int tfirst, ColFn col) {
#pragma unroll
    for (int i = 0; i < NLD; ++i) {
        int idx = tid + i * NT;
        asm volatile("" : "+v"(idx));
        u32x4 v = {0u, 0u, 0u, 0u};
        if (idx < NROW * PPR) { const int r = idx / PPR, pc = idx - r * PPR; const int t = tfirst + r;
            if (t >= 0 && t < L) v = *(const u32x4*)(P + (brow + t) * PW + col(pc)); }
        reg[i] = v;
    }
}
template <int PPR, int NROW, int NLD, int NT = 512>
__device__ __forceinline__ void raw_store(const u32x4 (&reg)[NLD], bf16_t* raw, int tid) {
#pragma unroll
    for (int i = 0; i < NLD; ++i) { const int idx = tid + i * NT; if (idx < NROW * PPR) *(u32x4*)(raw + (size_t)idx * 8) = reg[i]; }
}

template <bool HG>
__device__ __forceinline__ void even_item(const Params& p, float* lds, int b, int h) {
    const bf16_t* P = (const bf16_t*)(p.ws + WS_BIG);
    bf16_t* Y = (bf16_t*)(p.ws + WS_A1);
    constexpr int QP = 136;
    float* O = lds; float* Gt = O + TCH * 128; float* PC = Gt + TCH * 128;
    bf16_t* Qt = (bf16_t*)(PC + 256); bf16_t* Kt = Qt + TCH * QP;
    bf16_t* KhT = Kt + TCH * QP; bf16_t* VT = KhT + 2 * 128 * 16;
    bf16_t* raw = VT + 2 * 128 * 16;
    constexpr int PPR = 64, NROW = 32, NLD = 4, RP = 512;
    const int tid = otid(), lane = tid & 63, w = tid >> 6;
    const int fn = lane & 15, g = lane >> 4, vs = w * 16;
    const int cbase = (HG ? 2048 : 0) + h * 128;
    auto col = [&](int pc) { return cbase + (pc >> 4) * 512 + (pc & 15) * 8; };
    const size_t brow = (size_t)b * L;
    const float gamma = 1.0f - exp2f(-5.0f - (float)h);
    const int d_ = tid & 127, c2_ = (tid >> 7) & 1, hf_ = tid >> 8;
    float lbv = 0.f; float2 hgn = make_float2(0.f, 0.f);
    if (HG) {
        const float* lg = p.in[5]; const int c = h * 128 + d_;
        const float l0 = lg[c], l1 = lg[512 + c], l2 = lg[1024 + c]; const float mx = fmaxf(l0, fmaxf(l1, l2));
        const float e0 = __expf(l0 - mx), e1 = __expf(l1 - mx), e2 = __expf(l2 - mx); lbv = e0 / (e0 + e1 + e2);
        hgn = *(const float2*)(p.in[6] + h * 128 + 2 * lane);
    }
    const float rinv = exp2f(-(float)(d_ & 63) * 0.20762050593046f) * 0.15915494309189535f;
    f32x4 S[8];
#pragma unroll
    for (int T = 0; T < 8; ++T) S[T] = (f32x4){0.f, 0.f, 0.f, 0.f};
    u32x4 rg[NLD];
    __syncthreads();
    raw_fetch<PPR, NROW, NLD>(rg, P, tid, brow, 0, col); raw_store<PPR, NROW, NLD>(rg, raw, tid);
    for (int t0 = 0; t0 < L; t0 += TCH) {
        const int ns = (L - t0) < TCH ? (L - t0) : TCH;
        const bool more = (t0 + TCH < L);
        __syncthreads();
        if (more) raw_fetch<PPR, NROW, NLD>(rg, P, tid, brow, t0 + TCH, col);
        if (hf_ == 0) {
            float Pc = 1.0f; float kt[16];
#pragma unroll
            for (int i = 0; i < 16; ++i) {
                const int t = c2_ * 16 + i; const bf16_t* rr = raw + t * RP;
                float q, k, f;
                if (!HG) {
                    const int dd = d_ & 63;
                    float r = (float)(t0 + t) * rinv; r -= floorf(r);
                    const float sn = __builtin_amdgcn_sinf(r), cs = __builtin_amdgcn_cosf(r);
                    const float q1 = bf2f(rr[dd]), q2 = bf2f(rr[64 + dd]), k1 = bf2f(rr[128 + dd]), k2 = bf2f(rr[192 + dd]);
                    q = (d_ < 64) ? (q1 * cs - q2 * sn) : (q1 * sn + q2 * cs);
                    k = ((d_ < 64) ? (k1 * cs - k2 * sn) : (k1 * sn + k2 * cs)) * 0.08838834764831845f;
                    f = gamma;
                } else {
                    q = bf2f(rr[d_]); const float sg = sigmoidf_(bf2f(rr[128 + d_]));
                    f = lbv + (1.0f - lbv) * sg; k = (1.0f - lbv) * (1.0f - sg);
                }
                Pc *= f;
                Qt[t * QP + d_] = f2bf(q * Pc);
                kt[i] = k * __builtin_amdgcn_rcpf(Pc);
                Kt[t * QP + d_] = f2bf(kt[i]);
            }
            PC[c2_ * 128 + d_] = Pc;
            u32x4 u0, u1;
            u0.x = cvt_pk_bf16(kt[0] * Pc, kt[1] * Pc); u0.y = cvt_pk_bf16(kt[2] * Pc, kt[3] * Pc); u0.z = cvt_pk_bf16(kt[4] * Pc, kt[5] * Pc); u0.w = cvt_pk_bf16(kt[6] * Pc, kt[7] * Pc);
            u1.x = cvt_pk_bf16(kt[8] * Pc, kt[9] * Pc); u1.y = cvt_pk_bf16(kt[10] * Pc, kt[11] * Pc); u1.z = cvt_pk_bf16(kt[12] * Pc, kt[13] * Pc); u1.w = cvt_pk_bf16(kt[14] * Pc, kt[15] * Pc);
            *(u32x4*)(KhT + (c2_ * 128 + d_) * 16) = u0; *(u32x4*)(KhT + (c2_ * 128 + d_) * 16 + 8) = u1;
        } else {
            float vv[16];
#pragma unroll
            for (int i = 0; i < 16; ++i) {
                const int t = c2_ * 16 + i; const bf16_t* rr = raw + t * RP;
                vv[i] = bf2f(rr[256 + d_]);
                Gt[t * 128 + d_] = siluf_(bf2f(rr[384 + d_]));
            }
            u32x4 u0, u1;
            u0.x = cvt_pk_bf16(vv[0], vv[1]); u0.y = cvt_pk_bf16(vv[2], vv[3]); u0.z = cvt_pk_bf16(vv[4], vv[5]); u0.w = cvt_pk_bf16(vv[6], vv[7]);
            u1.x = cvt_pk_bf16(vv[8], vv[9]); u1.y = cvt_pk_bf16(vv[10], vv[11]); u1.z = cvt_pk_bf16(vv[12], vv[13]); u1.w = cvt_pk_bf16(vv[14], vv[15]);
            *(u32x4*)(VT + (c2_ * 128 + d_) * 16) = u0; *(u32x4*)(VT + (c2_ * 128 + d_) * 16 + 8) = u1;
        }
        __syncthreads();
        for (int c2 = 0; c2 < 2; ++c2) {
            if (c2 * 16 >= ns) break;
            const bf16_t* qrow = Qt + (c2 * 16 + fn) * QP; const bf16_t* krow = Kt + (c2 * 16 + fn) * QP;
            f32x4 at4 = {0.f, 0.f, 0.f, 0.f};
#pragma unroll
            for (int ks = 0; ks < 4; ++ks) at4 = __builtin_amdgcn_mfma_f32_16x16x32_bf16(*(const bf16x8*)(krow + ks * 32 + g * 8), *(const bf16x8*)(qrow + ks * 32 + g * 8), at4, 0, 0, 0);
            u32x4 ua; ua.x = cvt_pk_bf16((4 * g + 0 <= fn) ? at4[0] : 0.f, (4 * g + 1 <= fn) ? at4[1] : 0.f); ua.y = cvt_pk_bf16((4 * g + 2 <= fn) ? at4[2] : 0.f, (4 * g + 3 <= fn) ? at4[3] : 0.f); ua.z = 0u; ua.w = 0u;
            const u32x2 vlo = *(const u32x2*)(VT + (c2 * 128 + vs + fn) * 16 + 4 * g);
            u32x4 uv; uv.x = vlo.x; uv.y = vlo.y; uv.z = 0u; uv.w = 0u;
            const bf16x8 vb = __builtin_bit_cast(bf16x8, uv);
            f32x4 oacc = __builtin_amdgcn_mfma_f32_16x16x32_bf16(__builtin_bit_cast(bf16x8, ua), vb, (f32x4){0.f, 0.f, 0.f, 0.f}, 0, 0, 0);
#pragma unroll
            for (int ks = 0; ks < 4; ++ks) {
                const u32x2 qa = *(const u32x2*)(qrow + (2 * ks) * 16 + 4 * g), qb = *(const u32x2*)(qrow + (2 * ks + 1) * 16 + 4 * g);
                u32x4 uq; uq.x = qa.x; uq.y = qa.y; uq.z = qb.x; uq.w = qb.y;
                u32x4 us; us.x = cvt_pk_bf16(S[2 * ks][0], S[2 * ks][1]); us.y = cvt_pk_bf16(S[2 * ks][2], S[2 * ks][3]); us.z = cvt_pk_bf16(S[2 * ks + 1][0], S[2 * ks + 1][1]); us.w = cvt_pk_bf16(S[2 * ks + 1][2], S[2 * ks + 1][3]);
                oacc = __builtin_amdgcn_mfma_f32_16x16x32_bf16(__builtin_bit_cast(bf16x8, uq), __builtin_bit_cast(bf16x8, us), oacc, 0, 0, 0);
            }
#pragma unroll
            for (int jj = 0; jj < 4; ++jj) O[(c2 * 16 + 4 * g + jj) * 128 + vs + fn] = oacc[jj];
#pragma unroll
            for (int T = 0; T < 8; ++T) {
                const float4 pc4 = *(const float4*)(PC + c2 * 128 + T * 16 + 4 * g);
                const u32x2 kh = *(const u32x2*)(KhT + (c2 * 128 + T * 16 + fn) * 16 + 4 * g);
                u32x4 uk; uk.x = kh.x; uk.y = kh.y; uk.z = 0u; uk.w = 0u;
                f32x4 sc = S[T]; sc[0] *= pc4.x; sc[1] *= pc4.y; sc[2] *= pc4.z; sc[3] *= pc4.w;
                S[T] = __builtin_amdgcn_mfma_f32_16x16x32_bf16(__builtin_bit_cast(bf16x8, uk), vb, sc, 0, 0, 0);
            }
        }
        if (more) raw_store<PPR, NROW, NLD>(rg, raw, tid);
        __syncthreads();
        for (int t = w; t < ns; t += 8) {
            const size_t row = brow + t0 + t;
            const float2 o2 = *(const float2*)(O + t * 128 + lane * 2);
            const float2 g2 = *(const float2*)(Gt + t * 128 + lane * 2);
            const int v = lane * 2;
            if (!HG) {
                const float mean = wave_sum(o2.x + o2.y) * (1.0f / 128.0f);
                const float x0 = o2.x - mean, x1 = o2.y - mean;
                const float var = wave_sum(x0 * x0 + x1 * x1) * (1.0f / 128.0f);
                const float rs = rsqrtf(var + EPS);
                *(unsigned*)(Y + row * D + h * 128 + v) = cvt_pk_bf16(x0 * rs * g2.x, x1 * rs * g2.y);
            } else {
                const float ms = wave_sum(o2.x * o2.x + o2.y * o2.y) * (1.0f / 128.0f);
                const float rs = rsqrtf(ms + EPS);
                *(unsigned*)(Y + row * D + 512 + h * 128 + v) = cvt_pk_bf16(o2.x * rs * hgn.x * g2.x, o2.y * rs * hgn.y * g2.y);
            }
        }
    }
}
__device__ __forceinline__ void even_scan_phase(const Params& p, float* lds) {
    for (int item = obid(); item < 256; item += gridDim.x) {
        const int idx = item & 127, b = idx >> 2, h = idx & 3;
        if (item < 128) even_item<false>(p, lds, b, h); else even_item<true>(p, lds, b, h);
        __syncthreads();
    }
}

typedef float f32x2 __attribute__((ext_vector_type(2)));
constexpr int TCR = 16;
constexpr int RW_ITEM_FLOATS = 16256;
__device__ __forceinline__ void rwkv_half(const Params& p, float* lds, int b, int h, int half) {
    const bf16_t* P = (const bf16_t*)(p.ws + WS_BIG);
    bf16_t* Y = (bf16_t*)(p.ws + WS_Y2);
    float* R = lds; float* W = R + TCR * 64; float* Kk = W + TCR * 64; float* Vv = Kk + TCR * 64; float* A = Vv + TCR * 64; float* Bb = A + TCR * 64;
    float* O = Bb + TCR * 64; float* G = O + TCR * 64; float* RK = G + TCR * 64; float* WP = RK + 64; float* AP = WP + TCR * 64;
    constexpr int LAP = 264;
    bf16_t* LAb = (bf16_t*)(AP + TCR * 64);
    bf16_t* LAbS = (bf16_t*)((lds - half * RW_ITEM_FLOATS) + (8 * TCR * 64 + 64 + 2 * TCR * 64));
    bf16_t* raw = LAb + TCR * LAP;
    constexpr int PPR = 56, NROW = 17, NLD = 4, RP = 448;
    const float* mu = p.in[9]; const float* w2 = p.in[11]; const float* a2 = p.in[13]; const float* g2 = p.in[14];
    const int tid = otid() & 255, lane = tid & 63, lw = tid >> 6;
    const int kg = lane & 7, vp = lw * 8 + (lane >> 3);
    const int hc = h * 64 + lane;
    auto col = [&](int pc) { return pc < 24 ? (pc >> 3) * 512 + h * 64 + (pc & 7) * 8 : 1536 + (pc - 24) * 8; };
    const size_t brow = (size_t)b * L;
    const int j1 = tid; const float mu1 = mu[1536 + j1];
    const int tq = tid >> 4, cl = tid & 15, hc4 = h * 64 + 4 * cl;
    const float4 mu_r = *(const float4*)(mu + hc4), mu_k = *(const float4*)(mu + 512 + hc4), mu_v = *(const float4*)(mu + 1024 + hc4);
    const float4 w0c = *(const float4*)(p.in[10] + hc4), a0c = *(const float4*)(p.in[12] + hc4), kksc = *(const float4*)(p.in[15] + hc4), kasc = *(const float4*)(p.in[16] + hc4);
    const float4 rkc = *(const float4*)(p.in[17] + hc4), lnwc = *(const float4*)(p.in[18] + hc4), lnbc = *(const float4*)(p.in[19] + hc4);
    f32x2 S[8];
#pragma unroll
    for (int i = 0; i < 8; ++i) S[i] = (f32x2){0.f, 0.f};
    const int fn = lane & 15, fkq = lane >> 4;
    bf16x8 bw[2], ba[2], bg[4];
    {
        const int cc = h * 64 + lw * 16 + fn;
#pragma unroll
        for (int ks = 0; ks < 2; ++ks) {
            float e[8], f[8];
#pragma unroll
            for (int j = 0; j < 8; ++j) { e[j] = w2[(ks * 32 + fkq * 8 + j) * 512 + cc]; f[j] = a2[(ks * 32 + fkq * 8 + j) * 512 + cc]; }
            u32x4 u; u.x = cvt_pk_bf16(e[0], e[1]); u.y = cvt_pk_bf16(e[2], e[3]); u.z = cvt_pk_bf16(e[4], e[5]); u.w = cvt_pk_bf16(e[6], e[7]); bw[ks] = __builtin_bit_cast(bf16x8, u);
            u.x = cvt_pk_bf16(f[0], f[1]); u.y = cvt_pk_bf16(f[2], f[3]); u.z = cvt_pk_bf16(f[4], f[5]); u.w = cvt_pk_bf16(f[6], f[7]); ba[ks] = __builtin_bit_cast(bf16x8, u);
        }
#pragma unroll
        for (int ks = 0; ks < 4; ++ks) {
            float e[8];
#pragma unroll
            for (int j = 0; j < 8; ++j) e[j] = g2[(ks * 32 + fkq * 8 + j) * 512 + cc];
            u32x4 u; u.x = cvt_pk_bf16(e[0], e[1]); u.y = cvt_pk_bf16(e[2], e[3]); u.z = cvt_pk_bf16(e[4], e[5]); u.w = cvt_pk_bf16(e[6], e[7]); bg[ks] = __builtin_bit_cast(bf16x8, u);
        }
    }
    u32x4 rg[NLD];
    __syncthreads();
    raw_fetch<PPR, NROW, NLD, 256>(rg, P, tid, brow, -1, col); raw_store<PPR, NROW, NLD, 256>(rg, raw, tid);
    for (int t0 = 0; t0 < L; t0 += TCR) {
        const bool more = (t0 + TCR < L);
        if (t0 == 0) __syncthreads();
#pragma unroll 4
        for (int t = half * 8; t < half * 8 + 8; ++t) {
            const float cur = bf2f(raw[(t + 1) * RP + 192 + j1]), prev = bf2f(raw[t * RP + 192 + j1]);
            const float x = cur + (prev - cur) * mu1;
            float y;
            if (j1 < 64) y = 1.0f - 2.0f * __builtin_amdgcn_rcpf(1.0f + __expf(2.0f * x)); else if (j1 < 128) y = x; else y = sigmoidf_(x);
            LAbS[t * LAP + j1] = f2bf(y);
        }
        __syncthreads();
        {
            const bf16_t* ap = LAbS + fn * LAP + fkq * 8;
            f32x4 cw4 = {0.f, 0.f, 0.f, 0.f}, ca4 = {0.f, 0.f, 0.f, 0.f}, cg4 = {0.f, 0.f, 0.f, 0.f};
#pragma unroll
            for (int ks = 0; ks < 2; ++ks) cw4 = __builtin_amdgcn_mfma_f32_16x16x32_bf16(*(const bf16x8*)(ap + ks * 32), bw[ks], cw4, 0, 0, 0);
#pragma unroll
            for (int ks = 0; ks < 2; ++ks) ca4 = __builtin_amdgcn_mfma_f32_16x16x32_bf16(*(const bf16x8*)(ap + 64 + ks * 32), ba[ks], ca4, 0, 0, 0);
#pragma unroll
            for (int ks = 0; ks < 4; ++ks) cg4 = __builtin_amdgcn_mfma_f32_16x16x32_bf16(*(const bf16x8*)(ap + 128 + ks * 32), bg[ks], cg4, 0, 0, 0);
#pragma unroll
            for (int j = 0; j < 4; ++j) { const int o = (fkq * 4 + j) * 64 + lw * 16 + fn; WP[o] = cw4[j]; AP[o] = ca4[j]; G[o] = cg4[j]; }
        }
        __syncthreads();
        {
            const int t = tq;
            const u32x2 c0 = *(const u32x2*)(raw + (t + 1) * RP + 4 * cl), c1 = *(const u32x2*)(raw + (t + 1) * RP + 64 + 4 * cl), c2v = *(const u32x2*)(raw + (t + 1) * RP + 128 + 4 * cl);
            const u32x2 p0 = *(const u32x2*)(raw + t * RP + 4 * cl), p1 = *(const u32x2*)(raw + t * RP + 64 + 4 * cl), p2 = *(const u32x2*)(raw + t * RP + 128 + 4 * cl);
            auto up4 = [](u32x2 u, float (&o)[4]) { o[0] = __uint_as_float(u.x << 16); o[1] = __uint_as_float(u.x & 0xffff0000u); o[2] = __uint_as_float(u.y << 16); o[3] = __uint_as_float(u.y & 0xffff0000u); };
            float cr[4], ck[4], cv[4], pr[4], pk[4], pv[4];
            up4(c0, cr); up4(c1, ck); up4(c2v, cv); up4(p0, pr); up4(p1, pk); up4(p2, pv);
            const float4 wp4 = *(const float4*)(WP + t * 64 + 4 * cl), ap4 = *(const float4*)(AP + t * 64 + 4 * cl);
            const float mur[4] = {mu_r.x, mu_r.y, mu_r.z, mu_r.w}, muk[4] = {mu_k.x, mu_k.y, mu_k.z, mu_k.w}, muv[4] = {mu_v.x, mu_v.y, mu_v.z, mu_v.w};
            const float w0a[4] = {w0c.x, w0c.y, w0c.z, w0c.w}, a0a[4] = {a0c.x, a0c.y, a0c.z, a0c.w}, kksa[4] = {kksc.x, kksc.y, kksc.z, kksc.w}, kasa[4] = {kasc.x, kasc.y, kasc.z, kasc.w}, rka[4] = {rkc.x, rkc.y, rkc.z, rkc.w};
            const float wpa[4] = {wp4.x, wp4.y, wp4.z, wp4.w}, apa[4] = {ap4.x, ap4.y, ap4.z, ap4.w};
            float rr[4], kr[4], vr[4], dec[4], av[4], kkr[4], kmod[4]; float ssq = 0.f, rks = 0.f;
#pragma unroll
            for (int e = 0; e < 4; ++e) {
                rr[e] = cr[e] + (pr[e] - cr[e]) * mur[e]; kr[e] = ck[e] + (pk[e] - ck[e]) * muk[e]; vr[e] = cv[e] + (pv[e] - cv[e]) * muv[e];
                const float lw_ = -softplusf_(-(w0a[e] + wpa[e])) - 0.5f;
                dec[e] = __expf(-__expf(lw_));
                av[e] = sigmoidf_(a0a[e] + apa[e]);
                kkr[e] = kr[e] * kksa[e]; ssq += kkr[e] * kkr[e];
                kmod[e] = kr[e] * (1.0f + (av[e] - 1.0f) * kasa[e]);
                rks += rr[e] * kmod[e] * rka[e];
            }
            ssq = allreduce16(ssq); rks = allreduce16(rks);
            const float rn = rsqrtf(ssq + EPS);
            *(float4*)(R + t * 64 + 4 * cl) = make_float4(rr[0], rr[1], rr[2], rr[3]);
            *(float4*)(W + t * 64 + 4 * cl) = make_float4(dec[0], dec[1], dec[2], dec[3]);
            *(float4*)(Kk + t * 64 + 4 * cl) = make_float4(kmod[0], kmod[1], kmod[2], kmod[3]);
            *(float4*)(Vv + t * 64 + 4 * cl) = make_float4(vr[0], vr[1], vr[2], vr[3]);
            *(float4*)(A + t * 64 + 4 * cl) = make_float4(-kkr[0] * rn, -kkr[1] * rn, -kkr[2] * rn, -kkr[3] * rn);
            *(float4*)(Bb + t * 64 + 4 * cl) = make_float4(kkr[0] * rn * av[0], kkr[1] * rn * av[1], kkr[2] * rn * av[2], kkr[3] * rn * av[3]);
            if (cl == 0) RK[t] = rks;
        }
        __syncthreads();
        if (more) raw_fetch<PPR, NROW, NLD, 256>(rg, P, tid, brow, t0 + TCR - 1, col);
        {
            struct Ops { float4 aa, ab, wa, wb, ba, bb, ka, kb, ra, rb; float2 vv; };
            auto ld = [&](Ops& o, int t) {
                o.aa = *(const float4*)(A + t * 64 + kg * 8); o.ab = *(const float4*)(A + t * 64 + kg * 8 + 4);
                o.wa = *(const float4*)(W + t * 64 + kg * 8); o.wb = *(const float4*)(W + t * 64 + kg * 8 + 4);
                o.ba = *(const float4*)(Bb + t * 64 + kg * 8); o.bb = *(const float4*)(Bb + t * 64 + kg * 8 + 4);
                o.ka = *(const float4*)(Kk + t * 64 + kg * 8); o.kb = *(const float4*)(Kk + t * 64 + kg * 8 + 4);
                o.ra = *(const float4*)(R + t * 64 + kg * 8); o.rb = *(const float4*)(R + t * 64 + kg * 8 + 4);
                o.vv = *(const float2*)(Vv + t * 64 + 2 * vp);
            };
            auto step = [&](const Ops& x, int t) {
                const float a8[8] = {x.aa.x, x.aa.y, x.aa.z, x.aa.w, x.ab.x, x.ab.y, x.ab.z, x.ab.w};
                const float w8[8] = {x.wa.x, x.wa.y, x.wa.z, x.wa.w, x.wb.x, x.wb.y, x.wb.z, x.wb.w};
                const float b8[8] = {x.ba.x, x.ba.y, x.ba.z, x.ba.w, x.bb.x, x.bb.y, x.bb.z, x.bb.w};
                const float k8[8] = {x.ka.x, x.ka.y, x.ka.z, x.ka.w, x.kb.x, x.kb.y, x.kb.z, x.kb.w};
                const float r8[8] = {x.ra.x, x.ra.y, x.ra.z, x.ra.w, x.rb.x, x.rb.y, x.rb.z, x.rb.w};
                const f32x2 vv2 = {x.vv.x, x.vv.y};
                f32x2 sa0 = {0.f, 0.f}, sa1 = {0.f, 0.f};
#pragma unroll
                for (int i = 0; i < 8; i += 2) { sa0 += S[i] * a8[i]; sa1 += S[i + 1] * a8[i + 1]; }
                f32x2 sa = sa0 + sa1; sa.x = allreduce8(sa.x); sa.y = allreduce8(sa.y);
                f32x2 y0 = {0.f, 0.f}, y1 = {0.f, 0.f};
#pragma unroll
                for (int i = 0; i < 8; i += 2) {
                    S[i] = S[i] * w8[i] + sa * b8[i] + vv2 * k8[i]; y0 += S[i] * r8[i];
                    S[i + 1] = S[i + 1] * w8[i + 1] + sa * b8[i + 1] + vv2 * k8[i + 1]; y1 += S[i + 1] * r8[i + 1];
                }
                f32x2 y = y0 + y1; y.x = allreduce8(y.x); y.y = allreduce8(y.y);
                if (kg == 0) *(float2*)(O + t * 64 + 2 * vp) = make_float2(y.x, y.y);
            };
            Ops A_, B_; ld(A_, 0);
#pragma unroll
            for (int t = 0; t < TCR; t += 2) {
                ld(B_, t + 1); step(A_, t);
                if (t + 2 < TCR) ld(A_, t + 2);
                step(B_, t + 1);
            }
        }
        if (more) raw_store<PPR, NROW, NLD, 256>(rg, raw, tid);
        __syncthreads();
        {
            const int t = tq; const size_t row = brow + t0 + t;
            const float4 y4 = *(const float4*)(O + t * 64 + 4 * cl), v4 = *(const float4*)(Vv + t * 64 + 4 * cl), g4 = *(const float4*)(G + t * 64 + 4 * cl);
            const float mean = allreduce16((y4.x + y4.y) + (y4.z + y4.w)) * (1.0f / 64.0f);
            const float x0 = y4.x - mean, x1 = y4.y - mean, x2 = y4.z - mean, x3 = y4.w - mean;
            const float var = allreduce16((x0 * x0 + x1 * x1) + (x2 * x2 + x3 * x3)) * (1.0f / 64.0f);
            const float rs = rsqrtf(var + 64e-5f), rkt = RK[t];
            const float o0 = (x0 * rs * lnwc.x + lnbc.x + rkt * v4.x) * g4.x, o1 = (x1 * rs * lnwc.y + lnbc.y + rkt * v4.y) * g4.y;
            const float o2 = (x2 * rs * lnwc.z + lnbc.z + rkt * v4.z) * g4.z, o3 = (x3 * rs * lnwc.w + lnbc.w + rkt * v4.w) * g4.w;
            u32x2 ow; ow.x = cvt_pk_bf16(o0, o1); ow.y = cvt_pk_bf16(o2, o3);
            *(u32x2*)(Y + row * D + hc4) = ow;
        }
    }
}
template <int CTRL> __device__ __forceinline__ float dpp0f(float x) { return __int_as_float(__builtin_amdgcn_update_dpp(0, __float_as_int(x), CTRL, 0xF, 0xF, true)); }
__device__ __forceinline__ void gdn_item(const Params& p, float* lds, int b, int h) {
    const bf16_t* P = (const bf16_t*)(p.ws + WS_BIG);
    bf16_t* Y = (bf16_t*)(p.ws + WS_Y2);
    constexpr int QP = 136, MP = 24;
    float* O = lds; float* Gt = O + TCH * 128; float* GB = Gt + TCH * 128; float* CG = GB + 64;
    bf16_t* MinvB = (bf16_t*)(CG + 64); bf16_t* MinvE = MinvB + 2 * 16 * MP;
    bf16_t* Qb = MinvE + 2 * 16 * MP; bf16_t* Kb = Qb + TCH * QP; bf16_t* Wb = Kb + TCH * QP;
    bf16_t* KT = Wb + TCH * QP; bf16_t* VT = KT + 2 * 128 * 16;
    bf16_t* raw = VT + 2 * 128 * 16;
    constexpr int PPR = 65, NROW = 35, NLD = 5, RP = 520;
    const float* cw = p.in[20];
    const int tid = otid(), lane = tid & 63, w = tid >> 6;
    const int fn = lane & 15, g = lane >> 4, vs = w * 16;
    auto col = [&](int pc) { return pc < 48 ? 1792 + (pc >> 4) * 512 + h * 128 + (pc & 15) * 8 : (pc < 64 ? 3328 + h * 128 + (pc - 48) * 8 : 3840); };
    const size_t brow = (size_t)b * L;
    const float Aneg = -__expf(p.in[21][h]); const float dtb = p.in[22][h];
    const float2 gn = *(const float2*)(p.in[23] + 2 * lane);
    float cwr[3][4][2];
#pragma unroll
    for (int x = 0; x < 3; ++x)
#pragma unroll
        for (int j = 0; j < 4; ++j) { cwr[x][j][0] = cw[j * 1536 + x * 512 + h * 128 + 2 * lane]; cwr[x][j][1] = cw[j * 1536 + x * 512 + h * 128 + 2 * lane + 1]; }
    f32x4 S[8];
#pragma unroll
    for (int T = 0; T < 8; ++T) S[T] = (f32x4){0.f, 0.f, 0.f, 0.f};
    u32x4 rg[NLD];
    __syncthreads();
    raw_fetch<PPR, NROW, NLD>(rg, P, tid, brow, -3, col); raw_store<PPR, NROW, NLD>(rg, raw, tid);
    for (int t0 = 0; t0 < L; t0 += TCH) {
        const int ns = (L - t0) < TCH ? (L - t0) : TCH;
        const bool more = (t0 + TCH < L);
        __syncthreads();
        if (more) raw_fetch<PPR, NROW, NLD>(rg, P, tid, brow, t0 + TCH - 3, col);
        for (int t = w; t < ns; t += 8) {
            float xs[3][2];
#pragma unroll
            for (int x = 0; x < 3; ++x) {
                float a0 = 0.f, a1 = 0.f;
#pragma unroll
                for (int j = 0; j < 4; ++j) {
                    const unsigned wv = *(const unsigned*)(raw + (t + j) * RP + x * 128 + 2 * lane);
                    a0 += cwr[x][j][0] * __uint_as_float(wv << 16); a1 += cwr[x][j][1] * __uint_as_float(wv & 0xffff0000u);
                }
                xs[x][0] = siluf_(a0); xs[x][1] = siluf_(a1);
            }
            const float sq = wave_sum(xs[0][0] * xs[0][0] + xs[0][1] * xs[0][1]);
            const float sk = wave_sum(xs[1][0] * xs[1][0] + xs[1][1] * xs[1][1]);
            const float rq = rsqrtf(sq + EPS) * 0.08838834764831845f, rk = rsqrtf(sk + EPS);
            const int c2 = t >> 4, i = t & 15;
            *(unsigned*)(Qb + t * QP + 2 * lane) = cvt_pk_bf16(xs[0][0] * rq, xs[0][1] * rq);
            const unsigned kw = cvt_pk_bf16(xs[1][0] * rk, xs[1][1] * rk);
            *(unsigned*)(Kb + t * QP + 2 * lane) = kw;
            KT[(c2 * 128 + 2 * lane) * 16 + i] = (bf16_t)(kw & 0xffffu); KT[(c2 * 128 + 2 * lane + 1) * 16 + i] = (bf16_t)(kw >> 16);
            const unsigned vw = cvt_pk_bf16(xs[2][0], xs[2][1]);
            VT[(c2 * 128 + 2 * lane) * 16 + i] = (bf16_t)(vw & 0xffffu); VT[(c2 * 128 + 2 * lane + 1) * 16 + i] = (bf16_t)(vw >> 16);
            const unsigned gw = *(const unsigned*)(raw + (t + 3) * RP + 384 + 2 * lane);
            *(float2*)(Gt + t * 128 + 2 * lane) = make_float2(siluf_(__uint_as_float(gw << 16)), siluf_(__uint_as_float(gw & 0xffff0000u)));
            if (lane == 0) {
                const float al = bf2f(raw[(t + 3) * RP + 512 + h]), be = bf2f(raw[(t + 3) * RP + 516 + h]);
                GB[t * 2] = Aneg * softplusf_(al + dtb); GB[t * 2 + 1] = sigmoidf_(be);
            }
        }
        __syncthreads();
        if (w < 2 && w * 16 < ns) {
            const int c2 = w;
            float cgf = GB[(c2 * 16 + fn) * 2]; const float betf = GB[(c2 * 16 + fn) * 2 + 1];
            cgf += dpp0f<0x111>(cgf); cgf += dpp0f<0x112>(cgf); cgf += dpp0f<0x114>(cgf); cgf += dpp0f<0x118>(cgf);
            if (g == 0) CG[c2 * 16 + fn] = cgf;
            const bf16_t* krow = Kb + (c2 * 16 + fn) * QP;
            f32x4 kk4 = {0.f, 0.f, 0.f, 0.f};
#pragma unroll
            for (int ks = 0; ks < 4; ++ks) { const bf16x8 kf = *(const bf16x8*)(krow + ks * 32 + g * 8); kk4 = __builtin_amdgcn_mfma_f32_16x16x32_bf16(kf, kf, kk4, 0, 0, 0); }
            const float4 cga = *(const float4*)(CG + c2 * 16 + 4 * g);
            const float cga4[4] = {cga.x, cga.y, cga.z, cga.w};
            float m4[4];
#pragma unroll
            for (int jj = 0; jj < 4; ++jj) { const float ba = GB[(c2 * 16 + 4 * g + jj) * 2 + 1]; m4[jj] = (fn < 4 * g + jj) ? ba * kk4[jj] * __expf(cga4[jj] - cgf) : 0.f; }
            float x[16];
#pragma unroll
            for (int i = 0; i < 16; ++i) {
                float acc = (fn == i) ? 1.f : 0.f;
#pragma unroll
                for (int j = 0; j < i; ++j) {
                    const float mij = __int_as_float(__builtin_amdgcn_readlane(__float_as_int(m4[i & 3]), j + 16 * (i >> 2)));
                    acc -= mij * x[j];
                }
                x[i] = acc;
            }
            if (g == 0) {
                const float eb = betf * __expf(cgf);
#pragma unroll
                for (int i = 0; i < 16; ++i) { MinvB[(c2 * 16 + i) * MP + fn] = f2bf(x[i] * betf); MinvE[(c2 * 16 + i) * MP + fn] = f2bf(x[i] * eb); }
            }
        }
        __syncthreads();
        for (int c2 = 0; c2 < 2; ++c2) {
            if (c2 * 16 >= ns) break;
            const u32x2 ma = *(const u32x2*)(MinvE + (c2 * 16 + fn) * MP + 4 * g); const u32x2 kt = *(const u32x2*)(KT + (c2 * 128 + vs + fn) * 16 + 4 * g);
            u32x4 ua; ua.x = ma.x; ua.y = ma.y; ua.z = 0u; ua.w = 0u; u32x4 ub; ub.x = kt.x; ub.y = kt.y; ub.z = 0u; ub.w = 0u;
            const f32x4 c4 = __builtin_amdgcn_mfma_f32_16x16x32_bf16(__builtin_bit_cast(bf16x8, ua), __builtin_bit_cast(bf16x8, ub), (f32x4){0.f, 0.f, 0.f, 0.f}, 0, 0, 0);
#pragma unroll
            for (int jj = 0; jj < 4; ++jj) Wb[(c2 * 16 + 4 * g + jj) * QP + vs + fn] = f2bf(c4[jj]);
        }
        __syncthreads();
        for (int c2 = 0; c2 < 2; ++c2) {
            if (c2 * 16 >= ns) break;
            const float4 cgt = *(const float4*)(CG + c2 * 16 + 4 * g); const float cgt4[4] = {cgt.x, cgt.y, cgt.z, cgt.w};
            const float cgf = CG[c2 * 16 + fn], cg15 = CG[c2 * 16 + 15];
            const bf16_t* qrow = Qb + (c2 * 16 + fn) * QP; const bf16_t* krow = Kb + (c2 * 16 + fn) * QP; const bf16_t* wrow = Wb + (c2 * 16 + fn) * QP;
            f32x4 at4 = {0.f, 0.f, 0.f, 0.f};
#pragma unroll
            for (int ks = 0; ks < 4; ++ks) at4 = __builtin_amdgcn_mfma_f32_16x16x32_bf16(*(const bf16x8*)(krow + ks * 32 + g * 8), *(const bf16x8*)(qrow + ks * 32 + g * 8), at4, 0, 0, 0);
            float qv[4];
#pragma unroll
            for (int jj = 0; jj < 4; ++jj) qv[jj] = (4 * g + jj <= fn) ? at4[jj] * __expf(cgf - cgt4[jj]) : 0.f;
            u32x4 uqk; uqk.x = cvt_pk_bf16(qv[0], qv[1]); uqk.y = cvt_pk_bf16(qv[2], qv[3]); uqk.z = 0u; uqk.w = 0u;
            const u32x2 mb = *(const u32x2*)(MinvB + (c2 * 16 + fn) * MP + 4 * g); const u32x2 vt = *(const u32x2*)(VT + (c2 * 128 + vs + fn) * 16 + 4 * g);
            u32x4 uma; uma.x = mb.x; uma.y = mb.y; uma.z = 0u; uma.w = 0u; u32x4 uvt; uvt.x = vt.x; uvt.y = vt.y; uvt.z = 0u; uvt.w = 0u;
            const f32x4 u4 = __builtin_amdgcn_mfma_f32_16x16x32_bf16(__builtin_bit_cast(bf16x8, uma), __builtin_bit_cast(bf16x8, uvt), (f32x4){0.f, 0.f, 0.f, 0.f}, 0, 0, 0);
            f32x4 ws4 = {0.f, 0.f, 0.f, 0.f}, qs4 = {0.f, 0.f, 0.f, 0.f};
#pragma unroll
            for (int ks = 0; ks < 4; ++ks) {
                u32x4 us; us.x = cvt_pk_bf16(S[2 * ks][0], S[2 * ks][1]); us.y = cvt_pk_bf16(S[2 * ks][2], S[2 * ks][3]); us.z = cvt_pk_bf16(S[2 * ks + 1][0], S[2 * ks + 1][1]); us.w = cvt_pk_bf16(S[2 * ks + 1][2], S[2 * ks + 1][3]);
                const bf16x8 sb = __builtin_bit_cast(bf16x8, us);
                const u32x2 wa = *(const u32x2*)(wrow + (2 * ks) * 16 + 4 * g), wb2 = *(const u32x2*)(wrow + (2 * ks + 1) * 16 + 4 * g);
                u32x4 uw; uw.x = wa.x; uw.y = wa.y; uw.z = wb2.x; uw.w = wb2.y;
                ws4 = __builtin_amdgcn_mfma_f32_16x16x32_bf16(__builtin_bit_cast(bf16x8, uw), sb, ws4, 0, 0, 0);
                const u32x2 qa = *(const u32x2*)(qrow + (2 * ks) * 16 + 4 * g), qb2 = *(const u32x2*)(qrow + (2 * ks + 1) * 16 + 4 * g);
                u32x4 uq; uq.x = qa.x; uq.y = qa.y; uq.z = qb2.x; uq.w = qb2.y;
                qs4 = __builtin_amdgcn_mfma_f32_16x16x32_bf16(__builtin_bit_cast(bf16x8, uq), sb, qs4, 0, 0, 0);
            }
            float vn[4];
#pragma unroll
            for (int jj = 0; jj < 4; ++jj) { vn[jj] = u4[jj] - ws4[jj]; qs4[jj] *= __expf(cgt4[jj]); }
            u32x4 uvn; uvn.x = cvt_pk_bf16(vn[0], vn[1]); uvn.y = cvt_pk_bf16(vn[2], vn[3]); uvn.z = 0u; uvn.w = 0u;
            const f32x4 o4 = __builtin_amdgcn_mfma_f32_16x16x32_bf16(__builtin_bit_cast(bf16x8, uqk), __builtin_bit_cast(bf16x8, uvn), qs4, 0, 0, 0);
#pragma unroll
            for (int jj = 0; jj < 4; ++jj) O[(c2 * 16 + 4 * g + jj) * 128 + vs + fn] = o4[jj];
            u32x4 uvd; uvd.x = cvt_pk_bf16(vn[0] * __expf(cg15 - cgt4[0]), vn[1] * __expf(cg15 - cgt4[1])); uvd.y = cvt_pk_bf16(vn[2] * __expf(cg15 - cgt4[2]), vn[3] * __expf(cg15 - cgt4[3])); uvd.z = 0u; uvd.w = 0u;
            const bf16x8 vdb = __builtin_bit_cast(bf16x8, uvd);
            const float e15 = __expf(cg15);
#pragma unroll
            for (int T = 0; T < 8; ++T) {
                const u32x2 kh = *(const u32x2*)(KT + (c2 * 128 + T * 16 + fn) * 16 + 4 * g);
                u32x4 uk; uk.x = kh.x; uk.y = kh.y; uk.z = 0u; uk.w = 0u;
                f32x4 sc = S[T]; sc[0] *= e15; sc[1] *= e15; sc[2] *= e15; sc[3] *= e15;
                S[T] = __builtin_amdgcn_mfma_f32_16x16x32_bf16(__builtin_bit_cast(bf16x8, uk), vdb, sc, 0, 0, 0);
            }
        }
        if (more) raw_store<PPR, NROW, NLD>(rg, raw, tid);
        __syncthreads();
        for (int t = w; t < ns; t += 8) {
            const size_t row = brow + t0 + t;
            const float2 o2 = *(const float2*)(O + t * 128 + lane * 2);
            const float2 g2 = *(const float2*)(Gt + t * 128 + lane * 2);
            const int v = lane * 2;
            const float ms = wave_sum(o2.x * o2.x + o2.y * o2.y) * (1.0f / 128.0f);
            const float rs = rsqrtf(ms + EPS);
            *(unsigned*)(Y + row * D + 512 + h * 128 + v) = cvt_pk_bf16(o2.x * rs * gn.x * g2.x, o2.y * rs * gn.y * g2.y);
        }
    }
}
__device__ __forceinline__ void odd_scan_phase(const Params& p, float* lds) {
    for (int item = obid(); item < 256; item += gridDim.x) {
        if (item < 128) { gdn_item(p, lds, item >> 2, item & 3); __syncthreads(); }
        else {
            const int half = otid() >> 8; const int i0 = (item - 128) * 2 + half;
            rwkv_half(p, lds + half * RW_ITEM_FLOATS, i0 >> 3, i0 & 7, half); __syncthreads();
        }
    }
}

#define XB_TMO      128
#define XB_XCNT(j)  (256  + 64 * (j))
#define XB_XSUB(j)  (1280 + 64 * (j))
#define XB_XGEN(j)  (2304 + 64 * (j))
#define XB_TOP      3328
#define XB_TOPGEN   3392
#define XCD_BAR_WORDS 3456
#define XB_SPIN_CAP (1u << 18)
__device__ __forceinline__ unsigned xb_ld(unsigned* p)              { return __hip_atomic_load(p, __ATOMIC_RELAXED, __HIP_MEMORY_SCOPE_AGENT); }
__device__ __forceinline__ unsigned xb_add(unsigned* p, unsigned v) { return __hip_atomic_fetch_add(p, v, __ATOMIC_RELAXED, __HIP_MEMORY_SCOPE_AGENT); }
__device__ __forceinline__ unsigned xb_xcc_id() { return (unsigned)__builtin_amdgcn_s_getreg((3 << 11) | 20) & 0xFu; }
#define XB_SPIN(cond, bar) do { unsigned _sp = 0; while (cond) { __builtin_amdgcn_s_sleep(1); \
    if ((++_sp & 255u) == 0u) { if (xb_ld(&(bar)[XB_TMO])) break; if (_sp > XB_SPIN_CAP) { atomicAdd(&(bar)[XB_TMO], 1u); break; } } } } while (0)
struct XcdBarrier { unsigned* bar; unsigned x; volatile LAS unsigned* st; };
__device__ __forceinline__ XcdBarrier xcd_barrier_post(unsigned* bar, volatile LAS unsigned* st) {
    XcdBarrier b; b.bar = bar; b.x = xb_xcc_id(); b.st = st;
    if (threadIdx.x == 0) (void)xb_add(&bar[XB_XCNT(b.x)], 1u);
    return b;
}
__device__ __forceinline__ void xcd_barrier_complete(unsigned* bar, unsigned x, unsigned& nloc, unsigned& nx) {
    const unsigned G = gridDim.x * gridDim.y * gridDim.z;
    unsigned sum, cnt, mine, sp = 0u;
    for (;;) {
        sum = 0u; cnt = 0u; mine = 0u;
#pragma unroll
        for (unsigned j = 0; j < 16; ++j) { const unsigned c = xb_ld(&bar[XB_XCNT(j)]); sum += c; cnt += (c > 0u) ? 1u : 0u; mine = (j == x) ? c : mine; }
        if (sum == G) break;
        __builtin_amdgcn_s_sleep(1);
        if ((++sp & 255u) == 0u) { if (xb_ld(&bar[XB_TMO])) break; if (sp > XB_SPIN_CAP) { atomicAdd(&bar[XB_TMO], 1u); break; } }
    }
    nloc = mine > 0u ? mine : 1u; nx = cnt > 0u ? cnt : 1u;
}
__device__ __forceinline__ void xcd_barrier(const XcdBarrier& b) {
    asm volatile("s_waitcnt vmcnt(0)" ::: "memory");
    __syncthreads();
    if (threadIdx.x == 0) {
        unsigned* bar = b.bar;
        __builtin_amdgcn_s_waitcnt(0);
        unsigned nloc = b.st[0], nx = b.st[1];
        if (nloc == 0u) { xcd_barrier_complete(bar, b.x, nloc, nx); b.st[0] = nloc; b.st[1] = nx; }
        const unsigned old = xb_add(&bar[XB_XSUB(b.x)], 1u);
        const unsigned gen = old / nloc;
        if (old + 1u == (gen + 1u) * nloc) {
            __builtin_amdgcn_fence(__ATOMIC_RELEASE, "agent");
            asm volatile("s_waitcnt vmcnt(0)" ::: "memory");
            const unsigned og = xb_add(&bar[XB_TOP], 1u);
            const unsigned tg = og / nx;
            if (og + 1u == (tg + 1u) * nx) xb_add(&bar[XB_TOPGEN], 1u);
            else XB_SPIN(xb_ld(&bar[XB_TOPGEN]) == tg, bar);
            __builtin_amdgcn_fence(__ATOMIC_ACQUIRE, "agent");
            xb_add(&bar[XB_XGEN(b.x)], 1u);
            asm volatile("s_waitcnt vmcnt(0)" ::: "memory");
        } else {
            XB_SPIN(xb_ld(&bar[XB_XGEN(b.x)]) == gen, bar);
            __builtin_amdgcn_fence(__ATOMIC_ACQUIRE, "agent");
            asm volatile("s_waitcnt vmcnt(0)" ::: "memory");
        }
    }
    __syncthreads();
}

__device__ __forceinline__ void sub_barrier(unsigned* word, unsigned nblk) {
    asm volatile("s_waitcnt vmcnt(0)" ::: "memory");
    __syncthreads();
    if (threadIdx.x == 0) {
        __builtin_amdgcn_fence(__ATOMIC_RELEASE, "agent");
        asm volatile("s_waitcnt vmcnt(0)" ::: "memory");
        (void)xb_add(word, 1u);
        unsigned sp = 0;
        while (xb_ld(word) < nblk) { __builtin_amdgcn_s_sleep(2); if (++sp > (1u << 22)) break; }
        __builtin_amdgcn_fence(__ATOMIC_ACQUIRE, "agent");
        asm volatile("s_waitcnt vmcnt(0)" ::: "memory");
    }
    __syncthreads();
}

constexpr int NPHASE = 17;
__global__ void __launch_bounds__(512, 2) hybrid_fwd(Params p) {
    extern __shared__ __attribute__((aligned(16))) unsigned char lds_raw[];
    cg::grid_group grid = cg::this_grid();
    unsigned char* ws = p.ws;
    __shared__ uint4 xb_words;
    if (threadIdx.x == 0) xb_words = make_uint4(0u, 0u, 0u, 0u);
    __syncthreads();
    const XcdBarrier xbar = xcd_barrier_post((unsigned*)(ws + WS_BAR), (volatile LAS unsigned*)&xb_words);
    bf16_t* A1 = (bf16_t*)(ws + WS_A1); bf16_t* BIG = (bf16_t*)(ws + WS_BIG);
    const float* NG = p.in[2];
    for (int ph = p.ph_lo; ph < p.ph_hi; ++ph) {
        int kind = 0;
        pg8::Gemm g{nullptr, nullptr, 0, 0, 0}; pg8::EpiBf16 E{nullptr, 0, 0, nullptr, nullptr, nullptr, (LAS float*)((LAS unsigned char*)lds_raw + 131072)};
        int nmode = 1; const bf16_t* nsrc = nullptr; const float* gA = nullptr; const float* gB = nullptr; int layer = 0;
        const int lyr = ph >= 9 ? 1 : 0; const int q = ph - lyr * 8;
        const bf16_t* Wup = (const bf16_t*)(ws + WS_WB + (lyr ? WB_UP1 : WB_UP0)); const bf16_t* Wdn = (const bf16_t*)(ws + WS_WB + (lyr ? WB_DN1 : WB_DN0));
        const bf16_t* Wout = (const bf16_t*)(ws + WS_WB + (lyr ? WB_OUTO : WB_OUTE));
        bf16_t* ACTF = (bf16_t*)(ws + WS_BIG); bf16_t* HALO = (bf16_t*)(ws + WS_BIG + BIG_HALO);
        int gG = gridDim.x, tailnorm = 0, nlo = 0, nhi = M, then_odd = 0, tailword = 0; const bool split = (gridDim.x == 256); bf16_t* Y2 = (bf16_t*)(ws + WS_Y2);
        if (ph == 0) kind = 0;
        else if (q == 1) { kind = 1; g = pg8::Gemm{A1, (const bf16_t*)(ws + WS_WB + (lyr ? WB_INO : WB_INE)), M, (lyr && split) ? 1792 : PW, D}; E.O = BIG; E.ldc = PW; }
        else if (q == 2) { if (!lyr) kind = 2; else { kind = 1; then_odd = 1; gG = split ? 128 : 0; g = pg8::Gemm{A1, (const bf16_t*)(ws + WS_WB + WB_INO) + (size_t)1792 * D, M, 2304, D}; E.O = BIG + 1792; E.ldc = PW; } }
        else if (q == 3) { kind = 1; g = pg8::Gemm{lyr ? Y2 : A1, Wout, MHEAD, D, D}; E.O = BIG; E.ldc = D; }
        else if (q == 4) { kind = 1; gG = 8; tailnorm = 1; tailword = 3616 + lyr * 16; g = pg8::Gemm{(lyr ? Y2 : A1) + (size_t)MHEAD * D, Wout, M - MHEAD, D, D}; E.O = BIG + (size_t)MHEAD * D; E.ldc = D;
            nmode = 1; nsrc = BIG; gA = NG + (lyr * 4 + 1) * D; gB = NG + (lyr * 4 + 2) * D; }
        else if (q == 5) {
            kind = 1; g = pg8::Gemm{A1, Wup, M, DFF2, D}; E.O = ACTF; E.ldc = DFF; E.mode = 1; E.cw = p.in[25] + (size_t)lyr * 3 * DFF2; E.cb = p.in[26] + (size_t)lyr * DFF2; E.halo = HALO; }
        else if (q == 6) { kind = 5; layer = lyr; }
        else if (q == 7) { kind = 1; g = pg8::Gemm{ACTF, Wdn, MHEAD, D, DFF}; E.O = A1; E.ldc = D; }
        else {
            nsrc = A1; gA = NG + (lyr * 4 + 3) * D; if (lyr) nmode = 2; else { nmode = 1; gB = NG + (1 * 4 + 0) * D; }
            kind = 1; gG = 8; tailnorm = 1; tailword = 3648 + lyr * 16; g = pg8::Gemm{ACTF + (size_t)MHEAD * DFF, Wdn, M - MHEAD, D, DFF}; E.O = A1 + (size_t)MHEAD * D; E.ldc = D; }

#ifndef PROBE_KIND
#define PROBE_KIND -1
#endif
        for (int rep = 0; rep < ((kind == PROBE_KIND) ? 2 : 1); ++rep) {
        if (rep) xcd_barrier(xbar);
        if (kind == 0) {
            float* tile = (float*)lds_raw;
            bf16_t* wb = (bf16_t*)(ws + WS_WB);
            transpose_job(tile, p.in[3], (bf16_t*)((char*)wb + WB_INE), D, 4096, 4096, 0);
            transpose_job(tile, p.in[4], (bf16_t*)((char*)wb + WB_OUTE), D, D, D, 0);
            transpose_job(tile, p.in[7], (bf16_t*)((char*)wb + WB_INO), D, ODD_IN, 4096, 0);
            transpose_job(tile, p.in[8], (bf16_t*)((char*)wb + WB_OUTO), D, D, D, 0);
            transpose_job(tile, p.in[24], (bf16_t*)((char*)wb + WB_UP0), D, DFF2, DFF2, 1);
            transpose_job(tile, p.in[24] + (size_t)D * DFF2, (bf16_t*)((char*)wb + WB_UP1), D, DFF2, DFF2, 1);
            transpose_job(tile, p.in[27], (bf16_t*)((char*)wb + WB_DN0), DFF, D, D, 0);
            transpose_job(tile, p.in[27] + (size_t)DFF * D, (bf16_t*)((char*)wb + WB_DN1), DFF, D, D, 0);
            norm_phase(p, 0, nullptr, nullptr, NG, A1, 0, M, 0, (int)gridDim.x);
        } else if (kind == 1) {
            const int bid_g = obid();
            if (bid_g < gG) { pg8::StaticOrder S; S.init(g.M, g.N, gG, bid_g); pg8::gemm_phase((LAS unsigned char*)lds_raw, g, S, E); }
            if (tailnorm) {
                if (bid_g < 8) { sub_barrier((unsigned*)(ws + WS_BAR) + tailword, 8u); norm_phase(p, nmode, nsrc, gA, gB, A1, MHEAD, M, 0, 8); }
                else norm_phase(p, nmode, nsrc, gA, gB, A1, 0, MHEAD, 8, (int)gridDim.x - 8);
            }
            if (then_odd) {
                if (split && bid_g < 128) sub_barrier((unsigned*)(ws + WS_BAR) + 3600, 128u);
                odd_scan_phase(p, (float*)lds_raw);
            }
        } else if (kind == 2) {
            even_scan_phase(p, (float*)lds_raw);
        } else if (kind == 3) {
            odd_scan_phase(p, (float*)lds_raw);
        } else if (kind == 4) {
            norm_phase(p, nmode, nsrc, gA, gB, A1, nlo, nhi, 0, (int)gridDim.x);
        } else {
            ffn_fixup_phase(p, layer);
        }
        }
        if (ph + 1 < p.ph_hi) { if (p.ph_hi > 1000) grid.sync(); else xcd_barrier(xbar); }
    }
}

extern "C" void kernel_launch(void* const* d_in, const int* in_sizes, int n_in, void* d_out, int out_size, void* d_ws, size_t ws_size, hipStream_t stream) {
    static int grid_blocks = 0;
    if (grid_blocks == 0) {
        if (n_in != 28 || ws_size < WS_END) { fprintf(stderr, "kernel_launch: need 28 inputs and %zu bytes of workspace (got %d, %zu)\n", (size_t)WS_END, n_in, ws_size); grid_blocks = -1; return; }
        int dev = 0, cus = 0, per_cu = 0;
        hipGetDevice(&dev);
        hipDeviceGetAttribute(&cus, hipDeviceAttributeMultiprocessorCount, dev);
        if (hipFuncSetAttribute((const void*)hybrid_fwd, hipFuncAttributeMaxDynamicSharedMemorySize, LDS_BYTES) != hipSuccess) { fprintf(stderr, "kernel_launch: hipFuncSetAttribute failed\n"); grid_blocks = -1; return; }
        if (hipOccupancyMaxActiveBlocksPerMultiprocessor(&per_cu, (const void*)hybrid_fwd, 512, LDS_BYTES) != hipSuccess || per_cu < 1) { fprintf(stderr, "kernel_launch: occupancy query says %d\n", per_cu); per_cu = 1; }
        (void)hipGetLastError();
        grid_blocks = cus;
    }
    if (grid_blocks < 0) return;
    if (hipMemsetAsync((char*)d_ws + WS_BAR, 0, 16384, stream) != hipSuccess) { fprintf(stderr, "kernel_launch: hipMemsetAsync of the barrier words failed\n"); return; }
    Params p{};
    for (int i = 0; i < 28; ++i) p.in[i] = (const float*)d_in[i];
    p.out = (float*)d_out; p.ws = (unsigned char*)d_ws;
#if defined(MK_PER_PHASE)
    for (int ph = 0; ph < NPHASE; ++ph) { p.ph_lo = ph; p.ph_hi = ph + 1; hipLaunchKernelGGL(hybrid_fwd, dim3(grid_blocks), dim3(512), LDS_BYTES, stream, p); }
#else
    p.ph_lo = 0; p.ph_hi = NPHASE;
    void* args[] = {&p};
    hipError_t e = hipLaunchCooperativeKernel((const void*)hybrid_fwd, dim3(grid_blocks), dim3(512), args, LDS_BYTES, stream);
    if (e != hipSuccess) fprintf(stderr, "kernel_launch: cooperative launch failed: %s (grid %d)\n", hipGetErrorString(e), grid_blocks);
#endif
}
```

```cpp
#include <hip/hip_runtime.h>
#include <hip/hip_cooperative_groups.h>
#include <cstdio>
namespace cg = cooperative_groups;

#define LAS __attribute__((address_space(3)))
typedef unsigned short bf16_t;
typedef short bf16x8 __attribute__((ext_vector_type(8)));
typedef float f32x4 __attribute__((ext_vector_type(4)));
typedef unsigned u32x4 __attribute__((ext_vector_type(4)));
typedef unsigned u32x2 __attribute__((ext_vector_type(2)));

constexpr int NB = 32, SEQ = 2048, NMETA = 16, L = 2064, D = 1024, M = NB * L;
constexpr int DFF = 2816, DFF2 = 5632;
constexpr int PW = 4096;
constexpr int ODD_IN = 3848;
constexpr int SLAB = 33024;
constexpr int MHEAD = 65536;
constexpr float EPS = 1e-6f;

constexpr size_t WS_H = 0;
constexpr size_t WS_Y2 = WS_H + (size_t)M * D * 2;
constexpr size_t WS_A1 = WS_H + (size_t)M * D * 4;
constexpr size_t WS_BIG = WS_A1 + (size_t)M * D * 2;
constexpr size_t BIG_ZUP = 0, BIG_ACT = (size_t)SLAB * DFF2 * 2;
constexpr size_t BIG_BYTES = BIG_ACT + (size_t)SLAB * DFF * 2;
constexpr size_t WS_WB = WS_BIG + BIG_BYTES;
constexpr size_t WB_INE = 0, WB_OUTE = WB_INE + (size_t)4096 * 1024 * 2, WB_INO = WB_OUTE + (size_t)1024 * 1024 * 2, WB_OUTO = WB_INO + (size_t)4096 * 1024 * 2;
constexpr size_t WB_UP0 = WB_OUTO + (size_t)1024 * 1024 * 2, WB_UP1 = WB_UP0 + (size_t)DFF2 * 1024 * 2, WB_DN0 = WB_UP1 + (size_t)DFF2 * 1024 * 2, WB_DN1 = WB_DN0 + (size_t)1024 * DFF * 2;
constexpr size_t WS_BAR = WS_WB + WB_DN1 + (size_t)1024 * DFF * 2;
constexpr size_t WS_END = WS_BAR + 16384;
static_assert(BIG_BYTES >= (size_t)M * PW * 2, "BIG holds the projection");

constexpr int LDS_BYTES = 131072 + 4096;

struct Params { const float* in[28]; float* out; unsigned char* ws; int ph_lo, ph_hi; };

__device__ __forceinline__ float bf2f(bf16_t v) { return __uint_as_float(((unsigned)v) << 16); }
typedef __bf16 bf16x2_t __attribute__((ext_vector_type(2)));
typedef float f32x2_t __attribute__((ext_vector_type(2)));
__device__ __forceinline__ unsigned cvt_pk_bf16(float lo, float hi) { const f32x2_t f = {lo, hi}; const bf16x2_t v = __builtin_convertvector(f, bf16x2_t); return __builtin_bit_cast(unsigned, v); }
__device__ __forceinline__ bf16_t f2bf(float f) { return (bf16_t)(cvt_pk_bf16(f, 0.f) & 0xffffu); }
__device__ __forceinline__ float sigmoidf_(float x) { return __builtin_amdgcn_rcpf(1.0f + __expf(-x)); }
__device__ __forceinline__ float siluf_(float x) { return x * sigmoidf_(x); }
__device__ __forceinline__ float softplusf_(float x) { return fmaxf(x, 0.f) + __logf(1.0f + __expf(-fabsf(x))); }
__device__ __forceinline__ int otid() { int t = threadIdx.x; asm volatile("" : "+v"(t)); return t; }
__device__ __forceinline__ int obid() { int b = blockIdx.x; asm volatile("" : "+s"(b)); return b; }
template <int CTRL> __device__ __forceinline__ float dppf(float x) { return __int_as_float(__builtin_amdgcn_update_dpp(0, __float_as_int(x), CTRL, 0xF, 0xF, true)); }
__device__ __forceinline__ float allreduce8(float x) { x += dppf<0xB1>(x); x += dppf<0x4E>(x); x += dppf<0x141>(x); return x; }
__device__ __forceinline__ float allreduce16(float x) { x = allreduce8(x); x += dppf<0x140>(x); return x; }
__device__ __forceinline__ float wave_sum(float x) {
    x = allreduce16(x);
    const int xi = __float_as_int(x);
    const float r0 = __int_as_float(__builtin_amdgcn_readlane(xi, 0)), r1 = __int_as_float(__builtin_amdgcn_readlane(xi, 16));
    const float r2 = __int_as_float(__builtin_amdgcn_readlane(xi, 32)), r3 = __int_as_float(__builtin_amdgcn_readlane(xi, 48));
    return (r0 + r1) + (r2 + r3);
}

namespace pg8 {
constexpr int BM = 256, BK = 64, HALF = 128, HTB = HALF * BK * 2, STAGE_BYTES = 8 * HTB, NXCD = 8, WGM = 8;
__host__ __device__ __forceinline__ int lds_byte(int r, int c) { const int st = (r >> 4) * 2 + (c >> 5), rr = r & 15, cc = c & 31, ob = rr * 64 + cc * 2; return st * 1024 + (ob ^ (((ob >> 9) & 1) << 5)); }
__host__ __device__ __forceinline__ void stage_rc(int b, int& R, int& C) { const int st = b / 1024, sb = b % 1024, swz = sb ^ (((sb >> 9) & 1) << 5); R = (st >> 1) * 16 + swz / 64; C = (st & 1) * 32 + (swz % 64) / 2; }
__host__ __device__ __forceinline__ int perm32(int rho) { const int n = rho >> 4, i = rho & 15; return 8 * (i >> 2) + 4 * n + (i & 3); }
struct Unit { int pm, pn; };
struct Gemm { const bf16_t* A; const bf16_t* Bt; int M, N, K; };
struct StaticOrder {
    int nM, nN, nwg, G, c;
    __device__ void init(int M_, int N_, int G_, int c_) { nM = M_ / BM; nN = N_ / BM; nwg = nM * nN; G = G_; c = c_; }
    __device__ bool next(int i, Unit& u) const {
        const long Lx = (long)i * G + c; if (Lx >= nwg) return false;
        int wgid = (int)Lx; { const int q = nwg / NXCD, r = nwg % NXCD, xcd = wgid % NXCD, off = wgid / NXCD; wgid = (xcd < r ? xcd * (q + 1) : r * (q + 1) + (xcd - r) * q) + off; }
        const int nig = WGM * nN, gid = wgid / nig, fm = gid * WGM, gsz = (nM - fm) < WGM ? (nM - fm) : WGM;
        u.pm = fm + ((wgid % nig) % gsz); u.pn = (wgid % nig) / gsz; return true;
    }
};
struct EpiBf16 {
    bf16_t* O; int ldc; int mode; const float* cw; const float* cb; bf16_t* halo; LAS float* wlds;
    __device__ __forceinline__ void operator()(const f32x4 (&acc)[2][2][4][2], const Unit& u, int wr, int wc, int fr, int fq) const {
        if (mode == 0) {
            const int row0 = u.pm * BM + wr * 64 + fr; const int col0 = u.pn * BM + wc * 32 + 8 * fq;
#pragma unroll
            for (int ai = 0; ai < 2; ++ai)
#pragma unroll
                for (int m = 0; m < 4; ++m) { bf16_t* rowp = O + (size_t)(row0 + ai * HALF + m * 16) * ldc + col0;
#pragma unroll
                    for (int bj = 0; bj < 2; ++bj) { const f32x4 v0 = acc[ai][bj][m][0], v1 = acc[ai][bj][m][1];
                        u32x4 w; w.x = cvt_pk_bf16(v0[0], v0[1]); w.y = cvt_pk_bf16(v0[2], v0[3]); w.z = cvt_pk_bf16(v1[0], v1[1]); w.w = cvt_pk_bf16(v1[2], v1[3]);
                        *(u32x4*)(rowp + bj * HALF) = w; } }
            return;
        }
        const int ch0 = u.pn * 128 + wc * 32 + 8 * fq;
        const bool l15 = (fr == 15), l14 = (fr >= 14);
        LAS float* wsc = wlds + ((wr * 4 + wc) * 4 + fq) * 32;
        {
            f32x4 t[8];
#pragma unroll
            for (int j = 0; j < 3; ++j) { t[j] = *(const f32x4*)(cw + j * DFF2 + ch0 + 4); t[3 + j] = *(const f32x4*)(cw + j * DFF2 + DFF + ch0 + 4); }
            t[6] = *(const f32x4*)(cb + ch0 + 4); t[7] = *(const f32x4*)(cb + DFF + ch0 + 4);
#pragma unroll
            for (int j = 0; j < 8; ++j) *(LAS f32x4*)(wsc + 4 * j) = t[j];
        }
#pragma unroll
        for (int n = 0; n < 2; ++n) {
            float wg[3][4], wv[3][4], bg[4], bv[4];
            if (n == 0) {
#pragma unroll
                for (int j = 0; j < 3; ++j) {
                    const float4 a = *(const float4*)(cw + j * DFF2 + ch0), c = *(const float4*)(cw + j * DFF2 + DFF + ch0);
                    wg[j][0] = a.x; wg[j][1] = a.y; wg[j][2] = a.z; wg[j][3] = a.w; wv[j][0] = c.x; wv[j][1] = c.y; wv[j][2] = c.z; wv[j][3] = c.w;
                }
                const float4 a = *(const float4*)(cb + ch0), c = *(const float4*)(cb + DFF + ch0);
                bg[0] = a.x; bg[1] = a.y; bg[2] = a.z; bg[3] = a.w; bv[0] = c.x; bv[1] = c.y; bv[2] = c.z; bv[3] = c.w;
            } else {
#pragma unroll
                for (int j = 0; j < 3; ++j) {
                    const f32x4 a = *(const LAS f32x4*)(wsc + 4 * j), c = *(const LAS f32x4*)(wsc + 4 * (3 + j));
                    wg[j][0] = a[0]; wg[j][1] = a[1]; wg[j][2] = a[2]; wg[j][3] = a[3]; wv[j][0] = c[0]; wv[j][1] = c[1]; wv[j][2] = c[2]; wv[j][3] = c[3];
                }
                const f32x4 a = *(const LAS f32x4*)(wsc + 24), c = *(const LAS f32x4*)(wsc + 28);
                bg[0] = a[0]; bg[1] = a[1]; bg[2] = a[2]; bg[3] = a[3]; bv[0] = c[0]; bv[1] = c[1]; bv[2] = c[2]; bv[3] = c[3];
            }
#pragma unroll
            for (int ai = 0; ai < 2; ++ai)
#pragma unroll
                for (int m = 0; m < 4; ++m) {
                    const int r = u.pm * BM + ai * HALF + wr * 64 + m * 16 + fr; const int tb = r % L;
                    const bool k1 = (tb >= 1), k2 = (tb >= 2);
                    float o[4];
#pragma unroll
                    for (int e = 0; e < 4; ++e) {
                        const float g0 = acc[ai][0][m][n][e], v0 = acc[ai][1][m][n][e];
                        const float gm = (m > 0) ? acc[ai][0][m > 0 ? m - 1 : 0][n][e] : 0.f, vm = (m > 0) ? acc[ai][1][m > 0 ? m - 1 : 0][n][e] : 0.f;
                        float g1 = dppf<0x121>(l15 ? gm : g0), g2 = dppf<0x122>(l14 ? gm : g0), v1 = dppf<0x121>(l15 ? vm : v0), v2 = dppf<0x122>(l14 ? vm : v0);
                        g1 = k1 ? g1 : 0.f; v1 = k1 ? v1 : 0.f; g2 = k2 ? g2 : 0.f; v2 = k2 ? v2 : 0.f;
                        const float zg = fmaf(wg[0][e], g2, fmaf(wg[1][e], g1, fmaf(wg[2][e], g0, bg[e])));
                        const float zv = fmaf(wv[0][e], v2, fmaf(wv[1][e], v1, fmaf(wv[2][e], v0, bv[e])));
                        o[e] = siluf_(zg) * zv;
                    }
                    if (!(m == 0 && fr < 2)) {
                        u32x2 w; w.x = cvt_pk_bf16(o[0], o[1]); w.y = cvt_pk_bf16(o[2], o[3]);
                        *(u32x2*)(O + (size_t)r * ldc + ch0 + 4 * n) = w;
                    }
                }
        }
#pragma unroll
        for (int ai = 0; ai < 2; ++ai)
#pragma unroll
            for (int m = 0; m < 4; m += 3) {
                if ((m == 3 && fr >= 14) || (m == 0 && fr < 2)) {
                    const int r = u.pm * BM + ai * HALF + wr * 64 + m * 16 + fr;
                    const int slot = (m == 3) ? (fr - 14) : (2 + fr);
                    bf16_t* hp = halo + ((size_t)(r >> 6) * 4 + slot) * DFF2 + u.pn * 256 + wc * 32 + 8 * fq;
#pragma unroll
                    for (int bj = 0; bj < 2; ++bj) { const f32x4 a0 = acc[ai][bj][m][0], a1 = acc[ai][bj][m][1];
                        u32x4 w; w.x = cvt_pk_bf16(a0[0], a0[1]); w.y = cvt_pk_bf16(a0[2], a0[3]); w.z = cvt_pk_bf16(a1[0], a1[1]); w.w = cvt_pk_bf16(a1[2], a1[3]);
                        *(u32x4*)(hp + bj * 128) = w; }
                }
            }
    }
};

__device__ __forceinline__ void gemm_phase(LAS unsigned char* lds, const Gemm g, const StaticOrder& S, const EpiBf16& E) {
    const int tid = otid(), wid = __builtin_amdgcn_readfirstlane(tid >> 6), lane = tid & 63, wr = wid >> 2, wc = wid & 3, fr = lane & 15, fq = lane >> 4;
    const int K = g.K, nt = K / BK;
    unsigned voffA[2], voffB[2];
#pragma unroll
    for (int i = 0; i < 2; ++i) { int R, C; stage_rc(tid * 16 + i * 8192, R, C); const int Rb = (R & ~31) + perm32(R & 31);
        voffA[i] = (unsigned)(R * K + C) * 2u; voffB[i] = (unsigned)(Rb * K + C) * 2u; }
    const size_t kstep = (size_t)(BK * 2);
    const size_t hstep = (size_t)HALF * K * 2;
    const size_t tstep = 2 * hstep;
    const unsigned ldsw = (unsigned)wid * 1024u;
    const int aoff = lds_byte(wr * 64 + fr, fq * 8), boff = lds_byte(wc * 32 + fr, fq * 8);
#define PG8_SA(b, h) (((b) * 2 + (h)) * HTB)
#define PG8_SB(b, h) ((4 + (b) * 2 + (h)) * HTB)
#define PG8_STAGE(bufoff, gbase, voff) do { _Pragma("unroll") for (int _i = 0; _i < 2; ++_i) \
        __builtin_amdgcn_global_load_lds((const unsigned*)((const char*)(gbase) + (voff)[_i]), (LAS unsigned*)(lds + (bufoff) + ldsw + _i * 8192), 16, 0, 0); } while (0)
#define PG8_LDA(dst, b, h) do { _Pragma("unroll") for (int m = 0; m < 4; ++m) _Pragma("unroll") for (int k = 0; k < 2; ++k) dst[m][k] = *(const LAS bf16x8*)(lds + PG8_SA(b, h) + aoff + m * 2048 + k * 1024); } while (0)
#define PG8_LDB(dst, b, h) do { _Pragma("unroll") for (int n = 0; n < 2; ++n) _Pragma("unroll") for (int k = 0; k < 2; ++k) dst[n][k] = *(const LAS bf16x8*)(lds + PG8_SB(b, h) + boff + n * 2048 + k * 1024); } while (0)
#define PG8_MMA(ai, bj, At, Bt) do { __builtin_amdgcn_s_setprio(1); _Pragma("unroll") for (int m = 0; m < 4; ++m) _Pragma("unroll") for (int n = 0; n < 2; ++n) _Pragma("unroll") for (int k = 0; k < 2; ++k) \
        acc[ai][bj][m][n] = __builtin_amdgcn_mfma_f32_16x16x32_bf16(Bt[n][k], At[m][k], acc[ai][bj][m][n], 0, 0, 0); __builtin_amdgcn_s_setprio(0); } while (0)
#define PG8_WAIT_V(n) asm volatile("s_waitcnt vmcnt(" #n ")" ::: "memory")
#define PG8_WAIT_L(n) asm volatile("s_waitcnt lgkmcnt(" #n ")" ::: "memory")
#define PG8_BAR __builtin_amdgcn_s_barrier()
#define PG8_SCHED __builtin_amdgcn_sched_barrier(0)
    Unit cur, nxt; int ui = 0;
    if (!S.next(0, cur)) return;
    f32x4 acc[2][2][4][2];
#pragma unroll
    for (int a = 0; a < 2; ++a)
#pragma unroll
        for (int b = 0; b < 2; ++b)
#pragma unroll
            for (int m = 0; m < 4; ++m)
#pragma unroll
                for (int n = 0; n < 2; ++n) acc[a][b][m][n] = (f32x4){0.f, 0.f, 0.f, 0.f};
    bf16x8 At[4][2], B0[2][2], B1[2][2];
    const char* cA = (const char*)g.A + (size_t)cur.pm * tstep; const char* cB = (const char*)g.Bt + (size_t)cur.pn * tstep;
    PG8_STAGE(PG8_SB(0, 0), cB, voffB); PG8_STAGE(PG8_SA(0, 0), cA, voffA); PG8_STAGE(PG8_SB(0, 1), cB + hstep, voffB); PG8_STAGE(PG8_SA(0, 1), cA + hstep, voffA);
    if (wr == 1) PG8_BAR;
    PG8_WAIT_V(4); PG8_BAR;
    PG8_STAGE(PG8_SB(1, 0), cB + kstep, voffB); PG8_STAGE(PG8_SA(1, 0), cA + kstep, voffA); PG8_STAGE(PG8_SB(1, 1), cB + hstep + kstep, voffB);
    PG8_WAIT_V(6); PG8_BAR;
    for (;;) {
        const bool has_next = S.next(ui + 1, nxt);
        const char* nA = has_next ? (const char*)g.A + (size_t)nxt.pm * tstep : cA; const char* nB = has_next ? (const char*)g.Bt + (size_t)nxt.pn * tstep : cB;
        for (int t = 0; t < nt; t += 2) {
            const bool last = (t == nt - 2);
            const char* a1 = cA + (size_t)(t + 1) * kstep;
            const char* a2 = last ? nA : cA + (size_t)(t + 2) * kstep; const char* b2 = last ? nB : cB + (size_t)(t + 2) * kstep;
            const char* a3 = a2 + kstep; const char* b3 = b2 + kstep;
            PG8_LDB(B0, 0, 0); PG8_SCHED; PG8_LDA(At, 0, 0); PG8_STAGE(PG8_SA(1, 1), a1 + hstep, voffA);
            PG8_WAIT_L(8); PG8_BAR; PG8_WAIT_L(0); PG8_MMA(0, 0, At, B0); PG8_BAR; PG8_SCHED;
            PG8_LDB(B1, 0, 1); PG8_STAGE(PG8_SB(0, 0), b2, voffB);
            PG8_BAR; PG8_WAIT_L(0); PG8_MMA(0, 1, At, B1); PG8_BAR;
            PG8_LDA(At, 0, 1); PG8_STAGE(PG8_SA(0, 0), a2, voffA);
            PG8_BAR; PG8_WAIT_L(0); PG8_MMA(1, 0, At, B0); PG8_BAR; PG8_SCHED;
            PG8_STAGE(PG8_SB(0, 1), b2 + hstep, voffB);
            PG8_WAIT_V(6); PG8_BAR; PG8_MMA(1, 1, At, B1); PG8_BAR;
            PG8_LDB(B0, 1, 0); PG8_SCHED; PG8_LDA(At, 1, 0); PG8_STAGE(PG8_SA(0, 1), a2 + hstep, voffA);
            PG8_WAIT_L(8); PG8_BAR; PG8_WAIT_L(0); PG8_MMA(0, 0, At, B0); PG8_BAR; PG8_SCHED;
            PG8_LDB(B1, 1, 1); PG8_STAGE(PG8_SB(1, 0), b3, voffB);
            PG8_BAR; PG8_WAIT_L(0); PG8_MMA(0, 1, At, B1); PG8_BAR;
            PG8_LDA(At, 1, 1); PG8_STAGE(PG8_SA(1, 0), a3, voffA);
            PG8_BAR; PG8_WAIT_L(0); PG8_MMA(1, 0, At, B0); PG8_BAR; PG8_SCHED;
            PG8_STAGE(PG8_SB(1, 1), b3 + hstep, voffB);
            PG8_WAIT_V(6); PG8_BAR; PG8_MMA(1, 1, At, B1); PG8_BAR;
        }
        E(acc, cur, wr, wc, fr, fq);
        if (!has_next) break;
#pragma unroll
        for (int a = 0; a < 2; ++a)
#pragma unroll
            for (int b = 0; b < 2; ++b)
#pragma unroll
                for (int m = 0; m < 4; ++m)
#pragma unroll
                    for (int n = 0; n < 2; ++n) acc[a][b][m][n] = (f32x4){0.f, 0.f, 0.f, 0.f};
        cur = nxt; cA = nA; cB = nB; ++ui;
    }
    PG8_WAIT_V(0);
    if (wr == 0) PG8_BAR;
    PG8_BAR;
#undef PG8_SA
#undef PG8_SB
#undef PG8_STAGE
#undef PG8_LDA
#undef PG8_LDB
#undef PG8_MMA
#undef PG8_WAIT_V
#undef PG8_WAIT_L
#undef PG8_BAR
#undef PG8_SCHED
}
}

__device__ __noinline__ void transpose_job(float* tile  , const float* __restrict__ src, bf16_t* __restrict__ dst, int K, int N, int Npad, int glu) {
    const int tid = otid();
    const int tk = K / 64, tn = Npad / 64, ntiles = tk * tn;
    const int kkA = tid >> 4, n4 = (tid & 15) * 4;
    float4 v[2];
    auto fetch = [&](int tl) {
        const int k0 = (tl % tk) * 64, n0 = (tl / tk) * 64;
#pragma unroll
        for (int it = 0; it < 2; ++it) { v[it] = make_float4(0.f, 0.f, 0.f, 0.f); if (n0 + n4 < N) v[it] = *(const float4*)(src + (size_t)(k0 + kkA + it * 32) * N + n0 + n4); }
    };
    int tl = obid();
    if (tl < ntiles) fetch(tl);
    while (tl < ntiles) {
        const int k0 = (tl % tk) * 64, n0 = (tl / tk) * 64;
        __syncthreads();
#pragma unroll
        for (int it = 0; it < 2; ++it) { float* tp = tile + (kkA + it * 32) * 65 + n4; tp[0] = v[it].x; tp[1] = v[it].y; tp[2] = v[it].z; tp[3] = v[it].w; }
        const int nxt = tl + (int)gridDim.x;
        if (nxt < ntiles) fetch(nxt);
        __syncthreads();
        const int nn = tid >> 3, k8 = (tid & 7) * 8;
        float e[8];
#pragma unroll
        for (int j = 0; j < 8; ++j) e[j] = tile[(k8 + j) * 65 + nn];
        u32x4 w; w.x = cvt_pk_bf16(e[0], e[1]); w.y = cvt_pk_bf16(e[2], e[3]); w.z = cvt_pk_bf16(e[4], e[5]); w.w = cvt_pk_bf16(e[6], e[7]);
        const int r0 = !glu ? n0 : (n0 < DFF ? (n0 >> 7) * 256 + (n0 & 127) : ((n0 - DFF) >> 7) * 256 + 128 + ((n0 - DFF) & 127));
        *(u32x4*)(dst + (size_t)(r0 + nn) * K + k0 + k8) = w;
        tl = nxt;
    }
}

__device__ void norm_phase(const Params& p, int mode, const bf16_t* msrc, const float* __restrict__ gA, const float* __restrict__ gB, bf16_t* udst, int row_lo, int row_hi, int blk_first, int blk_cnt) {
    bf16_t* H = (bf16_t*)(p.ws + WS_H);
    const int tid_ = otid(); const int lane = tid_ & 63, w = tid_ >> 6;
    const int nw = blk_cnt * 8; const int bid_ = obid() - blk_first;
    if (bid_ < 0 || bid_ >= blk_cnt) return;
    float4 ga[4], gb[4];
#pragma unroll
    for (int i = 0; i < 4; ++i) { ga[i] = (mode != 0) ? *(const float4*)(gA + i * 256 + lane * 4) : make_float4(0.f, 0.f, 0.f, 0.f); gb[i] = (mode != 2) ? *(const float4*)(gB + i * 256 + lane * 4) : make_float4(0.f, 0.f, 0.f, 0.f); }
    float4 xr[4]; u32x2 hr[4], mr[4];
    auto fetch = [&](int row) {
        if (mode == 0) {
            const int b = row / L, t = row - b * L;
            const float* src = (t < NMETA) ? (p.in[1] + (size_t)t * D) : (p.in[0] + ((size_t)b * SEQ + (t - NMETA)) * D);
#pragma unroll
            for (int i = 0; i < 4; ++i) xr[i] = *(const float4*)(src + i * 256 + lane * 4);
        } else {
#pragma unroll
            for (int i = 0; i < 4; ++i) { hr[i] = *(const u32x2*)(H + (size_t)row * D + i * 256 + lane * 4); mr[i] = *(const u32x2*)(msrc + (size_t)row * D + i * 256 + lane * 4); }
        }
    };
    int row = row_lo + bid_ * 8 + w;
    if (row < row_hi) fetch(row);
    while (row < row_hi) {
        const int b = row / L, t = row - b * L;
        float4 hv[4];
        float mv[4][4]; float ssm = 0.f;
        if (mode == 0) {
#pragma unroll
            for (int i = 0; i < 4; ++i) hv[i] = xr[i];
        } else {
#pragma unroll
            for (int i = 0; i < 4; ++i) {
                hv[i] = make_float4(__uint_as_float(hr[i].x << 16), __uint_as_float(hr[i].x & 0xffff0000u), __uint_as_float(hr[i].y << 16), __uint_as_float(hr[i].y & 0xffff0000u));
                mv[i][0] = __uint_as_float(mr[i].x << 16); mv[i][1] = __uint_as_float(mr[i].x & 0xffff0000u); mv[i][2] = __uint_as_float(mr[i].y << 16); mv[i][3] = __uint_as_float(mr[i].y & 0xffff0000u);
                ssm += mv[i][0] * mv[i][0] + mv[i][1] * mv[i][1] + mv[i][2] * mv[i][2] + mv[i][3] * mv[i][3];
            }
        }
        const int nxt = row + nw;
        if (nxt < row_hi) fetch(nxt);
        if (mode != 0) {
            ssm = wave_sum(ssm);
            const float rs = rsqrtf(ssm * (1.0f / D) + EPS);
#pragma unroll
            for (int i = 0; i < 4; ++i) { hv[i].x += mv[i][0] * rs * ga[i].x; hv[i].y += mv[i][1] * rs * ga[i].y; hv[i].z += mv[i][2] * rs * ga[i].z; hv[i].w += mv[i][3] * rs * ga[i].w; }
        }
        if (mode == 2) {
            if (t >= NMETA) {
                float* o = p.out + ((size_t)b * SEQ + (t - NMETA)) * D;
#pragma unroll
                for (int i = 0; i < 4; ++i) *(float4*)(o + i * 256 + lane * 4) = hv[i];
            }
        } else {
            float ss = 0.f;
#pragma unroll
            for (int i = 0; i < 4; ++i) {
                { u32x2 hw; hw.x = cvt_pk_bf16(hv[i].x, hv[i].y); hw.y = cvt_pk_bf16(hv[i].z, hv[i].w); *(u32x2*)(H + (size_t)row * D + i * 256 + lane * 4) = hw; }
                ss += hv[i].x * hv[i].x + hv[i].y * hv[i].y + hv[i].z * hv[i].z + hv[i].w * hv[i].w;
            }
            ss = wave_sum(ss);
            const float rs = rsqrtf(ss * (1.0f / D) + EPS);
#pragma unroll
            for (int i = 0; i < 4; ++i) {
                u32x2 o; o.x = cvt_pk_bf16(hv[i].x * rs * gb[i].x, hv[i].y * rs * gb[i].y); o.y = cvt_pk_bf16(hv[i].z * rs * gb[i].z, hv[i].w * rs * gb[i].w);
                *(u32x2*)(udst + (size_t)row * D + i * 256 + lane * 4) = o;
            }
        }
        row = nxt;
    }
}

constexpr size_t BIG_HALO = (size_t)M * DFF * 2;
static_assert(BIG_HALO + (size_t)(M / 64) * 4 * DFF2 * 2 <= BIG_BYTES, "activation + halo fit");
__device__ void ffn_fixup_phase(const Params& p, int layer) {
    bf16_t* act = (bf16_t*)(p.ws + WS_BIG);
    const bf16_t* halo = (const bf16_t*)(p.ws + WS_BIG + BIG_HALO);
    const float* cw = p.in[25] + (size_t)layer * 3 * DFF2;
    const float* cb = p.in[26] + (size_t)layer * DFF2;
    constexpr int NCG = DFF / 8, NBLK = M / 64;
    const int nitems = NCG * NBLK;
    for (int item = obid() * 512 + otid(); item < nitems; item += gridDim.x * 512) {
        const int cgp = item % NCG, blk = item / NCG;
        const int c0 = cgp * 8;
        const int gcol = (c0 >> 7) * 256 + (c0 & 127);
        float wg[3][8], wv[3][8], bg[8], bv[8];
#pragma unroll
        for (int j = 0; j < 3; ++j)
#pragma unroll
            for (int e = 0; e < 8; ++e) { wg[j][e] = cw[j * DFF2 + c0 + e]; wv[j][e] = cw[j * DFF2 + DFF + c0 + e]; }
#pragma unroll
        for (int e = 0; e < 8; ++e) { bg[e] = cb[c0 + e]; bv[e] = cb[DFF + c0 + e]; }
        auto ldrow = [&](int bk, int slot, float (&g)[8], float (&v)[8]) {
            const bf16_t* hp = halo + ((size_t)bk * 4 + slot) * DFF2 + gcol;
            const u32x4 a = *(const u32x4*)hp, c = *(const u32x4*)(hp + 128);
#pragma unroll
            for (int e = 0; e < 4; ++e) { g[2 * e] = __uint_as_float(a[e] << 16); g[2 * e + 1] = __uint_as_float(a[e] & 0xffff0000u); v[2 * e] = __uint_as_float(c[e] << 16); v[2 * e + 1] = __uint_as_float(c[e] & 0xffff0000u); }
        };
        float gz[4][8], vz[4][8];
#pragma unroll
        for (int e = 0; e < 8; ++e) { gz[0][e] = 0.f; gz[1][e] = 0.f; vz[0][e] = 0.f; vz[1][e] = 0.f; }
        if (blk > 0) { ldrow(blk - 1, 0, gz[0], vz[0]); ldrow(blk - 1, 1, gz[1], vz[1]); }
        ldrow(blk, 2, gz[2], vz[2]); ldrow(blk, 3, gz[3], vz[3]);
#pragma unroll
        for (int q = 0; q < 2; ++q) {
            const int r = blk * 64 + q; const int tb = r % L;
            const float k1 = (tb >= 1) ? 1.f : 0.f, k2 = (tb >= 2) ? 1.f : 0.f;
            float o[8];
#pragma unroll
            for (int e = 0; e < 8; ++e) {
                const float zg = wg[0][e] * (k2 * gz[q][e]) + wg[1][e] * (k1 * gz[q + 1][e]) + wg[2][e] * gz[q + 2][e] + bg[e];
                const float zv = wv[0][e] * (k2 * vz[q][e]) + wv[1][e] * (k1 * vz[q + 1][e]) + wv[2][e] * vz[q + 2][e] + bv[e];
                o[e] = siluf_(zg) * zv;
            }
            u32x4 w; w.x = cvt_pk_bf16(o[0], o[1]); w.y = cvt_pk_bf16(o[2], o[3]); w.z = cvt_pk_bf16(o[4], o[5]); w.w = cvt_pk_bf16(o[6], o[7]);
            *(u32x4*)(act + (size_t)r * DFF + c0) = w;
        }
    }
}

constexpr int TCH = 32;
template <int PPR, int NROW, int NLD, int NT = 512, class ColFn>
__device__ __forceinline__ void raw_fetch(u32x4 (&reg)[NLD], const bf16_t* P, int tid, size_t brow, int tfirst, ColFn col) {
#pragma unroll
    for (int i = 0; i < NLD; ++i) {
        int idx = tid + i * NT;
        asm volatile("" : "+v"(idx));
        u32x4 v = {0u, 0u, 0u, 0u};
        if (idx < NROW * PPR) { const int r = idx / PPR, pc = idx - r * PPR; const int t = tfirst + r;
            if (t >= 0 && t < L) v = *(const u32x4*)(P + (brow + t) * PW + col(pc)); }
        reg[i] = v;
    }
}
template <int PPR, int NROW, int NLD, int NT = 512>
__device__ __forceinline__ void raw_store(const u32x4 (&reg)[NLD], bf16_t* raw, int tid) {
#pragma unroll
    for (int i = 0; i < NLD; ++i) { const int idx = tid + i * NT; if (idx < NROW * PPR) *(u32x4*)(raw + (size_t)idx * 8) = reg[i]; }
}

template <bool HG>
__device__ __forceinline__ void even_item(const Params& p, float* lds, int b, int h) {
    const bf16_t* P = (const bf16_t*)(p.ws + WS_BIG);
    bf16_t* Y = (bf16_t*)(p.ws + WS_A1);
    constexpr int QP = 136;
    float* O = lds; float* Gt = O + TCH * 128; float* PC = Gt + TCH * 128;
    bf16_t* Qt = (bf16_t*)(PC + 256); bf16_t* Kt = Qt + TCH * QP;
    bf16_t* KhT = Kt + TCH * QP; bf16_t* VT = KhT + 2 * 128 * 16;
    bf16_t* raw = VT + 2 * 128 * 16;
    constexpr int PPR = 64, NROW = 32, NLD = 4, RP = 512;
    const int tid = otid(), lane = tid & 63, w = tid >> 6;
    const int fn = lane & 15, g = lane >> 4, vs = w * 16;
    const int cbase = (HG ? 2048 : 0) + h * 128;
    auto col = [&](int pc) { return cbase + (pc >> 4) * 512 + (pc & 15) * 8; };
    const size_t brow = (size_t)b * L;
    const float gamma = 1.0f - exp2f(-5.0f - (float)h);
    const int d_ = tid & 127, c2_ = (tid >> 7) & 1, hf_ = tid >> 8;
    float lbv = 0.f; float2 hgn = make_float2(0.f, 0.f);
    if (HG) {
        const float* lg = p.in[5]; const int c = h * 128 + d_;
        const float l0 = lg[c], l1 = lg[512 + c], l2 = lg[1024 + c]; const float mx = fmaxf(l0, fmaxf(l1, l2));
        const float e0 = __expf(l0 - mx), e1 = __expf(l1 - mx), e2 = __expf(l2 - mx); lbv = e0 / (e0 + e1 + e2);
        hgn = *(const float2*)(p.in[6] + h * 128 + 2 * lane);
    }
    const float rinv = exp2f(-(float)(d_ & 63) * 0.20762050593046f) * 0.15915494309189535f;
    f32x4 S[8];
#pragma unroll
    for (int T = 0; T < 8; ++T) S[T] = (f32x4){0.f, 0.f, 0.f, 0.f};
    u32x4 rg[NLD];
    __syncthreads();
    raw_fetch<PPR, NROW, NLD>(rg, P, tid, brow, 0, col); raw_store<PPR, NROW, NLD>(rg, raw, tid);
    for (int t0 = 0; t0 < L; t0 += TCH) {
        const int ns = (L - t0) < TCH ? (L - t0) : TCH;
        const bool more = (t0 + TCH < L);
        __syncthreads();
        if (more) raw_fetch<PPR, NROW, NLD>(rg, P, tid, brow, t0 + TCH, col);
        if (hf_ == 0) {
            float Pc = 1.0f; float kt[16];
#pragma unroll
            for (int i = 0; i < 16; ++i) {
                const int t = c2_ * 16 + i; const bf16_t* rr = raw + t * RP;
                float q, k, f;
                if (!HG) {
                    const int dd = d_ & 63;
                    float r = (float)(t0 + t) * rinv; r -= floorf(r);
                    const float sn = __builtin_amdgcn_sinf(r), cs = __builtin_amdgcn_cosf(r);
                    const float q1 = bf2f(rr[dd]), q2 = bf2f(rr[64 + dd]), k1 = bf2f(rr[128 + dd]), k2 = bf2f(rr[192 + dd]);
                    q = (d_ < 64) ? (q1 * cs - q2 * sn) : (q1 * sn + q2 * cs);
                    k = ((d_ < 64) ? (k1 * cs - k2 * sn) : (k1 * sn + k2 * cs)) * 0.08838834764831845f;
                    f = gamma;
                } else {
                    q = bf2f(rr[d_]); const float sg = sigmoidf_(bf2f(rr[128 + d_]));
                    f = lbv + (1.0f - lbv) * sg; k = (1.0f - lbv) * (1.0f - sg);
                }
                Pc *= f;
                Qt[t * QP + d_] = f2bf(q * Pc);
                kt[i] = k * __builtin_amdgcn_rcpf(Pc);
                Kt[t * QP + d_] = f2bf(kt[i]);
            }
            PC[c2_ * 128 + d_] = Pc;
            u32x4 u0, u1;
            u0.x = cvt_pk_bf16(kt[0] * Pc, kt[1] * Pc); u0.y = cvt_pk_bf16(kt[2] * Pc, kt[3] * Pc); u0.z = cvt_pk_bf16(kt[4] * Pc, kt[5] * Pc); u0.w = cvt_pk_bf16(kt[6] * Pc, kt[7] * Pc);
            u1.x = cvt_pk_bf16(kt[8] * Pc, kt[9] * Pc); u1.y = cvt_pk_bf16(kt[10] * Pc, kt[11] * Pc); u1.z = cvt_pk_bf16(kt[12] * Pc, kt[13] * Pc); u1.w = cvt_pk_bf16(kt[14] * Pc, kt[15] * Pc);
            *(u32x4*)(KhT + (c2_ * 128 + d_) * 16) = u0; *(u32x4*)(KhT + (c2_ * 128 + d_) * 16 + 8) = u1;
        } else {
            float vv[16];
#pragma unroll
            for (int i = 0; i < 16; ++i) {
                const int t = c2_ * 16 + i; const bf16_t* rr = raw + t * RP;
                vv[i] = bf2f(rr[256 + d_]);
                Gt[t * 128 + d_] = siluf_(bf2f(rr[384 + d_]));
            }
            u32x4 u0, u1;
            u0.x = cvt_pk_bf16(vv[0], vv[1]); u0.y = cvt_pk_bf16(vv[2], vv[3]); u0.z = cvt_pk_bf16(vv[4], vv[5]); u0.w = cvt_pk_bf16(vv[6], vv[7]);
            u1.x = cvt_pk_bf16(vv[8], vv[9]); u1.y = cvt_pk_bf16(vv[10], vv[11]); u1.z = cvt_pk_bf16(vv[12], vv[13]); u1.w = cvt_pk_bf16(vv[14], vv[15]);
            *(u32x4*)(VT + (c2_ * 128 + d_) * 16) = u0; *(u32x4*)(VT + (c2_ * 128 + d_) * 16 + 8) = u1;
        }
        __syncthreads();
        for (int c2 = 0; c2 < 2; ++c2) {
            if (c2 * 16 >= ns) break;
            const bf16_t* qrow = Qt + (c2 * 16 + fn) * QP; const bf16_t* krow = Kt + (c2 * 16 + fn) * QP;
            f32x4 at4 = {0.f, 0.f, 0.f, 0.f};
#pragma unroll
            for (int ks = 0; ks < 4; ++ks) at4 = __builtin_amdgcn_mfma_f32_16x16x32_bf16(*(const bf16x8*)(krow + ks * 32 + g * 8), *(const bf16x8*)(qrow + ks * 32 + g * 8), at4, 0, 0, 0);
            u32x4 ua; ua.x = cvt_pk_bf16((4 * g + 0 <= fn) ? at4[0] : 0.f, (4 * g + 1 <= fn) ? at4[1] : 0.f); ua.y = cvt_pk_bf16((4 * g + 2 <= fn) ? at4[2] : 0.f, (4 * g + 3 <= fn) ? at4[3] : 0.f); ua.z = 0u; ua.w = 0u;
            const u32x2 vlo = *(const u32x2*)(VT + (c2 * 128 + vs + fn) * 16 + 4 * g);
            u32x4 uv; uv.x = vlo.x; uv.y = vlo.y; uv.z = 0u; uv.w = 0u;
            const bf16x8 vb = __builtin_bit_cast(bf16x8, uv);
            f32x4 oacc = __builtin_amdgcn_mfma_f32_16x16x32_bf16(__builtin_bit_cast(bf16x8, ua), vb, (f32x4){0.f, 0.f, 0.f, 0.f}, 0, 0, 0);
#pragma unroll
            for (int ks = 0; ks < 4; ++ks) {
                const u32x2 qa = *(const u32x2*)(qrow + (2 * ks) * 16 + 4 * g), qb = *(const u32x2*)(qrow + (2 * ks + 1) * 16 + 4 * g);
                u32x4 uq; uq.x = qa.x; uq.y = qa.y; uq.z = qb.x; uq.w = qb.y;
                u32x4 us; us.x = cvt_pk_bf16(S[2 * ks][0], S[2 * ks][1]); us.y = cvt_pk_bf16(S[2 * ks][2], S[2 * ks][3]); us.z = cvt_pk_bf16(S[2 * ks + 1][0], S[2 * ks + 1][1]); us.w = cvt_pk_bf16(S[2 * ks + 1][2], S[2 * ks + 1][3]);
                oacc = __builtin_amdgcn_mfma_f32_16x16x32_bf16(__builtin_bit_cast(bf16x8, uq), __builtin_bit_cast(bf16x8, us), oacc, 0, 0, 0);
            }
#pragma unroll
            for (int jj = 0; jj < 4; ++jj) O[(c2 * 16 + 4 * g + jj) * 128 + vs + fn] = oacc[jj];
#pragma unroll
            for (int T = 0; T < 8; ++T) {
                const float4 pc4 = *(const float4*)(PC + c2 * 128 + T * 16 + 4 * g);
                const u32x2 kh = *(const u32x2*)(KhT + (c2 * 128 + T * 16 + fn) * 16 + 4 * g);
                u32x4 uk; uk.x = kh.x; uk.y = kh.y; uk.z = 0u; uk.w = 0u;
                f32x4 sc = S[T]; sc[0] *= pc4.x; sc[1] *= pc4.y; sc[2] *= pc4.z; sc[3] *= pc4.w;
                S[T] = __builtin_amdgcn_mfma_f32_16x16x32_bf16(__builtin_bit_cast(bf16x8, uk), vb, sc, 0, 0, 0);
            }
        }
        if (more) raw_store<PPR, NROW, NLD>(rg, raw, tid);
        __syncthreads();
        for (int t = w; t < ns; t += 8) {
            const size_t row = brow + t0 + t;
            const float2 o2 = *(const float2*)(O + t * 128 + lane * 2);
            const float2 g2 = *(const float2*)(Gt + t * 128 + lane * 2);
            const int v = lane * 2;
            if (!HG) {
                const float mean = wave_sum(o2.x + o2.y) * (1.0f / 128.0f);
                const float x0 = o2.x - mean, x1 = o2.y - mean;
                const float var = wave_sum(x0 * x0 + x1 * x1) * (1.0f / 128.0f);
                const float rs = rsqrtf(var + EPS);
                *(unsigned*)(Y + row * D + h * 128 + v) = cvt_pk_bf16(x0 * rs * g2.x, x1 * rs * g2.y);
            } else {
                const float ms = wave_sum(o2.x * o2.x + o2.y * o2.y) * (1.0f / 128.0f);
                const float rs = rsqrtf(ms + EPS);
                *(unsigned*)(Y + row * D + 512 + h * 128 + v) = cvt_pk_bf16(o2.x * rs * hgn.x * g2.x, o2.y * rs * hgn.y * g2.y);
            }
        }
    }
}
__device__ __forceinline__ void even_scan_phase(const Params& p, float* lds) {
    for (int item = obid(); item < 256; item += gridDim.x) {
        const int idx = item & 127, b = idx >> 2, h = idx & 3;
        if (item < 128) even_item<false>(p, lds, b, h); else even_item<true>(p, lds, b, h);
        __syncthreads();
    }
}

typedef float f32x2 __attribute__((ext_vector_type(2)));
constexpr int TCR = 16;
constexpr int RW_ITEM_FLOATS = 16256;
__device__ __forceinline__ void rwkv_half(const Params& p, float* lds, int b, int h, int half) {
    const bf16_t* P = (const bf16_t*)(p.ws + WS_BIG);
    bf16_t* Y = (bf16_t*)(p.ws + WS_Y2);
    float* R = lds; float* W = R + TCR * 64; float* Kk = W + TCR * 64; float* Vv = Kk + TCR * 64; float* A = Vv + TCR * 64; float* Bb = A + TCR * 64;
    float* O = Bb + TCR * 64; float* G = O + TCR * 64; float* RK = G + TCR * 64; float* WP = RK + 64; float* AP = WP + TCR * 64;
    constexpr int LAP = 264;
    bf16_t* LAb = (bf16_t*)(AP + TCR * 64);
    bf16_t* LAbS = (bf16_t*)((lds - half * RW_ITEM_FLOATS) + (8 * TCR * 64 + 64 + 2 * TCR * 64));
    bf16_t* raw = LAb + TCR * LAP;
    constexpr int PPR = 56, NROW = 17, NLD = 4, RP = 448;
    const float* mu = p.in[9]; const float* w2 = p.in[11]; const float* a2 = p.in[13]; const float* g2 = p.in[14];
    const int tid = otid() & 255, lane = tid & 63, lw = tid >> 6;
    const int kg = lane & 7, vp = lw * 8 + (lane >> 3);
    const int hc = h * 64 + lane;
    auto col = [&](int pc) { return pc < 24 ? (pc >> 3) * 512 + h * 64 + (pc & 7) * 8 : 1536 + (pc - 24) * 8; };
    const size_t brow = (size_t)b * L;
    const int j1 = tid; const float mu1 = mu[1536 + j1];
    const int tq = tid >> 4, cl = tid & 15, hc4 = h * 64 + 4 * cl;
    const float4 mu_r = *(const float4*)(mu + hc4), mu_k = *(const float4*)(mu + 512 + hc4), mu_v = *(const float4*)(mu + 1024 + hc4);
    const float4 w0c = *(const float4*)(p.in[10] + hc4), a0c = *(const float4*)(p.in[12] + hc4), kksc = *(const float4*)(p.in[15] + hc4), kasc = *(const float4*)(p.in[16] + hc4);
    const float4 rkc = *(const float4*)(p.in[17] + hc4), lnwc = *(const float4*)(p.in[18] + hc4), lnbc = *(const float4*)(p.in[19] + hc4);
    f32x2 S[8];
#pragma unroll
    for (int i = 0; i < 8; ++i) S[i] = (f32x2){0.f, 0.f};
    const int fn = lane & 15, fkq = lane >> 4;
    bf16x8 bw[2], ba[2], bg[4];
    {
        const int cc = h * 64 + lw * 16 + fn;
#pragma unroll
        for (int ks = 0; ks < 2; ++ks) {
            float e[8], f[8];
#pragma unroll
            for (int j = 0; j < 8; ++j) { e[j] = w2[(ks * 32 + fkq * 8 + j) * 512 + cc]; f[j] = a2[(ks * 32 + fkq * 8 + j) * 512 + cc]; }
            u32x4 u; u.x = cvt_pk_bf16(e[0], e[1]); u.y = cvt_pk_bf16(e[2], e[3]); u.z = cvt_pk_bf16(e[4], e[5]); u.w = cvt_pk_bf16(e[6], e[7]); bw[ks] = __builtin_bit_cast(bf16x8, u);
            u.x = cvt_pk_bf16(f[0], f[1]); u.y = cvt_pk_bf16(f[2], f[3]); u.z = cvt_pk_bf16(f[4], f[5]); u.w = cvt_pk_bf16(f[6], f[7]); ba[ks] = __builtin_bit_cast(bf16x8, u);
        }
#pragma unroll
        for (int ks = 0; ks < 4; ++ks) {
            float e[8];
#pragma unroll
            for (int j = 0; j < 8; ++j) e[j] = g2[(ks * 32 + fkq * 8 + j) * 512 + cc];
            u32x4 u; u.x = cvt_pk_bf16(e[0], e[1]); u.y = cvt_pk_bf16(e[2], e[3]); u.z = cvt_pk_bf16(e[4], e[5]); u.w = cvt_pk_bf16(e[6], e[7]); bg[ks] = __builtin_bit_cast(bf16x8, u);
        }
    }
    u32x4 rg[NLD];
    __syncthreads();
    raw_fetch<PPR, NROW, NLD, 256>(rg, P, tid, brow, -1, col); raw_store<PPR, NROW, NLD, 256>(rg, raw, tid);
    for (int t0 = 0; t0 < L; t0 += TCR) {
        const bool more = (t0 + TCR < L);
        if (t0 == 0) __syncthreads();
#pragma unroll 4
        for (int t = half * 8; t < half * 8 + 8; ++t) {
            const float cur = bf2f(raw[(t + 1) * RP + 192 + j1]), prev = bf2f(raw[t * RP + 192 + j1]);
            const float x = cur + (prev - cur) * mu1;
            float y;
            if (j1 < 64) y = 1.0f - 2.0f * __builtin_amdgcn_rcpf(1.0f + __expf(2.0f * x)); else if (j1 < 128) y = x; else y = sigmoidf_(x);
            LAbS[t * LAP + j1] = f2bf(y);
        }
        __syncthreads();
        {
            const bf16_t* ap = LAbS + fn * LAP + fkq * 8;
            f32x4 cw4 = {0.f, 0.f, 0.f, 0.f}, ca4 = {0.f, 0.f, 0.f, 0.f}, cg4 = {0.f, 0.f, 0.f, 0.f};
#pragma unroll
            for (int ks = 0; ks < 2; ++ks) cw4 = __builtin_amdgcn_mfma_f32_16x16x32_bf16(*(const bf16x8*)(ap + ks * 32), bw[ks], cw4, 0, 0, 0);
#pragma unroll
            for (int ks = 0; ks < 2; ++ks) ca4 = __builtin_amdgcn_mfma_f32_16x16x32_bf16(*(const bf16x8*)(ap + 64 + ks * 32), ba[ks], ca4, 0, 0, 0);
#pragma unroll
            for (int ks = 0; ks < 4; ++ks) cg4 = __builtin_amdgcn_mfma_f32_16x16x32_bf16(*(const bf16x8*)(ap + 128 + ks * 32), bg[ks], cg4, 0, 0, 0);
#pragma unroll
            for (int j = 0; j < 4; ++j) { const int o = (fkq * 4 + j) * 64 + lw * 16 + fn; WP[o] = cw4[j]; AP[o] = ca4[j]; G[o] = cg4[j]; }
        }
        __syncthreads();
        {
            const int t = tq;
            const u32x2 c0 = *(const u32x2*)(raw + (t + 1) * RP + 4 * cl), c1 = *(const u32x2*)(raw + (t + 1) * RP + 64 + 4 * cl), c2v = *(const u32x2*)(raw + (t + 1) * RP + 128 + 4 * cl);
            const u32x2 p0 = *(const u32x2*)(raw + t * RP + 4 * cl), p1 = *(const u32x2*)(raw + t * RP + 64 + 4 * cl), p2 = *(const u32x2*)(raw + t * RP + 128 + 4 * cl);
            auto up4 = [](u32x2 u, float (&o)[4]) { o[0] = __uint_as_float(u.x << 16); o[1] = __uint_as_float(u.x & 0xffff0000u); o[2] = __uint_as_float(u.y << 16); o[3] = __uint_as_float(u.y & 0xffff0000u); };
            float cr[4], ck[4], cv[4], pr[4], pk[4], pv[4];
            up4(c0, cr); up4(c1, ck); up4(c2v, cv); up4(p0, pr); up4(p1, pk); up4(p2, pv);
            const float4 wp4 = *(const float4*)(WP + t * 64 + 4 * cl), ap4 = *(const float4*)(AP + t * 64 + 4 * cl);
            const float mur[4] = {mu_r.x, mu_r.y, mu_r.z, mu_r.w}, muk[4] = {mu_k.x, mu_k.y, mu_k.z, mu_k.w}, muv[4] = {mu_v.x, mu_v.y, mu_v.z, mu_v.w};
            const float w0a[4] = {w0c.x, w0c.y, w0c.z, w0c.w}, a0a[4] = {a0c.x, a0c.y, a0c.z, a0c.w}, kksa[4] = {kksc.x, kksc.y, kksc.z, kksc.w}, kasa[4] = {kasc.x, kasc.y, kasc.z, kasc.w}, rka[4] = {rkc.x, rkc.y, rkc.z, rkc.w};
            const float wpa[4] = {wp4.x, wp4.y, wp4.z, wp4.w}, apa[4] = {ap4.x, ap4.y, ap4.z, ap4.w};
            float rr[4], kr[4], vr[4], dec[4], av[4], kkr[4], kmod[4]; float ssq = 0.f, rks = 0.f;
#pragma unroll
            for (int e = 0; e < 4; ++e) {
                rr[e] = cr[e] + (pr[e] - cr[e]) * mur[e]; kr[e] = ck[e] + (pk[e] - ck[e]) * muk[e]; vr[e] = cv[e] + (pv[e] - cv[e]) * muv[e];
                const float lw_ = -softplusf_(-(w0a[e] + wpa[e])) - 0.5f;
                dec[e] = __expf(-__expf(lw_));
                av[e] = sigmoidf_(a0a[e] + apa[e]);
                kkr[e] = kr[e] * kksa[e]; ssq += kkr[e] * kkr[e];
                kmod[e] = kr[e] * (1.0f + (av[e] - 1.0f) * kasa[e]);
                rks += rr[e] * kmod[e] * rka[e];
            }
            ssq = allreduce16(ssq); rks = allreduce16(rks);
            const float rn = rsqrtf(ssq + EPS);
            *(float4*)(R + t * 64 + 4 * cl) = make_float4(rr[0], rr[1], rr[2], rr[3]);
            *(float4*)(W + t * 64 + 4 * cl) = make_float4(dec[0], dec[1], dec[2], dec[3]);
            *(float4*)(Kk + t * 64 + 4 * cl) = make_float4(kmod[0], kmod[1], kmod[2], kmod[3]);
            *(float4*)(Vv + t * 64 + 4 * cl) = make_float4(vr[0], vr[1], vr[2], vr[3]);
            *(float4*)(A + t * 64 + 4 * cl) = make_float4(-kkr[0] * rn, -kkr[1] * rn, -kkr[2] * rn, -kkr[3] * rn);
            *(float4*)(Bb + t * 64 + 4 * cl) = make_float4(kkr[0] * rn * av[0], kkr[1] * rn * av[1], kkr[2] * rn * av[2], kkr[3] * rn * av[3]);
            if (cl == 0) RK[t] = rks;
        }
        __syncthreads();
        if (more) raw_fetch<PPR, NROW, NLD, 256>(rg, P, tid, brow, t0 + TCR - 1, col);
        {
            struct Ops { float4 aa, ab, wa, wb, ba, bb, ka, kb, ra, rb; float2 vv; };
            auto ld = [&](Ops& o, int t) {
                o.aa = *(const float4*)(A + t * 64 + kg * 8); o.ab = *(const float4*)(A + t * 64 + kg * 8 + 4);
                o.wa = *(const float4*)(W + t * 64 + kg * 8); o.wb = *(const float4*)(W + t * 64 + kg * 8 + 4);
                o.ba = *(const float4*)(Bb + t * 64 + kg * 8); o.bb = *(const float4*)(Bb + t * 64 + kg * 8 + 4);
                o.ka = *(const float4*)(Kk + t * 64 + kg * 8); o.kb = *(const float4*)(Kk + t * 64 + kg * 8 + 4);
                o.ra = *(const float4*)(R + t * 64 + kg * 8); o.rb = *(const float4*)(R + t * 64 + kg * 8 + 4);
                o.vv = *(const float2*)(Vv + t * 64 + 2 * vp);
            };
            auto step = [&](const Ops& x, int t) {
                const float a8[8] = {x.aa.x, x.aa.y, x.aa.z, x.aa.w, x.ab.x, x.ab.y, x.ab.z, x.ab.w};
                const float w8[8] = {x.wa.x, x.wa.y, x.wa.z, x.wa.w, x.wb.x, x.wb.y, x.wb.z, x.wb.w};
                const float b8[8] = {x.ba.x, x.ba.y, x.ba.z, x.ba.w, x.bb.x, x.bb.y, x.bb.z, x.bb.w};
                const float k8[8] = {x.ka.x, x.ka.y, x.ka.z, x.ka.w, x.kb.x, x.kb.y, x.kb.z, x.kb.w};
                const float r8[8] = {x.ra.x, x.ra.y, x.ra.z, x.ra.w, x.rb.x, x.rb.y, x.rb.z, x.rb.w};
                const f32x2 vv2 = {x.vv.x, x.vv.y};
                f32x2 sa0 = {0.f, 0.f}, sa1 = {0.f, 0.f};
#pragma unroll
                for (int i = 0; i < 8; i += 2) { sa0 += S[i] * a8[i]; sa1 += S[i + 1] * a8[i + 1]; }
                f32x2 sa = sa0 + sa1; sa.x = allreduce8(sa.x); sa.y = allreduce8(sa.y);
                f32x2 y0 = {0.f, 0.f}, y1 = {0.f, 0.f};
#pragma unroll
                for (int i = 0; i < 8; i += 2) {
                    S[i] = S[i] * w8[i] + sa * b8[i] + vv2 * k8[i]; y0 += S[i] * r8[i];
                    S[i + 1] = S[i + 1] * w8[i + 1] + sa * b8[i + 1] + vv2 * k8[i + 1]; y1 += S[i + 1] * r8[i + 1];
                }
                f32x2 y = y0 + y1; y.x = allreduce8(y.x); y.y = allreduce8(y.y);
                if (kg == 0) *(float2*)(O + t * 64 + 2 * vp) = make_float2(y.x, y.y);
            };
            Ops A_, B_; ld(A_, 0);
#pragma unroll
            for (int t = 0; t < TCR; t += 2) {
                ld(B_, t + 1); step(A_, t);
                if (t + 2 < TCR) ld(A_, t + 2);
                step(B_, t + 1);
            }
        }
        if (more) raw_store<PPR, NROW, NLD, 256>(rg, raw, tid);
        __syncthreads();
        {
            const int t = tq; const size_t row = brow + t0 + t;
            const float4 y4 = *(const float4*)(O + t * 64 + 4 * cl), v4 = *(const float4*)(Vv + t * 64 + 4 * cl), g4 = *(const float4*)(G + t * 64 + 4 * cl);
            const float mean = allreduce16((y4.x + y4.y) + (y4.z + y4.w)) * (1.0f / 64.0f);
            const float x0 = y4.x - mean, x1 = y4.y - mean, x2 = y4.z - mean, x3 = y4.w - mean;
            const float var = allreduce16((x0 * x0 + x1 * x1) + (x2 * x2 + x3 * x3)) * (1.0f / 64.0f);
            const float rs = rsqrtf(var + 64e-5f), rkt = RK[t];
            const float o0 = (x0 * rs * lnwc.x + lnbc.x + rkt * v4.x) * g4.x, o1 = (x1 * rs * lnwc.y + lnbc.y + rkt * v4.y) * g4.y;
            const float o2 = (x2 * rs * lnwc.z + lnbc.z + rkt * v4.z) * g4.z, o3 = (x3 * rs * lnwc.w + lnbc.w + rkt * v4.w) * g4.w;
            u32x2 ow; ow.x = cvt_pk_bf16(o0, o1); ow.y = cvt_pk_bf16(o2, o3);
            *(u32x2*)(Y + row * D + hc4) = ow;
        }
    }
}
template <int CTRL> __device__ __forceinline__ float dpp0f(float x) { return __int_as_float(__builtin_amdgcn_update_dpp(0, __float_as_int(x), CTRL, 0xF, 0xF, true)); }
__device__ __forceinline__ void gdn_item(const Params& p, float* lds, int b, int h) {
    const bf16_t* P = (const bf16_t*)(p.ws + WS_BIG);
    bf16_t* Y = (bf16_t*)(p.ws + WS_Y2);
    constexpr int QP = 136, MP = 24;
    float* O = lds; float* Gt = O + TCH * 128; float* GB = Gt + TCH * 128; float* CG = GB + 64;
    bf16_t* MinvB = (bf16_t*)(CG + 64); bf16_t* MinvE = MinvB + 2 * 16 * MP;
    bf16_t* Qb = MinvE + 2 * 16 * MP; bf16_t* Kb = Qb + TCH * QP; bf16_t* Wb = Kb + TCH * QP;
    bf16_t* KT = Wb + TCH * QP; bf16_t* VT = KT + 2 * 128 * 16;
    bf16_t* raw = VT + 2 * 128 * 16;
    constexpr int PPR = 65, NROW = 35, NLD = 5, RP = 520;
    const float* cw = p.in[20];
    const int tid = otid(), lane = tid & 63, w = tid >> 6;
    const int fn = lane & 15, g = lane >> 4, vs = w * 16;
    auto col = [&](int pc) { return pc < 48 ? 1792 + (pc >> 4) * 512 + h * 128 + (pc & 15) * 8 : (pc < 64 ? 3328 + h * 128 + (pc - 48) * 8 : 3840); };
    const size_t brow = (size_t)b * L;
    const float Aneg = -__expf(p.in[21][h]); const float dtb = p.in[22][h];
    const float2 gn = *(const float2*)(p.in[23] + 2 * lane);
    float cwr[3][4][2];
#pragma unroll
    for (int x = 0; x < 3; ++x)
#pragma unroll
        for (int j = 0; j < 4; ++j) { cwr[x][j][0] = cw[j * 1536 + x * 512 + h * 128 + 2 * lane]; cwr[x][j][1] = cw[j * 1536 + x * 512 + h * 128 + 2 * lane + 1]; }
    f32x4 S[8];
#pragma unroll
    for (int T = 0; T < 8; ++T) S[T] = (f32x4){0.f, 0.f, 0.f, 0.f};
    u32x4 rg[NLD];
    __syncthreads();
    raw_fetch<PPR, NROW, NLD>(rg, P, tid, brow, -3, col); raw_store<PPR, NROW, NLD>(rg, raw, tid);
    for (int t0 = 0; t0 < L; t0 += TCH) {
        const int ns = (L - t0) < TCH ? (L - t0) : TCH;
        const bool more = (t0 + TCH < L);
        __syncthreads();
        if (more) raw_fetch<PPR, NROW, NLD>(rg, P, tid, brow, t0 + TCH - 3, col);
        for (int t = w; t < ns; t += 8) {
            float xs[3][2];
#pragma unroll
            for (int x = 0; x < 3; ++x) {
                float a0 = 0.f, a1 = 0.f;
#pragma unroll
                for (int j = 0; j < 4; ++j) {
                    const unsigned wv = *(const unsigned*)(raw + (t + j) * RP + x * 128 + 2 * lane);
                    a0 += cwr[x][j][0] * __uint_as_float(wv << 16); a1 += cwr[x][j][1] * __uint_as_float(wv & 0xffff0000u);
                }
                xs[x][0] = siluf_(a0); xs[x][1] = siluf_(a1);
            }
            const float sq = wave_sum(xs[0][0] * xs[0][0] + xs[0][1] * xs[0][1]);
            const float sk = wave_sum(xs[1][0] * xs[1][0] + xs[1][1] * xs[1][1]);
            const float rq = rsqrtf(sq + EPS) * 0.08838834764831845f, rk = rsqrtf(sk + EPS);
            const int c2 = t >> 4, i = t & 15;
            *(unsigned*)(Qb + t * QP + 2 * lane) = cvt_pk_bf16(xs[0][0] * rq, xs[0][1] * rq);
            const unsigned kw = cvt_pk_bf16(xs[1][0] * rk, xs[1][1] * rk);
            *(unsigned*)(Kb + t * QP + 2 * lane) = kw;
            KT[(c2 * 128 + 2 * lane) * 16 + i] = (bf16_t)(kw & 0xffffu); KT[(c2 * 128 + 2 * lane + 1) * 16 + i] = (bf16_t)(kw >> 16);
            const unsigned vw = cvt_pk_bf16(xs[2][0], xs[2][1]);
            VT[(c2 * 128 + 2 * lane) * 16 + i] = (bf16_t)(vw & 0xffffu); VT[(c2 * 128 + 2 * lane + 1) * 16 + i] = (bf16_t)(vw >> 16);
            const unsigned gw = *(const unsigned*)(raw + (t + 3) * RP + 384 + 2 * lane);
            *(float2*)(Gt + t * 128 + 2 * lane) = make_float2(siluf_(__uint_as_float(gw << 16)), siluf_(__uint_as_float(gw & 0xffff0000u)));
            if (lane == 0) {
                const float al = bf2f(raw[(t + 3) * RP + 512 + h]), be = bf2f(raw[(t + 3) * RP + 516 + h]);
                GB[t * 2] = Aneg * softplusf_(al + dtb); GB[t * 2 + 1] = sigmoidf_(be);
            }
        }
        __syncthreads();
        if (w < 2 && w * 16 < ns) {
            const int c2 = w;
            float cgf = GB[(c2 * 16 + fn) * 2]; const float betf = GB[(c2 * 16 + fn) * 2 + 1];
            cgf += dpp0f<0x111>(cgf); cgf += dpp0f<0x112>(cgf); cgf += dpp0f<0x114>(cgf); cgf += dpp0f<0x118>(cgf);
            if (g == 0) CG[c2 * 16 + fn] = cgf;
            const bf16_t* krow = Kb + (c2 * 16 + fn) * QP;
            f32x4 kk4 = {0.f, 0.f, 0.f, 0.f};
#pragma unroll
            for (int ks = 0; ks < 4; ++ks) { const bf16x8 kf = *(const bf16x8*)(krow + ks * 32 + g * 8); kk4 = __builtin_amdgcn_mfma_f32_16x16x32_bf16(kf, kf, kk4, 0, 0, 0); }
            const float4 cga = *(const float4*)(CG + c2 * 16 + 4 * g);
            const float cga4[4] = {cga.x, cga.y, cga.z, cga.w};
            float m4[4];
#pragma unroll
            for (int jj = 0; jj < 4; ++jj) { const float ba = GB[(c2 * 16 + 4 * g + jj) * 2 + 1]; m4[jj] = (fn < 4 * g + jj) ? ba * kk4[jj] * __expf(cga4[jj] - cgf) : 0.f; }
            float x[16];
#pragma unroll
            for (int i = 0; i < 16; ++i) {
                float acc = (fn == i) ? 1.f : 0.f;
#pragma unroll
                for (int j = 0; j < i; ++j) {
                    const float mij = __int_as_float(__builtin_amdgcn_readlane(__float_as_int(m4[i & 3]), j + 16 * (i >> 2)));
                    acc -= mij * x[j];
                }
                x[i] = acc;
            }
            if (g == 0) {
                const float eb = betf * __expf(cgf);
#pragma unroll
                for (int i = 0; i < 16; ++i) { MinvB[(c2 * 16 + i) * MP + fn] = f2bf(x[i] * betf); MinvE[(c2 * 16 + i) * MP + fn] = f2bf(x[i] * eb); }
            }
        }
        __syncthreads();
        for (int c2 = 0; c2 < 2; ++c2) {
            if (c2 * 16 >= ns) break;
            const u32x2 ma = *(const u32x2*)(MinvE + (c2 * 16 + fn) * MP + 4 * g); const u32x2 kt = *(const u32x2*)(KT + (c2 * 128 + vs + fn) * 16 + 4 * g);
            u32x4 ua; ua.x = ma.x; ua.y = ma.y; ua.z = 0u; ua.w = 0u; u32x4 ub; ub.x = kt.x; ub.y = kt.y; ub.z = 0u; ub.w = 0u;
            const f32x4 c4 = __builtin_amdgcn_mfma_f32_16x16x32_bf16(__builtin_bit_cast(bf16x8, ua), __builtin_bit_cast(bf16x8, ub), (f32x4){0.f, 0.f, 0.f, 0.f}, 0, 0, 0);
#pragma unroll
            for (int jj = 0; jj < 4; ++jj) Wb[(c2 * 16 + 4 * g + jj) * QP + vs + fn] = f2bf(c4[jj]);
        }
        __syncthreads();
        for (int c2 = 0; c2 < 2; ++c2) {
            if (c2 * 16 >= ns) break;
            const float4 cgt = *(const float4*)(CG + c2 * 16 + 4 * g); const float cgt4[4] = {cgt.x, cgt.y, cgt.z, cgt.w};
            const float cgf = CG[c2 * 16 + fn], cg15 = CG[c2 * 16 + 15];
            const bf16_t* qrow = Qb + (c2 * 16 + fn) * QP; const bf16_t* krow = Kb + (c2 * 16 + fn) * QP; const bf16_t* wrow = Wb + (c2 * 16 + fn) * QP;
            f32x4 at4 = {0.f, 0.f, 0.f, 0.f};
#pragma unroll
            for (int ks = 0; ks < 4; ++ks) at4 = __builtin_amdgcn_mfma_f32_16x16x32_bf16(*(const bf16x8*)(krow + ks * 32 + g * 8), *(const bf16x8*)(qrow + ks * 32 + g * 8), at4, 0, 0, 0);
            float qv[4];
#pragma unroll
            for (int jj = 0; jj < 4; ++jj) qv[jj] = (4 * g + jj <= fn) ? at4[jj] * __expf(cgf - cgt4[jj]) : 0.f;
            u32x4 uqk; uqk.x = cvt_pk_bf16(qv[0], qv[1]); uqk.y = cvt_pk_bf16(qv[2], qv[3]); uqk.z = 0u; uqk.w = 0u;
            const u32x2 mb = *(const u32x2*)(MinvB + (c2 * 16 + fn) * MP + 4 * g); const u32x2 vt = *(const u32x2*)(VT + (c2 * 128 + vs + fn) * 16 + 4 * g);
            u32x4 uma; uma.x = mb.x; uma.y = mb.y; uma.z = 0u; uma.w = 0u; u32x4 uvt; uvt.x = vt.x; uvt.y = vt.y; uvt.z = 0u; uvt.w = 0u;
            const f32x4 u4 = __builtin_amdgcn_mfma_f32_16x16x32_bf16(__builtin_bit_cast(bf16x8, uma), __builtin_bit_cast(bf16x8, uvt), (f32x4){0.f, 0.f, 0.f, 0.f}, 0, 0, 0);
            f32x4 ws4 = {0.f, 0.f, 0.f, 0.f}, qs4 = {0.f, 0.f, 0.f, 0.f};
#pragma unroll
            for (int ks = 0; ks < 4; ++ks) {
                u32x4 us; us.x = cvt_pk_bf16(S[2 * ks][0], S[2 * ks][1]); us.y = cvt_pk_bf16(S[2 * ks][2], S[2 * ks][3]); us.z = cvt_pk_bf16(S[2 * ks + 1][0], S[2 * ks + 1][1]); us.w = cvt_pk_bf16(S[2 * ks + 1][2], S[2 * ks + 1][3]);
                const bf16x8 sb = __builtin_bit_cast(bf16x8, us);
                const u32x2 wa = *(const u32x2*)(wrow + (2 * ks) * 16 + 4 * g), wb2 = *(const u32x2*)(wrow + (2 * ks + 1) * 16 + 4 * g);
                u32x4 uw; uw.x = wa.x; uw.y = wa.y; uw.z = wb2.x; uw.w = wb2.y;
                ws4 = __builtin_amdgcn_mfma_f32_16x16x32_bf16(__builtin_bit_cast(bf16x8, uw), sb, ws4, 0, 0, 0);
                const u32x2 qa = *(const u32x2*)(qrow + (2 * ks) * 16 + 4 * g), qb2 = *(const u32x2*)(qrow + (2 * ks + 1) * 16 + 4 * g);
                u32x4 uq; uq.x = qa.x; uq.y = qa.y; uq.z = qb2.x; uq.w = qb2.y;
                qs4 = __builtin_amdgcn_mfma_f32_16x16x32_bf16(__builtin_bit_cast(bf16x8, uq), sb, qs4, 0, 0, 0);
            }
            float vn[4];
#pragma unroll
            for (int jj = 0; jj < 4; ++jj) { vn[jj] = u4[jj] - ws4[jj]; qs4[jj] *= __expf(cgt4[jj]); }
            u32x4 uvn; uvn.x = cvt_pk_bf16(vn[0], vn[1]); uvn.y = cvt_pk_bf16(vn[2], vn[3]); uvn.z = 0u; uvn.w = 0u;
            const f32x4 o4 = __builtin_amdgcn_mfma_f32_16x16x32_bf16(__builtin_bit_cast(bf16x8, uqk), __builtin_bit_cast(bf16x8, uvn), qs4, 0, 0, 0);
#pragma unroll
            for (int jj = 0; jj < 4; ++jj) O[(c2 * 16 + 4 * g + jj) * 128 + vs + fn] = o4[jj];
            u32x4 uvd; uvd.x = cvt_pk_bf16(vn[0] * __expf(cg15 - cgt4[0]), vn[1] * __expf(cg15 - cgt4[1])); uvd.y = cvt_pk_bf16(vn[2] * __expf(cg15 - cgt4[2]), vn[3] * __expf(cg15 - cgt4[3])); uvd.z = 0u; uvd.w = 0u;
            const bf16x8 vdb = __builtin_bit_cast(bf16x8, uvd);
            const float e15 = __expf(cg15);
#pragma unroll
            for (int T = 0; T < 8; ++T) {
                const u32x2 kh = *(const u32x2*)(KT + (c2 * 128 + T * 16 + fn) * 16 + 4 * g);
                u32x4 uk; uk.x = kh.x; uk.y = kh.y; uk.z = 0u; uk.w = 0u;
                f32x4 sc = S[T]; sc[0] *= e15; sc[1] *= e15; sc[2] *= e15; sc[3] *= e15;
                S[T] = __builtin_amdgcn_mfma_f32_16x16x32_bf16(__builtin_bit_cast(bf16x8, uk), vdb, sc, 0, 0, 0);
            }
        }
        if (more) raw_store<PPR, NROW, NLD>(rg, raw, tid);
        __syncthreads();
        for (int t = w; t < ns; t += 8) {
            const size_t row = brow + t0 + t;
            const float2 o2 = *(const float2*)(O + t * 128 + lane * 2);
            const float2 g2 = *(const float2*)(Gt + t * 128 + lane * 2);
            const int v = lane * 2;
            const float ms = wave_sum(o2.x * o2.x + o2.y * o2.y) * (1.0f / 128.0f);
            const float rs = rsqrtf(ms + EPS);
            *(unsigned*)(Y + row * D + 512 + h * 128 + v) = cvt_pk_bf16(o2.x * rs * gn.x * g2.x, o2.y * rs * gn.y * g2.y);
        }
    }
}
__device__ __forceinline__ void odd_scan_phase(const Params& p, float* lds) {
    for (int item = obid(); item < 256; item += gridDim.x) {
        if (item < 128) { gdn_item(p, lds, item >> 2, item & 3); __syncthreads(); }
        else {
            const int half = otid() >> 8; const int i0 = (item - 128) * 2 + half;
            rwkv_half(p, lds + half * RW_ITEM_FLOATS, i0 >> 3, i0 & 7, half); __syncthreads();
        }
    }
}

#define XB_TMO      128
#define XB_XCNT(j)  (256  + 64 * (j))
#define XB_XSUB(j)  (1280 + 64 * (j))
#define XB_XGEN(j)  (2304 + 64 * (j))
#define XB_TOP      3328
#define XB_TOPGEN   3392
#define XCD_BAR_WORDS 3456
#define XB_SPIN_CAP (1u << 18)
__device__ __forceinline__ unsigned xb_ld(unsigned* p)              { return __hip_atomic_load(p, __ATOMIC_RELAXED, __HIP_MEMORY_SCOPE_AGENT); }
__device__ __forceinline__ unsigned xb_add(unsigned* p, unsigned v) { return __hip_atomic_fetch_add(p, v, __ATOMIC_RELAXED, __HIP_MEMORY_SCOPE_AGENT); }
__device__ __forceinline__ unsigned xb_xcc_id() { return (unsigned)__builtin_amdgcn_s_getreg((3 << 11) | 20) & 0xFu; }
#define XB_SPIN(cond, bar) do { unsigned _sp = 0; while (cond) { __builtin_amdgcn_s_sleep(1); \
    if ((++_sp & 255u) == 0u) { if (xb_ld(&(bar)[XB_TMO])) break; if (_sp > XB_SPIN_CAP) { atomicAdd(&(bar)[XB_TMO], 1u); break; } } } } while (0)
struct XcdBarrier { unsigned* bar; unsigned x; volatile LAS unsigned* st; };
__device__ __forceinline__ XcdBarrier xcd_barrier_post(unsigned* bar, volatile LAS unsigned* st) {
    XcdBarrier b; b.bar = bar; b.x = xb_xcc_id(); b.st = st;
    if (threadIdx.x == 0) (void)xb_add(&bar[XB_XCNT(b.x)], 1u);
    return b;
}
__device__ __forceinline__ void xcd_barrier_complete(unsigned* bar, unsigned x, unsigned& nloc, unsigned& nx) {
    const unsigned G = gridDim.x * gridDim.y * gridDim.z;
    unsigned sum, cnt, mine, sp = 0u;
    for (;;) {
        sum = 0u; cnt = 0u; mine = 0u;
#pragma unroll
        for (unsigned j = 0; j < 16; ++j) { const unsigned c = xb_ld(&bar[XB_XCNT(j)]); sum += c; cnt += (c > 0u) ? 1u : 0u; mine = (j == x) ? c : mine; }
        if (sum == G) break;
        __builtin_amdgcn_s_sleep(1);
        if ((++sp & 255u) == 0u) { if (xb_ld(&bar[XB_TMO])) break; if (sp > XB_SPIN_CAP) { atomicAdd(&bar[XB_TMO], 1u); break; } }
    }
    nloc = mine > 0u ? mine : 1u; nx = cnt > 0u ? cnt : 1u;
}
__device__ __forceinline__ void xcd_barrier(const XcdBarrier& b) {
    asm volatile("s_waitcnt vmcnt(0)" ::: "memory");
    __syncthreads();
    if (threadIdx.x == 0) {
        unsigned* bar = b.bar;
        __builtin_amdgcn_s_waitcnt(0);
        unsigned nloc = b.st[0], nx = b.st[1];
        if (nloc == 0u) { xcd_barrier_complete(bar, b.x, nloc, nx); b.st[0] = nloc; b.st[1] = nx; }
        const unsigned old = xb_add(&bar[XB_XSUB(b.x)], 1u);
        const unsigned gen = old / nloc;
        if (old + 1u == (gen + 1u) * nloc) {
            __builtin_amdgcn_fence(__ATOMIC_RELEASE, "agent");
            asm volatile("s_waitcnt vmcnt(0)" ::: "memory");
            const unsigned og = xb_add(&bar[XB_TOP], 1u);
            const unsigned tg = og / nx;
            if (og + 1u == (tg + 1u) * nx) xb_add(&bar[XB_TOPGEN], 1u);
            else XB_SPIN(xb_ld(&bar[XB_TOPGEN]) == tg, bar);
            __builtin_amdgcn_fence(__ATOMIC_ACQUIRE, "agent");
            xb_add(&bar[XB_XGEN(b.x)], 1u);
            asm volatile("s_waitcnt vmcnt(0)" ::: "memory");
        } else {
            XB_SPIN(xb_ld(&bar[XB_XGEN(b.x)]) == gen, bar);
            __builtin_amdgcn_fence(__ATOMIC_ACQUIRE, "agent");
            asm volatile("s_waitcnt vmcnt(0)" ::: "memory");
        }
    }
    __syncthreads();
}

__device__ __forceinline__ void sub_barrier(unsigned* word, unsigned nblk) {
    asm volatile("s_waitcnt vmcnt(0)" ::: "memory");
    __syncthreads();
    if (threadIdx.x == 0) {
        __builtin_amdgcn_fence(__ATOMIC_RELEASE, "agent");
        asm volatile("s_waitcnt vmcnt(0)" ::: "memory");
        (void)xb_add(word, 1u);
        unsigned sp = 0;
        while (xb_ld(word) < nblk) { __builtin_amdgcn_s_sleep(2); if (++sp > (1u << 22)) break; }
        __builtin_amdgcn_fence(__ATOMIC_ACQUIRE, "agent");
        asm volatile("s_waitcnt vmcnt(0)" ::: "memory");
    }
    __syncthreads();
}

constexpr int NPHASE = 17;
__global__ void __launch_bounds__(512, 2) hybrid_fwd(Params p) {
    extern __shared__ __attribute__((aligned(16))) unsigned char lds_raw[];
    cg::grid_group grid = cg::this_grid();
    unsigned char* ws = p.ws;
    __shared__ uint4 xb_words;
    if (threadIdx.x == 0) xb_words = make_uint4(0u, 0u, 0u, 0u);
    __syncthreads();
    const XcdBarrier xbar = xcd_barrier_post((unsigned*)(ws + WS_BAR), (volatile LAS unsigned*)&xb_words);
    bf16_t* A1 = (bf16_t*)(ws + WS_A1); bf16_t* BIG = (bf16_t*)(ws + WS_BIG);
    const float* NG = p.in[2];
    for (int ph = p.ph_lo; ph < p.ph_hi; ++ph) {
        int kind = 0;
        pg8::Gemm g{nullptr, nullptr, 0, 0, 0}; pg8::EpiBf16 E{nullptr, 0, 0, nullptr, nullptr, nullptr, (LAS float*)((LAS unsigned char*)lds_raw + 131072)};
        int nmode = 1; const bf16_t* nsrc = nullptr; const float* gA = nullptr; const float* gB = nullptr; int layer = 0;
        const int lyr = ph >= 9 ? 1 : 0; const int q = ph - lyr * 8;
        const bf16_t* Wup = (const bf16_t*)(ws + WS_WB + (lyr ? WB_UP1 : WB_UP0)); const bf16_t* Wdn = (const bf16_t*)(ws + WS_WB + (lyr ? WB_DN1 : WB_DN0));
        const bf16_t* Wout = (const bf16_t*)(ws + WS_WB + (lyr ? WB_OUTO : WB_OUTE));
        bf16_t* ACTF = (bf16_t*)(ws + WS_BIG); bf16_t* HALO = (bf16_t*)(ws + WS_BIG + BIG_HALO);
        int gG = gridDim.x, tailnorm = 0, nlo = 0, nhi = M, then_odd = 0, tailword = 0, ngemm = 1; pg8::Gemm gs{nullptr, nullptr, 0, 0, 0}; bf16_t* EsO = nullptr; const bool split = (gridDim.x == 256); bf16_t* Y2 = (bf16_t*)(ws + WS_Y2);
        if (ph == 0) kind = 0;
        else if (q == 1) { kind = 1; g = pg8::Gemm{A1, (const bf16_t*)(ws + WS_WB + (lyr ? WB_INO : WB_INE)), M, (lyr && split) ? 1792 : PW, D}; E.O = BIG; E.ldc = PW;
            if (lyr && split) {
                ngemm = 2; gs = pg8::Gemm{A1 + (size_t)MHEAD * D, (const bf16_t*)(ws + WS_WB + WB_INO) + (size_t)1792 * D, M - MHEAD, 2304, D}; EsO = BIG + (size_t)MHEAD * PW + 1792; } }
        else if (q == 2) { if (!lyr) kind = 2; else { kind = 1; then_odd = 1; gG = split ? 128 : 0; g = pg8::Gemm{A1, (const bf16_t*)(ws + WS_WB + WB_INO) + (size_t)1792 * D, MHEAD, 2304, D}; E.O = BIG + 1792; E.ldc = PW; } }
        else if (q == 3) { kind = 1; g = pg8::Gemm{lyr ? Y2 : A1, Wout, MHEAD, D, D}; E.O = BIG; E.ldc = D; }
        else if (q == 4) { kind = 1; gG = 8; tailnorm = 1; tailword = 3616 + lyr * 16; g = pg8::Gemm{(lyr ? Y2 : A1) + (size_t)MHEAD * D, Wout, M - MHEAD, D, D}; E.O = BIG + (size_t)MHEAD * D; E.ldc = D;
            nmode = 1; nsrc = BIG; gA = NG + (lyr * 4 + 1) * D; gB = NG + (lyr * 4 + 2) * D; }
        else if (q == 5) {
            kind = 1; g = pg8::Gemm{A1, Wup, M, DFF2, D}; E.O = ACTF; E.ldc = DFF; E.mode = 1; E.cw = p.in[25] + (size_t)lyr * 3 * DFF2; E.cb = p.in[26] + (size_t)lyr * DFF2; E.halo = HALO; }
        else if (q == 6) { kind = 5; layer = lyr; }
        else if (q == 7) { kind = 1; g = pg8::Gemm{ACTF, Wdn, MHEAD, D, DFF}; E.O = A1; E.ldc = D; }
        else {
            nsrc = A1; gA = NG + (lyr * 4 + 3) * D; if (lyr) nmode = 2; else { nmode = 1; gB = NG + (1 * 4 + 0) * D; }
            kind = 1; gG = 8; tailnorm = 1; tailword = 3648 + lyr * 16; g = pg8::Gemm{ACTF + (size_t)MHEAD * DFF, Wdn, M - MHEAD, D, DFF}; E.O = A1 + (size_t)MHEAD * D; E.ldc = D; }

#ifndef PROBE_KIND
#define PROBE_KIND -1
#endif
        for (int rep = 0; rep < ((kind == PROBE_KIND) ? 2 : 1); ++rep) {
        if (rep) xcd_barrier(xbar);
        if (kind == 0) {
            float* tile = (float*)lds_raw;
            bf16_t* wb = (bf16_t*)(ws + WS_WB);
            transpose_job(tile, p.in[3], (bf16_t*)((char*)wb + WB_INE), D, 4096, 4096, 0);
            transpose_job(tile, p.in[4], (bf16_t*)((char*)wb + WB_OUTE), D, D, D, 0);
            transpose_job(tile, p.in[7], (bf16_t*)((char*)wb + WB_INO), D, ODD_IN, 4096, 0);
            transpose_job(tile, p.in[8], (bf16_t*)((char*)wb + WB_OUTO), D, D, D, 0);
            transpose_job(tile, p.in[24], (bf16_t*)((char*)wb + WB_UP0), D, DFF2, DFF2, 1);
            transpose_job(tile, p.in[24] + (size_t)D * DFF2, (bf16_t*)((char*)wb + WB_UP1), D, DFF2, DFF2, 1);
            transpose_job(tile, p.in[27], (bf16_t*)((char*)wb + WB_DN0), DFF, D, D, 0);
            transpose_job(tile, p.in[27] + (size_t)DFF * D, (bf16_t*)((char*)wb + WB_DN1), DFF, D, D, 0);
            norm_phase(p, 0, nullptr, nullptr, NG, A1, 0, M, 0, (int)gridDim.x);
        } else if (kind == 1) {
            const int bid_g = obid();
            for (int gi = 0; gi < ngemm; ++gi) {
                const pg8::Gemm gg = gi ? gs : g; pg8::EpiBf16 EE = E; if (gi) EE.O = EsO;
                const int skipg = gi ? 14 : 0;
                if (bid_g >= skipg && bid_g < gG) { pg8::StaticOrder S; S.init(gg.M, gg.N, gG - skipg, bid_g - skipg); pg8::gemm_phase((LAS unsigned char*)lds_raw, gg, S, EE); }
            }
            if (tailnorm) {
                if (bid_g < 8) { sub_barrier((unsigned*)(ws + WS_BAR) + tailword, 8u); norm_phase(p, nmode, nsrc, gA, gB, A1, MHEAD, M, 0, 8); }
                else norm_phase(p, nmode, nsrc, gA, gB, A1, 0, MHEAD, 8, (int)gridDim.x - 8);
            }
            if (then_odd) {
                if (split && bid_g < 128) sub_barrier((unsigned*)(ws + WS_BAR) + 3600, 128u);
                odd_scan_phase(p, (float*)lds_raw);
            }
        } else if (kind == 2) {
            even_scan_phase(p, (float*)lds_raw);
        } else if (kind == 3) {
            odd_scan_phase(p, (float*)lds_raw);
        } else if (kind == 4) {
            norm_phase(p, nmode, nsrc, gA, gB, A1, nlo, nhi, 0, (int)gridDim.x);
        } else {
            ffn_fixup_phase(p, layer);
        }
        }
        if (ph + 1 < p.ph_hi) { if (p.ph_hi > 1000) grid.sync(); else xcd_barrier(xbar); }
    }
}

extern "C" void kernel_launch(void* const* d_in, const int* in_sizes, int n_in, void* d_out, int out_size, void* d_ws, size_t ws_size, hipStream_t stream) {
    static int grid_blocks = 0;
    if (grid_blocks == 0) {
        if (n_in != 28 || ws_size < WS_END) { fprintf(stderr, "kernel_launch: need 28 inputs and %zu bytes of workspace (got %d, %zu)\n", (size_t)WS_END, n_in, ws_size); grid_blocks = -1; return; }
        int dev = 0, cus = 0, per_cu = 0;
        hipGetDevice(&dev);
        hipDeviceGetAttribute(&cus, hipDeviceAttributeMultiprocessorCount, dev);
        if (hipFuncSetAttribute((const void*)hybrid_fwd, hipFuncAttributeMaxDynamicSharedMemorySize, LDS_BYTES) != hipSuccess) { fprintf(stderr, "kernel_launch: hipFuncSetAttribute failed\n"); grid_blocks = -1; return; }
        if (hipOccupancyMaxActiveBlocksPerMultiprocessor(&per_cu, (const void*)hybrid_fwd, 512, LDS_BYTES) != hipSuccess || per_cu < 1) { fprintf(stderr, "kernel_launch: occupancy query says %d\n", per_cu); per_cu = 1; }
        (void)hipGetLastError();
        grid_blocks = cus;
    }
    if (grid_blocks < 0) return;
    if (hipMemsetAsync((char*)d_ws + WS_BAR, 0, 16384, stream) != hipSuccess) { fprintf(stderr, "kernel_launch: hipMemsetAsync of the barrier words failed\n"); return; }
    Params p{};
    for (int i = 0; i < 28; ++i) p.in[i] = (const float*)d_in[i];
    p.out = (float*)d_out; p.ws = (unsigned char*)d_ws;
#if defined(MK_PER_PHASE)
    for (int ph = 0; ph < NPHASE; ++ph) { p.ph_lo = ph; p.ph_hi = ph + 1; hipLaunchKernelGGL(hybrid_fwd, dim3(grid_blocks), dim3(512), LDS_BYTES, stream, p); }
#else
    p.ph_lo = 0; p.ph_hi = NPHASE;
    void* args[] = {&p};
    hipError_t e = hipLaunchCooperativeKernel((const void*)hybrid_fwd, dim3(grid_blocks), dim3(512), args, LDS_BYTES, stream);
    if (e != hipSuccess) fprintf(stderr, "kernel_launch: cooperative launch failed: %s (grid %d)\n", hipGetErrorString(e), grid_blocks);
#endif
}
```

```cpp
#include <hip/hip_runtime.h>
#include <hip/hip_cooperative_groups.h>
#include <cstdio>
namespace cg = cooperative_groups;

#define LAS __attribute__((address_space(3)))
typedef unsigned short bf16_t;
typedef short bf16x8 __attribute__((ext_vector_type(8)));
typedef float f32x4 __attribute__((ext_vector_type(4)));
typedef unsigned u32x4 __attribute__((ext_vector_type(4)));
typedef unsigned u32x2 __attribute__((ext_vector_type(2)));

constexpr int NB = 32, SEQ = 2048, NMETA = 16, L = 2064, D = 1024, M = NB * L;
constexpr int DFF = 2816, DFF2 = 5632;
constexpr int PW = 4096;
constexpr int ODD_IN = 3848;
constexpr int SLAB = 33024;
constexpr int MHEAD = 65536;
constexpr float EPS = 1e-6f;

constexpr size_t WS_H = 0;
constexpr size_t WS_Y2 = WS_H + (size_t)M * D * 2;
constexpr size_t WS_A1 = WS_H + (size_t)M * D * 4;
constexpr size_t WS_BIG = WS_A1 + (size_t)M * D * 2;
constexpr size_t BIG_ZUP = 0, BIG_ACT = (size_t)SLAB * DFF2 * 2;
constexpr size_t BIG_BYTES = BIG_ACT + (size_t)SLAB * DFF * 2;
constexpr size_t WS_WB = WS_BIG + BIG_BYTES;
constexpr size_t WB_INE = 0, WB_OUTE = WB_INE + (size_t)4096 * 1024 * 2, WB_INO = WB_OUTE + (size_t)1024 * 1024 * 2, WB_OUTO = WB_INO + (size_t)4096 * 1024 * 2;
constexpr size_t WB_UP0 = WB_OUTO + (size_t)1024 * 1024 * 2, WB_UP1 = WB_UP0 + (size_t)DFF2 * 1024 * 2, WB_DN0 = WB_UP1 + (size_t)DFF2 * 1024 * 2, WB_DN1 = WB_DN0 + (size_t)1024 * DFF * 2;
constexpr size_t WS_BAR = WS_WB + WB_DN1 + (size_t)1024 * DFF * 2;
constexpr size_t WS_END = WS_BAR + 16384;
static_assert(BIG_BYTES >= (size_t)M * PW * 2, "BIG holds the projection");

constexpr int LDS_BYTES = 131072 + 4096;

struct Params { const float* in[28]; float* out; unsigned char* ws; int ph_lo, ph_hi; };

__device__ __forceinline__ float bf2f(bf16_t v) { return __uint_as_float(((unsigned)v) << 16); }
typedef __bf16 bf16x2_t __attribute__((ext_vector_type(2)));
typedef float f32x2_t __attribute__((ext_vector_type(2)));
__device__ __forceinline__ unsigned cvt_pk_bf16(float lo, float hi) { const f32x2_t f = {lo, hi}; const bf16x2_t v = __builtin_convertvector(f, bf16x2_t); return __builtin_bit_cast(unsigned, v); }
__device__ __forceinline__ bf16_t f2bf(float f) { return (bf16_t)(cvt_pk_bf16(f, 0.f) & 0xffffu); }
__device__ __forceinline__ float sigmoidf_(float x) { return __builtin_amdgcn_rcpf(1.0f + __expf(-x)); }
__device__ __forceinline__ float siluf_(float x) { return x * sigmoidf_(x); }
__device__ __forceinline__ float softplusf_(float x) { return fmaxf(x, 0.f) + __logf(1.0f + __expf(-fabsf(x))); }
__device__ __forceinline__ int otid() { int t = threadIdx.x; asm volatile("" : "+v"(t)); return t; }
__device__ __forceinline__ int obid() { int b = blockIdx.x; asm volatile("" : "+s"(b)); return b; }
template <int CTRL> __device__ __forceinline__ float dppf(float x) { return __int_as_float(__builtin_amdgcn_update_dpp(0, __float_as_int(x), CTRL, 0xF, 0xF, true)); }
__device__ __forceinline__ float allreduce8(float x) { x += dppf<0xB1>(x); x += dppf<0x4E>(x); x += dppf<0x141>(x); return x; }
__device__ __forceinline__ float allreduce16(float x) { x = allreduce8(x); x += dppf<0x140>(x); return x; }
__device__ __forceinline__ float wave_sum(float x) {
    x = allreduce16(x);
    const int xi = __float_as_int(x);
    const float r0 = __int_as_float(__builtin_amdgcn_readlane(xi, 0)), r1 = __int_as_float(__builtin_amdgcn_readlane(xi, 16));
    const float r2 = __int_as_float(__builtin_amdgcn_readlane(xi, 32)), r3 = __int_as_float(__builtin_amdgcn_readlane(xi, 48));
    return (r0 + r1) + (r2 + r3);
}

namespace pg8 {
constexpr int BM = 256, BK = 64, HALF = 128, HTB = HALF * BK * 2, STAGE_BYTES = 8 * HTB, NXCD = 8, WGM = 8;
__host__ __device__ __forceinline__ int lds_byte(int r, int c) { const int st = (r >> 4) * 2 + (c >> 5), rr = r & 15, cc = c & 31, ob = rr * 64 + cc * 2; return st * 1024 + (ob ^ (((ob >> 9) & 1) << 5)); }
__host__ __device__ __forceinline__ void stage_rc(int b, int& R, int& C) { const int st = b / 1024, sb = b % 1024, swz = sb ^ (((sb >> 9) & 1) << 5); R = (st >> 1) * 16 + swz / 64; C = (st & 1) * 32 + (swz % 64) / 2; }
__host__ __device__ __forceinline__ int perm32(int rho) { const int n = rho >> 4, i = rho & 15; return 8 * (i >> 2) + 4 * n + (i & 3); }
struct Unit { int pm, pn; };
struct Gemm { const bf16_t* A; const bf16_t* Bt; int M, N, K; };
struct StaticOrder {
    int nM, nN, nwg, G, c;
    __device__ void init(int M_, int N_, int G_, int c_) { nM = M_ / BM; nN = N_ / BM; nwg = nM * nN; G = G_; c = c_; }
    __device__ bool next(int i, Unit& u) const {
        const long Lx = (long)i * G + c; if (Lx >= nwg) return false;
        int wgid = (int)Lx; { const int q = nwg / NXCD, r = nwg % NXCD, xcd = wgid % NXCD, off = wgid / NXCD; wgid = (xcd < r ? xcd * (q + 1) : r * (q + 1) + (xcd - r) * q) + off; }
        const int nig = WGM * nN, gid = wgid / nig, fm = gid * WGM, gsz = (nM - fm) < WGM ? (nM - fm) : WGM;
        u.pm = fm + ((wgid % nig) % gsz); u.pn = (wgid % nig) / gsz; return true;
    }
};
struct EpiBf16 {
    bf16_t* O; int ldc; int mode; const float* cw; const float* cb; bf16_t* halo; LAS float* wlds;
    __device__ __forceinline__ void operator()(const f32x4 (&acc)[2][2][4][2], const Unit& u, int wr, int wc, int fr, int fq) const {
        if (mode == 0) {
            const int row0 = u.pm * BM + wr * 64 + fr; const int col0 = u.pn * BM + wc * 32 + 8 * fq;
#pragma unroll
            for (int ai = 0; ai < 2; ++ai)
#pragma unroll
                for (int m = 0; m < 4; ++m) { bf16_t* rowp = O + (size_t)(row0 + ai * HALF + m * 16) * ldc + col0;
#pragma unroll
                    for (int bj = 0; bj < 2; ++bj) { const f32x4 v0 = acc[ai][bj][m][0], v1 = acc[ai][bj][m][1];
                        u32x4 w; w.x = cvt_pk_bf16(v0[0], v0[1]); w.y = cvt_pk_bf16(v0[2], v0[3]); w.z = cvt_pk_bf16(v1[0], v1[1]); w.w = cvt_pk_bf16(v1[2], v1[3]);
                        *(u32x4*)(rowp + bj * HALF) = w; } }
            return;
        }
        const int ch0 = u.pn * 128 + wc * 32 + 8 * fq;
        const bool l15 = (fr == 15), l14 = (fr >= 14);
        LAS float* wsc = wlds + ((wr * 4 + wc) * 4 + fq) * 32;
        {
            f32x4 t[8];
#pragma unroll
            for (int j = 0; j < 3; ++j) { t[j] = *(const f32x4*)(cw + j * DFF2 + ch0 + 4); t[3 + j] = *(const f32x4*)(cw + j * DFF2 + DFF + ch0 + 4); }
            t[6] = *(const f32x4*)(cb + ch0 + 4); t[7] = *(const f32x4*)(cb + DFF + ch0 + 4);
#pragma unroll
            for (int j = 0; j < 8; ++j) *(LAS f32x4*)(wsc + 4 * j) = t[j];
        }
#pragma unroll
        for (int n = 0; n < 2; ++n) {
            float wg[3][4], wv[3][4], bg[4], bv[4];
            if (n == 0) {
#pragma unroll
                for (int j = 0; j < 3; ++j) {
                    const float4 a = *(const float4*)(cw + j * DFF2 + ch0), c = *(const float4*)(cw + j * DFF2 + DFF + ch0);
                    wg[j][0] = a.x; wg[j][1] = a.y; wg[j][2] = a.z; wg[j][3] = a.w; wv[j][0] = c.x; wv[j][1] = c.y; wv[j][2] = c.z; wv[j][3] = c.w;
                }
                const float4 a = *(const float4*)(cb + ch0), c = *(const float4*)(cb + DFF + ch0);
                bg[0] = a.x; bg[1] = a.y; bg[2] = a.z; bg[3] = a.w; bv[0] = c.x; bv[1] = c.y; bv[2] = c.z; bv[3] = c.w;
            } else {
#pragma unroll
                for (int j = 0; j < 3; ++j) {
                    const f32x4 a = *(const LAS f32x4*)(wsc + 4 * j), c = *(const LAS f32x4*)(wsc + 4 * (3 + j));
                    wg[j][0] = a[0]; wg[j][1] = a[1]; wg[j][2] = a[2]; wg[j][3] = a[3]; wv[j][0] = c[0]; wv[j][1] = c[1]; wv[j][2] = c[2]; wv[j][3] = c[3];
                }
                const f32x4 a = *(const LAS f32x4*)(wsc + 24), c = *(const LAS f32x4*)(wsc + 28);
                bg[0] = a[0]; bg[1] = a[1]; bg[2] = a[2]; bg[3] = a[3]; bv[0] = c[0]; bv[1] = c[1]; bv[2] = c[2]; bv[3] = c[3];
            }
#pragma unroll
            for (int ai = 0; ai < 2; ++ai)
#pragma unroll
                for (int m = 0; m < 4; ++m) {
                    const int r = u.pm * BM + ai * HALF + wr * 64 + m * 16 + fr; const int tb = r % L;
                    const bool k1 = (tb >= 1), k2 = (tb >= 2);
                    float o[4];
#pragma unroll
                    for (int e = 0; e < 4; ++e) {
                        const float g0 = acc[ai][0][m][n][e], v0 = acc[ai][1][m][n][e];
                        const float gm = (m > 0) ? acc[ai][0][m > 0 ? m - 1 : 0][n][e] : 0.f, vm = (m > 0) ? acc[ai][1][m > 0 ? m - 1 : 0][n][e] : 0.f;
                        float g1 = dppf<0x121>(l15 ? gm : g0), g2 = dppf<0x122>(l14 ? gm : g0), v1 = dppf<0x121>(l15 ? vm : v0), v2 = dppf<0x122>(l14 ? vm : v0);
                        g1 = k1 ? g1 : 0.f; v1 = k1 ? v1 : 0.f; g2 = k2 ? g2 : 0.f; v2 = k2 ? v2 : 0.f;
                        const float zg = fmaf(wg[0][e], g2, fmaf(wg[1][e], g1, fmaf(wg[2][e], g0, bg[e])));
                        const float zv = fmaf(wv[0][e], v2, fmaf(wv[1][e], v1, fmaf(wv[2][e], v0, bv[e])));
                        o[e] = siluf_(zg) * zv;
                    }
                    if (!(m == 0 && fr < 2)) {
                        u32x2 w; w.x = cvt_pk_bf16(o[0], o[1]); w.y = cvt_pk_bf16(o[2], o[3]);
                        *(u32x2*)(O + (size_t)r * ldc + ch0 + 4 * n) = w;
                    }
                }
        }
#pragma unroll
        for (int ai = 0; ai < 2; ++ai)
#pragma unroll
            for (int m = 0; m < 4; m += 3) {
                if ((m == 3 && fr >= 14) || (m == 0 && fr < 2)) {
                    const int r = u.pm * BM + ai * HALF + wr * 64 + m * 16 + fr;
                    const int slot = (m == 3) ? (fr - 14) : (2 + fr);
                    bf16_t* hp = halo + ((size_t)(r >> 6) * 4 + slot) * DFF2 + u.pn * 256 + wc * 32 + 8 * fq;
#pragma unroll
                    for (int bj = 0; bj < 2; ++bj) { const f32x4 a0 = acc[ai][bj][m][0], a1 = acc[ai][bj][m][1];
                        u32x4 w; w.x = cvt_pk_bf16(a0[0], a0[1]); w.y = cvt_pk_bf16(a0[2], a0[3]); w.z = cvt_pk_bf16(a1[0], a1[1]); w.w = cvt_pk_bf16(a1[2], a1[3]);
                        *(u32x4*)(hp + bj * 128) = w; }
                }
            }
    }
};

__device__ __forceinline__ void gemm_phase(LAS unsigned char* lds, const Gemm g, const StaticOrder& S, const EpiBf16& E) {
    const int tid = otid(), wid = __builtin_amdgcn_readfirstlane(tid >> 6), lane = tid & 63, wr = wid >> 2, wc = wid & 3, fr = lane & 15, fq = lane >> 4;
    const int K = g.K, nt = K / BK;
    unsigned voffA[2], voffB[2];
#pragma unroll
    for (int i = 0; i < 2; ++i) { int R, C; stage_rc(tid * 16 + i * 8192, R, C); const int Rb = (R & ~31) + perm32(R & 31);
        voffA[i] = (unsigned)(R * K + C) * 2u; voffB[i] = (unsigned)(Rb * K + C) * 2u; }
    const size_t kstep = (size_t)(BK * 2);
    const size_t hstep = (size_t)HALF * K * 2;
    const size_t tstep = 2 * hstep;
    const unsigned ldsw = (unsigned)wid * 1024u;
    const int aoff = lds_byte(wr * 64 + fr, fq * 8), boff = lds_byte(wc * 32 + fr, fq * 8);
#define PG8_SA(b, h) (((b) * 2 + (h)) * HTB)
#define PG8_SB(b, h) ((4 + (b) * 2 + (h)) * HTB)
#define PG8_STAGE(bufoff, gbase, voff) do { _Pragma("unroll") for (int _i = 0; _i < 2; ++_i) \
        __builtin_amdgcn_global_load_lds((const unsigned*)((const char*)(gbase) + (voff)[_i]), (LAS unsigned*)(lds + (bufoff) + ldsw + _i * 8192), 16, 0, 0); } while (0)
#define PG8_LDA(dst, b, h) do { _Pragma("unroll") for (int m = 0; m < 4; ++m) _Pragma("unroll") for (int k = 0; k < 2; ++k) dst[m][k] = *(const LAS bf16x8*)(lds + PG8_SA(b, h) + aoff + m * 2048 + k * 1024); } while (0)
#define PG8_LDB(dst, b, h) do { _Pragma("unroll") for (int n = 0; n < 2; ++n) _Pragma("unroll") for (int k = 0; k < 2; ++k) dst[n][k] = *(const LAS bf16x8*)(lds + PG8_SB(b, h) + boff + n * 2048 + k * 1024); } while (0)
#define PG8_MMA(ai, bj, At, Bt) do { __builtin_amdgcn_s_setprio(1); _Pragma("unroll") for (int m = 0; m < 4; ++m) _Pragma("unroll") for (int n = 0; n < 2; ++n) _Pragma("unroll") for (int k = 0; k < 2; ++k) \
        acc[ai][bj][m][n] = __builtin_amdgcn_mfma_f32_16x16x32_bf16(Bt[n][k], At[m][k], acc[ai][bj][m][n], 0, 0, 0); __builtin_amdgcn_s_setprio(0); } while (0)
#define PG8_WAIT_V(n) asm volatile("s_waitcnt vmcnt(" #n ")" ::: "memory")
#define PG8_WAIT_L(n) asm volatile("s_waitcnt lgkmcnt(" #n ")" ::: "memory")
#define PG8_BAR __builtin_amdgcn_s_barrier()
#define PG8_SCHED __builtin_amdgcn_sched_barrier(0)
    Unit cur, nxt; int ui = 0;
    if (!S.next(0, cur)) return;
    f32x4 acc[2][2][4][2];
#pragma unroll
    for (int a = 0; a < 2; ++a)
#pragma unroll
        for (int b = 0; b < 2; ++b)
#pragma unroll
            for (int m = 0; m < 4; ++m)
#pragma unroll
                for (int n = 0; n < 2; ++n) acc[a][b][m][n] = (f32x4){0.f, 0.f, 0.f, 0.f};
    bf16x8 At[4][2], B0[2][2], B1[2][2];
    const char* cA = (const char*)g.A + (size_t)cur.pm * tstep; const char* cB = (const char*)g.Bt + (size_t)cur.pn * tstep;
    PG8_STAGE(PG8_SB(0, 0), cB, voffB); PG8_STAGE(PG8_SA(0, 0), cA, voffA); PG8_STAGE(PG8_SB(0, 1), cB + hstep, voffB); PG8_STAGE(PG8_SA(0, 1), cA + hstep, voffA);
    if (wr == 1) PG8_BAR;
    PG8_WAIT_V(4); PG8_BAR;
    PG8_STAGE(PG8_SB(1, 0), cB + kstep, voffB); PG8_STAGE(PG8_SA(1, 0), cA + kstep, voffA); PG8_STAGE(PG8_SB(1, 1), cB + hstep + kstep, voffB);
    PG8_WAIT_V(6); PG8_BAR;
    for (;;) {
        const bool has_next = S.next(ui + 1, nxt);
        const char* nA = has_next ? (const char*)g.A + (size_t)nxt.pm * tstep : cA; const char* nB = has_next ? (const char*)g.Bt + (size_t)nxt.pn * tstep : cB;
        for (int t = 0; t < nt; t += 2) {
            const bool last = (t == nt - 2);
            const char* a1 = cA + (size_t)(t + 1) * kstep;
            const char* a2 = last ? nA : cA + (size_t)(t + 2) * kstep; const char* b2 = last ? nB : cB + (size_t)(t + 2) * kstep;
            const char* a3 = a2 + kstep; const char* b3 = b2 + kstep;
            PG8_LDB(B0, 0, 0); PG8_SCHED; PG8_LDA(At, 0, 0); PG8_STAGE(PG8_SA(1, 1), a1 + hstep, voffA);
            PG8_WAIT_L(8); PG8_BAR; PG8_WAIT_L(0); PG8_MMA(0, 0, At, B0); PG8_BAR; PG8_SCHED;
            PG8_LDB(B1, 0, 1); PG8_STAGE(PG8_SB(0, 0), b2, voffB);
            PG8_BAR; PG8_WAIT_L(0); PG8_MMA(0, 1, At, B1); PG8_BAR;
            PG8_LDA(At, 0, 1); PG8_STAGE(PG8_SA(0, 0), a2, voffA);
            PG8_BAR; PG8_WAIT_L(0); PG8_MMA(1, 0, At, B0); PG8_BAR; PG8_SCHED;
            PG8_STAGE(PG8_SB(0, 1), b2 + hstep, voffB);
            PG8_WAIT_V(6); PG8_BAR; PG8_MMA(1, 1, At, B1); PG8_BAR;
            PG8_LDB(B0, 1, 0); PG8_SCHED; PG8_LDA(At, 1, 0); PG8_STAGE(PG8_SA(0, 1), a2 + hstep, voffA);
            PG8_WAIT_L(8); PG8_BAR; PG8_WAIT_L(0); PG8_MMA(0, 0, At, B0); PG8_BAR; PG8_SCHED;
            PG8_LDB(B1, 1, 1); PG8_STAGE(PG8_SB(1, 0), b3, voffB);
            PG8_BAR; PG8_WAIT_L(0); PG8_MMA(0, 1, At, B1); PG8_BAR;
            PG8_LDA(At, 1, 1); PG8_STAGE(PG8_SA(1, 0), a3, voffA);
            PG8_BAR; PG8_WAIT_L(0); PG8_MMA(1, 0, At, B0); PG8_BAR; PG8_SCHED;
            PG8_STAGE(PG8_SB(1, 1), b3 + hstep, voffB);
            PG8_WAIT_V(6); PG8_BAR; PG8_MMA(1, 1, At, B1); PG8_BAR;
        }
        E(acc, cur, wr, wc, fr, fq);
        if (!has_next) break;
#pragma unroll
        for (int a = 0; a < 2; ++a)
#pragma unroll
            for (int b = 0; b < 2; ++b)
#pragma unroll
                for (int m = 0; m < 4; ++m)
#pragma unroll
                    for (int n = 0; n < 2; ++n) acc[a][b][m][n] = (f32x4){0.f, 0.f, 0.f, 0.f};
        cur = nxt; cA = nA; cB = nB; ++ui;
    }
    PG8_WAIT_V(0);
    if (wr == 0) PG8_BAR;
    PG8_BAR;
#undef PG8_SA
#undef PG8_SB
#undef PG8_STAGE
#undef PG8_LDA
#undef PG8_LDB
#undef PG8_MMA
#undef PG8_WAIT_V
#undef PG8_WAIT_L
#undef PG8_BAR
#undef PG8_SCHED
}
}

__device__ __noinline__ void transpose_job(float* tile  , const float* __restrict__ src, bf16_t* __restrict__ dst, int K, int N, int Npad, int glu) {
    const int tid = otid();
    const int tk = K / 64, tn = Npad / 64, ntiles = tk * tn;
    const int kkA = tid >> 4, n4 = (tid & 15) * 4;
    float4 v[2];
    auto fetch = [&](int tl) {
        const int k0 = (tl % tk) * 64, n0 = (tl / tk) * 64;
#pragma unroll
        for (int it = 0; it < 2; ++it) { v[it] = make_float4(0.f, 0.f, 0.f, 0.f); if (n0 + n4 < N) v[it] = *(const float4*)(src + (size_t)(k0 + kkA + it * 32) * N + n0 + n4); }
    };
    int tl = obid();
    if (tl < ntiles) fetch(tl);
    while (tl < ntiles) {
        const int k0 = (tl % tk) * 64, n0 = (tl / tk) * 64;
        __syncthreads();
#pragma unroll
        for (int it = 0; it < 2; ++it) { float* tp = tile + (kkA + it * 32) * 65 + n4; tp[0] = v[it].x; tp[1] = v[it].y; tp[2] = v[it].z; tp[3] = v[it].w; }
        const int nxt = tl + (int)gridDim.x;
        if (nxt < ntiles) fetch(nxt);
        __syncthreads();
        const int nn = tid >> 3, k8 = (tid & 7) * 8;
        float e[8];
#pragma unroll
        for (int j = 0; j < 8; ++j) e[j] = tile[(k8 + j) * 65 + nn];
        u32x4 w; w.x = cvt_pk_bf16(e[0], e[1]); w.y = cvt_pk_bf16(e[2], e[3]); w.z = cvt_pk_bf16(e[4], e[5]); w.w = cvt_pk_bf16(e[6], e[7]);
        const int r0 = !glu ? n0 : (n0 < DFF ? (n0 >> 7) * 256 + (n0 & 127) : ((n0 - DFF) >> 7) * 256 + 128 + ((n0 - DFF) & 127));
        *(u32x4*)(dst + (size_t)(r0 + nn) * K + k0 + k8) = w;
        tl = nxt;
    }
}

__device__ void norm_phase(const Params& p, int mode, const bf16_t* msrc, const float* __restrict__ gA, const float* __restrict__ gB, bf16_t* udst, int row_lo, int row_hi, int blk_first, int blk_cnt) {
    bf16_t* H = (bf16_t*)(p.ws + WS_H);
    const int tid_ = otid(); const int lane = tid_ & 63, w = tid_ >> 6;
    const int nw = blk_cnt * 8; const int bid_ = obid() - blk_first;
    if (bid_ < 0 || bid_ >= blk_cnt) return;
    float4 ga[4], gb[4];
#pragma unroll
    for (int i = 0; i < 4; ++i) { ga[i] = (mode != 0) ? *(const float4*)(gA + i * 256 + lane * 4) : make_float4(0.f, 0.f, 0.f, 0.f); gb[i] = (mode != 2) ? *(const float4*)(gB + i * 256 + lane * 4) : make_float4(0.f, 0.f, 0.f, 0.f); }
    float4 xr[4]; u32x2 hr[4], mr[4];
    auto fetch = [&](int row) {
        if (mode == 0) {
            const int b = row / L, t = row - b * L;
            const float* src = (t < NMETA) ? (p.in[1] + (size_t)t * D) : (p.in[0] + ((size_t)b * SEQ + (t - NMETA)) * D);
#pragma unroll
            for (int i = 0; i < 4; ++i) xr[i] = *(const float4*)(src + i * 256 + lane * 4);
        } else {
#pragma unroll
            for (int i = 0; i < 4; ++i) { hr[i] = *(const u32x2*)(H + (size_t)row * D + i * 256 + lane * 4); mr[i] = *(const u32x2*)(msrc + (size_t)row * D + i * 256 + lane * 4); }
        }
    };
    int row = row_lo + bid_ * 8 + w;
    if (row < row_hi) fetch(row);
    while (row < row_hi) {
        const int b = row / L, t = row - b * L;
        float4 hv[4];
        float mv[4][4]; float ssm = 0.f;
        if (mode == 0) {
#pragma unroll
            for (int i = 0; i < 4; ++i) hv[i] = xr[i];
        } else {
#pragma unroll
            for (int i = 0; i < 4; ++i) {
                hv[i] = make_float4(__uint_as_float(hr[i].x << 16), __uint_as_float(hr[i].x & 0xffff0000u), __uint_as_float(hr[i].y << 16), __uint_as_float(hr[i].y & 0xffff0000u));
                mv[i][0] = __uint_as_float(mr[i].x << 16); mv[i][1] = __uint_as_float(mr[i].x & 0xffff0000u); mv[i][2] = __uint_as_float(mr[i].y << 16); mv[i][3] = __uint_as_float(mr[i].y & 0xffff0000u);
                ssm += mv[i][0] * mv[i][0] + mv[i][1] * mv[i][1] + mv[i][2] * mv[i][2] + mv[i][3] * mv[i][3];
            }
        }
        const int nxt = row + nw;
        if (nxt < row_hi) fetch(nxt);
        if (mode != 0) {
            ssm = wave_sum(ssm);
            const float rs = rsqrtf(ssm * (1.0f / D) + EPS);
#pragma unroll
            for (int i = 0; i < 4; ++i) { hv[i].x += mv[i][0] * rs * ga[i].x; hv[i].y += mv[i][1] * rs * ga[i].y; hv[i].z += mv[i][2] * rs * ga[i].z; hv[i].w += mv[i][3] * rs * ga[i].w; }
        }
        if (mode == 2) {
            if (t >= NMETA) {
                float* o = p.out + ((size_t)b * SEQ + (t - NMETA)) * D;
#pragma unroll
                for (int i = 0; i < 4; ++i) *(float4*)(o + i * 256 + lane * 4) = hv[i];
            }
        } else {
            float ss = 0.f;
#pragma unroll
            for (int i = 0; i < 4; ++i) {
                { u32x2 hw; hw.x = cvt_pk_bf16(hv[i].x, hv[i].y); hw.y = cvt_pk_bf16(hv[i].z, hv[i].w); *(u32x2*)(H + (size_t)row * D + i * 256 + lane * 4) = hw; }
                ss += hv[i].x * hv[i].x + hv[i].y * hv[i].y + hv[i].z * hv[i].z + hv[i].w * hv[i].w;
            }
            ss = wave_sum(ss);
            const float rs = rsqrtf(ss * (1.0f / D) + EPS);
#pragma unroll
            for (int i = 0; i < 4; ++i) {
                u32x2 o; o.x = cvt_pk_bf16(hv[i].x * rs * gb[i].x, hv[i].y * rs * gb[i].y); o.y = cvt_pk_bf16(hv[i].z * rs * gb[i].z, hv[i].w * rs * gb[i].w);
                *(u32x2*)(udst + (size_t)row * D + i * 256 + lane * 4) = o;
            }
        }
        row = nxt;
    }
}

constexpr size_t BIG_HALO = (size_t)M * DFF * 2;
static_assert(BIG_HALO + (size_t)(M / 64) * 4 * DFF2 * 2 <= BIG_BYTES, "activation + halo fit");
__device__ void ffn_fixup_phase(const Params& p, int layer) {
    bf16_t* act = (bf16_t*)(p.ws + WS_BIG);
    const bf16_t* halo = (const bf16_t*)(p.ws + WS_BIG + BIG_HALO);
    const float* cw = p.in[25] + (size_t)layer * 3 * DFF2;
    const float* cb = p.in[26] + (size_t)layer * DFF2;
    constexpr int NCG = DFF / 8, NBLK = M / 64;
    const int nitems = NCG * NBLK;
    for (int item = obid() * 512 + otid(); item < nitems; item += gridDim.x * 512) {
        const int cgp = item % NCG, blk = item / NCG;
        const int c0 = cgp * 8;
        const int gcol = (c0 >> 7) * 256 + (c0 & 127);
        float wg[3][8], wv[3][8], bg[8], bv[8];
#pragma unroll
        for (int j = 0; j < 3; ++j)
#pragma unroll
            for (int e = 0; e < 8; ++e) { wg[j][e] = cw[j * DFF2 + c0 + e]; wv[j][e] = cw[j * DFF2 + DFF + c0 + e]; }
#pragma unroll
        for (int e = 0; e < 8; ++e) { bg[e] = cb[c0 + e]; bv[e] = cb[DFF + c0 + e]; }
        auto ldrow = [&](int bk, int slot, float (&g)[8], float (&v)[8]) {
            const bf16_t* hp = halo + ((size_t)bk * 4 + slot) * DFF2 + gcol;
            const u32x4 a = *(const u32x4*)hp, c = *(const u32x4*)(hp + 128);
#pragma unroll
            for (int e = 0; e < 4; ++e) { g[2 * e] = __uint_as_float(a[e] << 16); g[2 * e + 1] = __uint_as_float(a[e] & 0xffff0000u); v[2 * e] = __uint_as_float(c[e] << 16); v[2 * e + 1] = __uint_as_float(c[e] & 0xffff0000u); }
        };
        float gz[4][8], vz[4][8];
#pragma unroll
        for (int e = 0; e < 8; ++e) { gz[0][e] = 0.f; gz[1][e] = 0.f; vz[0][e] = 0.f; vz[1][e] = 0.f; }
        if (blk > 0) { ldrow(blk - 1, 0, gz[0], vz[0]); ldrow(blk - 1, 1, gz[1], vz[1]); }
        ldrow(blk, 2, gz[2], vz[2]); ldrow(blk, 3, gz[3], vz[3]);
#pragma unroll
        for (int q = 0; q < 2; ++q) {
            const int r = blk * 64 + q; const int tb = r % L;
            const float k1 = (tb >= 1) ? 1.f : 0.f, k2 = (tb >= 2) ? 1.f : 0.f;
            float o[8];
#pragma unroll
            for (int e = 0; e < 8; ++e) {
                const float zg = wg[0][e] * (k2 * gz[q][e]) + wg[1][e] * (k1 * gz[q + 1][e]) + wg[2][e] * gz[q + 2][e] + bg[e];
                const float zv = wv[0][e] * (k2 * vz[q][e]) + wv[1][e] * (k1 * vz[q + 1][e]) + wv[2][e] * vz[q + 2][e] + bv[e];
                o[e] = siluf_(zg) * zv;
            }
            u32x4 w; w.x = cvt_pk_bf16(o[0], o[1]); w.y = cvt_pk_bf16(o[2], o[3]); w.z = cvt_pk_bf16(o[4], o[5]); w.w = cvt_pk_bf16(o[6], o[7]);
            *(u32x4*)(act + (size_t)r * DFF + c0) = w;
        }
    }
}

constexpr int TCH = 32;
template <int PPR, int NROW, int NLD, int NT = 512, class ColFn>
__device__ __forceinline__ void raw_fetch(u32x4 (&reg)[NLD], const bf16_t* P, int tid, size_t brow, int tfirst, ColFn col) {
#pragma unroll
    for (int i = 0; i < NLD; ++i) {
        int idx = tid + i * NT;
        asm volatile("" : "+v"(idx));
        u32x4 v = {0u, 0u, 0u, 0u};
        if (idx < NROW * PPR) { const int r = idx / PPR, pc = idx - r * PPR; const int t = tfirst + r;
            if (t >= 0 && t < L) v = *(const u32x4*)(P + (brow + t) * PW + col(pc)); }
        reg[i] = v;
    }
}
template <int PPR, int NROW, int NLD, int NT = 512>
__device__ __forceinline__ void raw_store(const u32x4 (&reg)[NLD], bf16_t* raw, int tid) {
#pragma unroll
    for (int i = 0; i < NLD; ++i) { const int idx = tid + i * NT; if (idx < NROW * PPR) *(u32x4*)(raw + (size_t)idx * 8) = reg[i]; }
}

template <bool HG>
__device__ __forceinline__ void even_item(const Params& p, float* lds, int b, int h) {
    const bf16_t* P = (const bf16_t*)(p.ws + WS_BIG);
    bf16_t* Y = (bf16_t*)(p.ws + WS_A1);
    constexpr int QP = 136;
    float* O = lds; float* Gt = O + TCH * 128; float* PC = Gt + TCH * 128;
    bf16_t* Qt = (bf16_t*)(PC + 256); bf16_t* Kt = Qt + TCH * QP;
    bf16_t* KhT = Kt + TCH * QP; bf16_t* VT = KhT + 2 * 128 * 16;
    bf16_t* raw = VT + 2 * 128 * 16;
    constexpr int PPR = 64, NROW = 32, NLD = 4, RP = 512;
    const int tid = otid(), lane = tid & 63, w = tid >> 6;
    const int fn = lane & 15, g = lane >> 4, vs = w * 16;
    const int cbase = (HG ? 2048 : 0) + h * 128;
    auto col = [&](int pc) { return cbase + (pc >> 4) * 512 + (pc & 15) * 8; };
    const size_t brow = (size_t)b * L;
    const float gamma = 1.0f - exp2f(-5.0f - (float)h);
    const int d_ = tid & 127, c2_ = (tid >> 7) & 1, hf_ = tid >> 8;
    float lbv = 0.f; float2 hgn = make_float2(0.f, 0.f);
    if (HG) {
        const float* lg = p.in[5]; const int c = h * 128 + d_;
        const float l0 = lg[c], l1 = lg[512 + c], l2 = lg[1024 + c]; const float mx = fmaxf(l0, fmaxf(l1, l2));
        const float e0 = __expf(l0 - mx), e1 = __expf(l1 - mx), e2 = __expf(l2 - mx); lbv = e0 / (e0 + e1 + e2);
        hgn = *(const float2*)(p.in[6] + h * 128 + 2 * lane);
    }
    const float rinv = exp2f(-(float)(d_ & 63) * 0.20762050593046f) * 0.15915494309189535f;
    f32x4 S[8];
#pragma unroll
    for (int T = 0; T < 8; ++T) S[T] = (f32x4){0.f, 0.f, 0.f, 0.f};
    u32x4 rg[NLD];
    __syncthreads();
    raw_fetch<PPR, NROW, NLD>(rg, P, tid, brow, 0, col); raw_store<PPR, NROW, NLD>(rg, raw, tid);
    for (int t0 = 0; t0 < L; t0 += TCH) {
        const int ns = (L - t0) < TCH ? (L - t0) : TCH;
        const bool more = (t0 + TCH < L);
        __syncthreads();
        if (more) raw_fetch<PPR, NROW, NLD>(rg, P, tid, brow, t0 + TCH, col);
        if (hf_ == 0) {
            float Pc = 1.0f; float kt[16];
#pragma unroll
            for (int i = 0; i < 16; ++i) {
                const int t = c2_ * 16 + i; const bf16_t* rr = raw + t * RP;
                float q, k, f;
                if (!HG) {
                    const int dd = d_ & 63;
                    float r = (float)(t0 + t) * rinv; r -= floorf(r);
                    const float sn = __builtin_amdgcn_sinf(r), cs = __builtin_amdgcn_cosf(r);
                    const float q1 = bf2f(rr[dd]), q2 = bf2f(rr[64 + dd]), k1 = bf2f(rr[128 + dd]), k2 = bf2f(rr[192 + dd]);
                    q = (d_ < 64) ? (q1 * cs - q2 * sn) : (q1 * sn + q2 * cs);
                    k = ((d_ < 64) ? (k1 * cs - k2 * sn) : (k1 * sn + k2 * cs)) * 0.08838834764831845f;
                    f = gamma;
                } else {
                    q = bf2f(rr[d_]); const float sg = sigmoidf_(bf2f(rr[128 + d_]));
                    f = lbv + (1.0f - lbv) * sg; k = (1.0f - lbv) * (1.0f - sg);
                }
                Pc *= f;
                Qt[t * QP + d_] = f2bf(q * Pc);
                kt[i] = k * __builtin_amdgcn_rcpf(Pc);
                Kt[t * QP + d_] = f2bf(kt[i]);
            }
            PC[c2_ * 128 + d_] = Pc;
            u32x4 u0, u1;
            u0.x = cvt_pk_bf16(kt[0] * Pc, kt[1] * Pc); u0.y = cvt_pk_bf16(kt[2] * Pc, kt[3] * Pc); u0.z = cvt_pk_bf16(kt[4] * Pc, kt[5] * Pc); u0.w = cvt_pk_bf16(kt[6] * Pc, kt[7] * Pc);
            u1.x = cvt_pk_bf16(kt[8] * Pc, kt[9] * Pc); u1.y = cvt_pk_bf16(kt[10] * Pc, kt[11] * Pc); u1.z = cvt_pk_bf16(kt[12] * Pc, kt[13] * Pc); u1.w = cvt_pk_bf16(kt[14] * Pc, kt[15] * Pc);
            *(u32x4*)(KhT + (c2_ * 128 + d_) * 16) = u0; *(u32x4*)(KhT + (c2_ * 128 + d_) * 16 + 8) = u1;
        } else {
            float vv[16];
#pragma unroll
            for (int i = 0; i < 16; ++i) {
                const int t = c2_ * 16 + i; const bf16_t* rr = raw + t * RP;
                vv[i] = bf2f(rr[256 + d_]);
                Gt[t * 128 + d_] = siluf_(bf2f(rr[384 + d_]));
            }
            u32x4 u0, u1;
            u0.x = cvt_pk_bf16(vv[0], vv[1]); u0.y = cvt_pk_bf16(vv[2], vv[3]); u0.z = cvt_pk_bf16(vv[4], vv[5]); u0.w = cvt_pk_bf16(vv[6], vv[7]);
            u1.x = cvt_pk_bf16(vv[8], vv[9]); u1.y = cvt_pk_bf16(vv[10], vv[11]); u1.z = cvt_pk_bf16(vv[12], vv[13]); u1.w = cvt_pk_bf16(vv[14], vv[15]);
            *(u32x4*)(VT + (c2_ * 128 + d_) * 16) = u0; *(u32x4*)(VT + (c2_ * 128 + d_) * 16 + 8) = u1;
        }
        __syncthreads();
        for (int c2 = 0; c2 < 2; ++c2) {
            if (c2 * 16 >= ns) break;
            const bf16_t* qrow = Qt + (c2 * 16 + fn) * QP; const bf16_t* krow = Kt + (c2 * 16 + fn) * QP;
            f32x4 at4 = {0.f, 0.f, 0.f, 0.f};
#pragma unroll
            for (int ks = 0; ks < 4; ++ks) at4 = __builtin_amdgcn_mfma_f32_16x16x32_bf16(*(const bf16x8*)(krow + ks * 32 + g * 8), *(const bf16x8*)(qrow + ks * 32 + g * 8), at4, 0, 0, 0);
            u32x4 ua; ua.x = cvt_pk_bf16((4 * g + 0 <= fn) ? at4[0] : 0.f, (4 * g + 1 <= fn) ? at4[1] : 0.f); ua.y = cvt_pk_bf16((4 * g + 2 <= fn) ? at4[2] : 0.f, (4 * g + 3 <= fn) ? at4[3] : 0.f); ua.z = 0u; ua.w = 0u;
            const u32x2 vlo = *(const u32x2*)(VT + (c2 * 128 + vs + fn) * 16 + 4 * g);
            u32x4 uv; uv.x = vlo.x; uv.y = vlo.y; uv.z = 0u; uv.w = 0u;
            const bf16x8 vb = __builtin_bit_cast(bf16x8, uv);
            f32x4 oacc = __builtin_amdgcn_mfma_f32_16x16x32_bf16(__builtin_bit_cast(bf16x8, ua), vb, (f32x4){0.f, 0.f, 0.f, 0.f}, 0, 0, 0);
#pragma unroll
            for (int ks = 0; ks < 4; ++ks) {
                const u32x2 qa = *(const u32x2*)(qrow + (2 * ks) * 16 + 4 * g), qb = *(const u32x2*)(qrow + (2 * ks + 1) * 16 + 4 * g);
                u32x4 uq; uq.x = qa.x; uq.y = qa.y; uq.z = qb.x; uq.w = qb.y;
                u32x4 us; us.x = cvt_pk_bf16(S[2 * ks][0], S[2 * ks][1]); us.y = cvt_pk_bf16(S[2 * ks][2], S[2 * ks][3]); us.z = cvt_pk_bf16(S[2 * ks + 1][0], S[2 * ks + 1][1]); us.w = cvt_pk_bf16(S[2 * ks + 1][2], S[2 * ks + 1][3]);
                oacc = __builtin_amdgcn_mfma_f32_16x16x32_bf16(__builtin_bit_cast(bf16x8, uq), __builtin_bit_cast(bf16x8, us), oacc, 0, 0, 0);
            }
#pragma unroll
            for (int jj = 0; jj < 4; ++jj) O[(c2 * 16 + 4 * g + jj) * 128 + vs + fn] = oacc[jj];
#pragma unroll
            for (int T = 0; T < 8; ++T) {
                const float4 pc4 = *(const float4*)(PC + c2 * 128 + T * 16 + 4 * g);
                const u32x2 kh = *(const u32x2*)(KhT + (c2 * 128 + T * 16 + fn) * 16 + 4 * g);
                u32x4 uk; uk.x = kh.x; uk.y = kh.y; uk.z = 0u; uk.w = 0u;
                f32x4 sc = S[T]; sc[0] *= pc4.x; sc[1] *= pc4.y; sc[2] *= pc4.z; sc[3] *= pc4.w;
                S[T] = __builtin_amdgcn_mfma_f32_16x16x32_bf16(__builtin_bit_cast(bf16x8, uk), vb, sc, 0, 0, 0);
            }
        }
        if (more) raw_store<PPR, NROW, NLD>(rg, raw, tid);
        __syncthreads();
        for (int t = w; t < ns; t += 8) {
            const size_t row = brow + t0 + t;
            const float2 o2 = *(const float2*)(O + t * 128 + lane * 2);
            const float2 g2 = *(const float2*)(Gt + t * 128 + lane * 2);
            const int v = lane * 2;
            if (!HG) {
                const float mean = wave_sum(o2.x + o2.y) * (1.0f / 128.0f);
                const float x0 = o2.x - mean, x1 = o2.y - mean;
                const float var = wave_sum(x0 * x0 + x1 * x1) * (1.0f / 128.0f);
                const float rs = rsqrtf(var + EPS);
                *(unsigned*)(Y + row * D + h * 128 + v) = cvt_pk_bf16(x0 * rs * g2.x, x1 * rs * g2.y);
            } else {
                const float ms = wave_sum(o2.x * o2.x + o2.y * o2.y) * (1.0f / 128.0f);
                const float rs = rsqrtf(ms + EPS);
                *(unsigned*)(Y + row * D + 512 + h * 128 + v) = cvt_pk_bf16(o2.x * rs * hgn.x * g2.x, o2.y * rs * hgn.y * g2.y);
            }
        }
    }
}
__device__ __forceinline__ void even_scan_phase(const Params& p, float* lds) {
    for (int item = obid(); item < 256; item += gridDim.x) {
        const int idx = item & 127, b = idx >> 2, h = idx & 3;
        if (item < 128) even_item<false>(p, lds, b, h); else even_item<true>(p, lds, b, h);
        __syncthreads();
    }
}

typedef float f32x2 __attribute__((ext_vector_type(2)));
constexpr int TCR = 16;
constexpr int RW_ITEM_FLOATS = 16256;
__device__ __forceinline__ void rwkv_half(const Params& p, float* lds, int b, int h, int half) {
    const bf16_t* P = (const bf16_t*)(p.ws + WS_BIG);
    bf16_t* Y = (bf16_t*)(p.ws + WS_Y2);
    float* R = lds; float* W = R + TCR * 64; float* Kk = W + TCR * 64; float* Vv = Kk + TCR * 64; float* A = Vv + TCR * 64; float* Bb = A + TCR * 64;
    float* O = Bb + TCR * 64; float* G = O + TCR * 64; float* RK = G + TCR * 64; float* WP = RK + 64; float* AP = WP + TCR * 64;
    constexpr int LAP = 264;
    bf16_t* LAb = (bf16_t*)(AP + TCR * 64);
    bf16_t* LAbS = (bf16_t*)((lds - half * RW_ITEM_FLOATS) + (8 * TCR * 64 + 64 + 2 * TCR * 64));
    bf16_t* raw = LAb + TCR * LAP;
    constexpr int PPR = 56, NROW = 17, NLD = 4, RP = 448;
    const float* mu = p.in[9]; const float* w2 = p.in[11]; const float* a2 = p.in[13]; const float* g2 = p.in[14];
    const int tid = otid() & 255, lane = tid & 63, lw = tid >> 6;
    const int kg = lane & 7, vp = lw * 8 + (lane >> 3);
    const int hc = h * 64 + lane;
    auto col = [&](int pc) { return pc < 24 ? (pc >> 3) * 512 + h * 64 + (pc & 7) * 8 : 1536 + (pc - 24) * 8; };
    const size_t brow = (size_t)b * L;
    const int j1 = tid; const float mu1 = mu[1536 + j1];
    const int tq = tid >> 4, cl = tid & 15, hc4 = h * 64 + 4 * cl;
    const float4 mu_r = *(const float4*)(mu + hc4), mu_k = *(const float4*)(mu + 512 + hc4), mu_v = *(const float4*)(mu + 1024 + hc4);
    const float4 w0c = *(const float4*)(p.in[10] + hc4), a0c = *(const float4*)(p.in[12] + hc4), kksc = *(const float4*)(p.in[15] + hc4), kasc = *(const float4*)(p.in[16] + hc4);
    const float4 rkc = *(const float4*)(p.in[17] + hc4), lnwc = *(const float4*)(p.in[18] + hc4), lnbc = *(const float4*)(p.in[19] + hc4);
    f32x2 S[8];
#pragma unroll
    for (int i = 0; i < 8; ++i) S[i] = (f32x2){0.f, 0.f};
    const int fn = lane & 15, fkq = lane >> 4;
    bf16x8 bw[2], ba[2], bg[4];
    {
        const int cc = h * 64 + lw * 16 + fn;
#pragma unroll
        for (int ks = 0; ks < 2; ++ks) {
            float e[8], f[8];
#pragma unroll
            for (int j = 0; j < 8; ++j) { e[j] = w2[(ks * 32 + fkq * 8 + j) * 512 + cc]; f[j] = a2[(ks * 32 + fkq * 8 + j) * 512 + cc]; }
            u32x4 u; u.x = cvt_pk_bf16(e[0], e[1]); u.y = cvt_pk_bf16(e[2], e[3]); u.z = cvt_pk_bf16(e[4], e[5]); u.w = cvt_pk_bf16(e[6], e[7]); bw[ks] = __builtin_bit_cast(bf16x8, u);
            u.x = cvt_pk_bf16(f[0], f[1]); u.y = cvt_pk_bf16(f[2], f[3]); u.z = cvt_pk_bf16(f[4], f[5]); u.w = cvt_pk_bf16(f[6], f[7]); ba[ks] = __builtin_bit_cast(bf16x8, u);
        }
#pragma unroll
        for (int ks = 0; ks < 4; ++ks) {
            float e[8];
#pragma unroll
            for (int j = 0; j < 8; ++j) e[j] = g2[(ks * 32 + fkq * 8 + j) * 512 + cc];
            u32x4 u; u.x = cvt_pk_bf16(e[0], e[1]); u.y = cvt_pk_bf16(e[2], e[3]); u.z = cvt_pk_bf16(e[4], e[5]); u.w = cvt_pk_bf16(e[6], e[7]); bg[ks] = __builtin_bit_cast(bf16x8, u);
        }
    }
    u32x4 rg[NLD];
    __syncthreads();
    raw_fetch<PPR, NROW, NLD, 256>(rg, P, tid, brow, -1, col); raw_store<PPR, NROW, NLD, 256>(rg, raw, tid);
    for (int t0 = 0; t0 < L; t0 += TCR) {
        const bool more = (t0 + TCR < L);
        if (t0 == 0) __syncthreads();
#pragma unroll 4
        for (int t = half * 8; t < half * 8 + 8; ++t) {
            const float cur = bf2f(raw[(t + 1) * RP + 192 + j1]), prev = bf2f(raw[t * RP + 192 + j1]);
            const float x = cur + (prev - cur) * mu1;
            float y;
            if (j1 < 64) y = 1.0f - 2.0f * __builtin_amdgcn_rcpf(1.0f + __expf(2.0f * x)); else if (j1 < 128) y = x; else y = sigmoidf_(x);
            LAbS[t * LAP + j1] = f2bf(y);
        }
        __syncthreads();
        {
            const bf16_t* ap = LAbS + fn * LAP + fkq * 8;
            f32x4 cw4 = {0.f, 0.f, 0.f, 0.f}, ca4 = {0.f, 0.f, 0.f, 0.f}, cg4 = {0.f, 0.f, 0.f, 0.f};
#pragma unroll
            for (int ks = 0; ks < 2; ++ks) cw4 = __builtin_amdgcn_mfma_f32_16x16x32_bf16(*(const bf16x8*)(ap + ks * 32), bw[ks], cw4, 0, 0, 0);
#pragma unroll
            for (int ks = 0; ks < 2; ++ks) ca4 = __builtin_amdgcn_mfma_f32_16x16x32_bf16(*(const bf16x8*)(ap + 64 + ks * 32), ba[ks], ca4, 0, 0, 0);
#pragma unroll
            for (int ks = 0; ks < 4; ++ks) cg4 = __builtin_amdgcn_mfma_f32_16x16x32_bf16(*(const bf16x8*)(ap + 128 + ks * 32), bg[ks], cg4, 0, 0, 0);
#pragma unroll
            for (int j = 0; j < 4; ++j) { const int o = (fkq * 4 + j) * 64 + lw * 16 + fn; WP[o] = cw4[j]; AP[o] = ca4[j]; G[o] = cg4[j]; }
        }
        __syncthreads();
        {
            const int t = tq;
            const u32x2 c0 = *(const u32x2*)(raw + (t + 1) * RP + 4 * cl), c1 = *(const u32x2*)(raw + (t + 1) * RP + 64 + 4 * cl), c2v = *(const u32x2*)(raw + (t + 1) * RP + 128 + 4 * cl);
            const u32x2 p0 = *(const u32x2*)(raw + t * RP + 4 * cl), p1 = *(const u32x2*)(raw + t * RP + 64 + 4 * cl), p2 = *(const u32x2*)(raw + t * RP + 128 + 4 * cl);
            auto up4 = [](u32x2 u, float (&o)[4]) { o[0] = __uint_as_float(u.x << 16); o[1] = __uint_as_float(u.x & 0xffff0000u); o[2] = __uint_as_float(u.y << 16); o[3] = __uint_as_float(u.y & 0xffff0000u); };
            float cr[4], ck[4], cv[4], pr[4], pk[4], pv[4];
            up4(c0, cr); up4(c1, ck); up4(c2v, cv); up4(p0, pr); up4(p1, pk); up4(p2, pv);
            const float4 wp4 = *(const float4*)(WP + t * 64 + 4 * cl), ap4 = *(const float4*)(AP + t * 64 + 4 * cl);
            const float mur[4] = {mu_r.x, mu_r.y, mu_r.z, mu_r.w}, muk[4] = {mu_k.x, mu_k.y, mu_k.z, mu_k.w}, muv[4] = {mu_v.x, mu_v.y, mu_v.z, mu_v.w};
            const float w0a[4] = {w0c.x, w0c.y, w0c.z, w0c.w}, a0a[4] = {a0c.x, a0c.y, a0c.z, a0c.w}, kksa[4] = {kksc.x, kksc.y, kksc.z, kksc.w}, kasa[4] = {kasc.x, kasc.y, kasc.z, kasc.w}, rka[4] = {rkc.x, rkc.y, rkc.z, rkc.w};
            const float wpa[4] = {wp4.x, wp4.y, wp4.z, wp4.w}, apa[4] = {ap4.x, ap4.y, ap4.z, ap4.w};
            float rr[4], kr[4], vr[4], dec[4], av[4], kkr[4], kmod[4]; float ssq = 0.f, rks = 0.f;
#pragma unroll
            for (int e = 0; e < 4; ++e) {
                rr[e] = cr[e] + (pr[e] - cr[e]) * mur[e]; kr[e] = ck[e] + (pk[e] - ck[e]) * muk[e]; vr[e] = cv[e] + (pv[e] - cv[e]) * muv[e];
                const float lw_ = -softplusf_(-(w0a[e] + wpa[e])) - 0.5f;
                dec[e] = __expf(-__expf(lw_));
                av[e] = sigmoidf_(a0a[e] + apa[e]);
                kkr[e] = kr[e] * kksa[e]; ssq += kkr[e] * kkr[e];
                kmod[e] = kr[e] * (1.0f + (av[e] - 1.0f) * kasa[e]);
                rks += rr[e] * kmod[e] * rka[e];
            }
            ssq = allreduce16(ssq); rks = allreduce16(rks);
            const float rn = rsqrtf(ssq + EPS);
            *(float4*)(R + t * 64 + 4 * cl) = make_float4(rr[0], rr[1], rr[2], rr[3]);
            *(float4*)(W + t * 64 + 4 * cl) = make_float4(dec[0], dec[1], dec[2], dec[3]);
            *(float4*)(Kk + t * 64 + 4 * cl) = make_float4(kmod[0], kmod[1], kmod[2], kmod[3]);
            *(float4*)(Vv + t * 64 + 4 * cl) = make_float4(vr[0], vr[1], vr[2], vr[3]);
            *(float4*)(A + t * 64 + 4 * cl) = make_float4(-kkr[0] * rn, -kkr[1] * rn, -kkr[2] * rn, -kkr[3] * rn);
            *(float4*)(Bb + t * 64 + 4 * cl) = make_float4(kkr[0] * rn * av[0], kkr[1] * rn * av[1], kkr[2] * rn * av[2], kkr[3] * rn * av[3]);
            if (cl == 0) RK[t] = rks;
        }
        __syncthreads();
        if (more) raw_fetch<PPR, NROW, NLD, 256>(rg, P, tid, brow, t0 + TCR - 1, col);
        {
            struct Ops { float4 aa, ab, wa, wb, ba, bb, ka, kb, ra, rb; float2 vv; };
            auto ld = [&](Ops& o, int t) {
                o.aa = *(const float4*)(A + t * 64 + kg * 8); o.ab = *(const float4*)(A + t * 64 + kg * 8 + 4);
                o.wa = *(const float4*)(W + t * 64 + kg * 8); o.wb = *(const float4*)(W + t * 64 + kg * 8 + 4);
                o.ba = *(const float4*)(Bb + t * 64 + kg * 8); o.bb = *(const float4*)(Bb + t * 64 + kg * 8 + 4);
                o.ka = *(const float4*)(Kk + t * 64 + kg * 8); o.kb = *(const float4*)(Kk + t * 64 + kg * 8 + 4);
                o.ra = *(const float4*)(R + t * 64 + kg * 8); o.rb = *(const float4*)(R + t * 64 + kg * 8 + 4);
                o.vv = *(const float2*)(Vv + t * 64 + 2 * vp);
            };
            auto step = [&](const Ops& x, int t) {
                const float a8[8] = {x.aa.x, x.aa.y, x.aa.z, x.aa.w, x.ab.x, x.ab.y, x.ab.z, x.ab.w};
                const float w8[8] = {x.wa.x, x.wa.y, x.wa.z, x.wa.w, x.wb.x, x.wb.y, x.wb.z, x.wb.w};
                const float b8[8] = {x.ba.x, x.ba.y, x.ba.z, x.ba.w, x.bb.x, x.bb.y, x.bb.z, x.bb.w};
                const float k8[8] = {x.ka.x, x.ka.y, x.ka.z, x.ka.w, x.kb.x, x.kb.y, x.kb.z, x.kb.w};
                const float r8[8] = {x.ra.x, x.ra.y, x.ra.z, x.ra.w, x.rb.x, x.rb.y, x.rb.z, x.rb.w};
                const f32x2 vv2 = {x.vv.x, x.vv.y};
                f32x2 sa0 = {0.f, 0.f}, sa1 = {0.f, 0.f};
#pragma unroll
                for (int i = 0; i < 8; i += 2) { sa0 += S[i] * a8[i]; sa1 += S[i + 1] * a8[i + 1]; }
                f32x2 sa = sa0 + sa1; sa.x = allreduce8(sa.x); sa.y = allreduce8(sa.y);
                f32x2 y0 = {0.f, 0.f}, y1 = {0.f, 0.f};
#pragma unroll
                for (int i = 0; i < 8; i += 2) {
                    S[i] = S[i] * w8[i] + sa * b8[i] + vv2 * k8[i]; y0 += S[i] * r8[i];
                    S[i + 1] = S[i + 1] * w8[i + 1] + sa * b8[i + 1] + vv2 * k8[i + 1]; y1 += S[i + 1] * r8[i + 1];
                }
                f32x2 y = y0 + y1; y.x = allreduce8(y.x); y.y = allreduce8(y.y);
                if (kg == 0) *(float2*)(O + t * 64 + 2 * vp) = make_float2(y.x, y.y);
            };
            Ops A_, B_; ld(A_, 0);
#pragma unroll
            for (int t = 0; t < TCR; t += 2) {
                ld(B_, t + 1); step(A_, t);
                if (t + 2 < TCR) ld(A_, t + 2);
                step(B_, t + 1);
            }
        }
        if (more) raw_store<PPR, NROW, NLD, 256>(rg, raw, tid);
        __syncthreads();
        {
            const int t = tq; const size_t row = brow + t0 + t;
            const float4 y4 = *(const float4*)(O + t * 64 + 4 * cl), v4 = *(const float4*)(Vv + t * 64 + 4 * cl), g4 = *(const float4*)(G + t * 64 + 4 * cl);
            const float mean = allreduce16((y4.x + y4.y) + (y4.z + y4.w)) * (1.0f / 64.0f);
            const float x0 = y4.x - mean, x1 = y4.y - mean, x2 = y4.z - mean, x3 = y4.w - mean;
            const float var = allreduce16((x0 * x0 + x1 * x1) + (x2 * x2 + x3 * x3)) * (1.0f / 64.0f);
            const float rs = rsqrtf(var + 64e-5f), rkt = RK[t];
            const float o0 = (x0 * rs * lnwc.x + lnbc.x + rkt * v4.x) * g4.x, o1 = (x1 * rs * lnwc.y + lnbc.y + rkt * v4.y) * g4.y;
            const float o2 = (x2 * rs * lnwc.z + lnbc.z + rkt * v4.z) * g4.z, o3 = (x3 * rs * lnwc.w + lnbc.w + rkt * v4.w) * g4.w;
            u32x2 ow; ow.x = cvt_pk_bf16(o0, o1); ow.y = cvt_pk_bf16(o2, o3);
            *(u32x2*)(Y + row * D + hc4) = ow;
        }
    }
}
template <int CTRL> __device__ __forceinline__ float dpp0f(float x) { return __int_as_float(__builtin_amdgcn_update_dpp(0, __float_as_int(x), CTRL, 0xF, 0xF, true)); }
__device__ __forceinline__ void gdn_item(const Params& p, float* lds, int b, int h) {
    const bf16_t* P = (const bf16_t*)(p.ws + WS_BIG);
    bf16_t* Y = (bf16_t*)(p.ws + WS_Y2);
    constexpr int QP = 136, MP = 24;
    float* O = lds; float* Gt = O + TCH * 128; float* GB = Gt + TCH * 128; float* CG = GB + 64;
    bf16_t* MinvB = (bf16_t*)(CG + 64); bf16_t* MinvE = MinvB + 2 * 16 * MP;
    bf16_t* Qb = MinvE + 2 * 16 * MP; bf16_t* Kb = Qb + TCH * QP; bf16_t* Wb = Kb + TCH * QP;
    bf16_t* KT = Wb + TCH * QP; bf16_t* VT = KT + 2 * 128 * 16;
    bf16_t* raw = VT + 2 * 128 * 16;
    constexpr int PPR = 65, NROW = 35, NLD = 5, RP = 520;
    const float* cw = p.in[20];
    const int tid = otid(), lane = tid & 63, w = tid >> 6;
    const int fn = lane & 15, g = lane >> 4, vs = w * 16;
    auto col = [&](int pc) { return pc < 48 ? 1792 + (pc >> 4) * 512 + h * 128 + (pc & 15) * 8 : (pc < 64 ? 3328 + h * 128 + (pc - 48) * 8 : 3840); };
    const size_t brow = (size_t)b * L;
    const float Aneg = -__expf(p.in[21][h]); const float dtb = p.in[22][h];
    const float2 gn = *(const float2*)(p.in[23] + 2 * lane);
    float cwr[3][4][2];
#pragma unroll
    for (int x = 0; x < 3; ++x)
#pragma unroll
        for (int j = 0; j < 4; ++j) { cwr[x][j][0] = cw[j * 1536 + x * 512 + h * 128 + 2 * lane]; cwr[x][j][1] = cw[j * 1536 + x * 512 + h * 128 + 2 * lane + 1]; }
    f32x4 S[8];
#pragma unroll
    for (int T = 0; T < 8; ++T) S[T] = (f32x4){0.f, 0.f, 0.f, 0.f};
    u32x4 rg[NLD];
    __syncthreads();
    raw_fetch<PPR, NROW, NLD>(rg, P, tid, brow, -3, col); raw_store<PPR, NROW, NLD>(rg, raw, tid);
    for (int t0 = 0; t0 < L; t0 += TCH) {
        const int ns = (L - t0) < TCH ? (L - t0) : TCH;
        const bool more = (t0 + TCH < L);
        __syncthreads();
        if (more) raw_fetch<PPR, NROW, NLD>(rg, P, tid, brow, t0 + TCH - 3, col);
        for (int t = w; t < ns; t += 8) {
            float xs[3][2];
#pragma unroll
            for (int x = 0; x < 3; ++x) {
                float a0 = 0.f, a1 = 0.f;
#pragma unroll
                for (int j = 0; j < 4; ++j) {
                    const unsigned wv = *(const unsigned*)(raw + (t + j) * RP + x * 128 + 2 * lane);
                    a0 += cwr[x][j][0] * __uint_as_float(wv << 16); a1 += cwr[x][j][1] * __uint_as_float(wv & 0xffff0000u);
                }
                xs[x][0] = siluf_(a0); xs[x][1] = siluf_(a1);
            }
            const float sq = wave_sum(xs[0][0] * xs[0][0] + xs[0][1] * xs[0][1]);
            const float sk = wave_sum(xs[1][0] * xs[1][0] + xs[1][1] * xs[1][1]);
            const float rq = rsqrtf(sq + EPS) * 0.08838834764831845f, rk = rsqrtf(sk + EPS);
            const int c2 = t >> 4, i = t & 15;
            *(unsigned*)(Qb + t * QP + 2 * lane) = cvt_pk_bf16(xs[0][0] * rq, xs[0][1] * rq);
            const unsigned kw = cvt_pk_bf16(xs[1][0] * rk, xs[1][1] * rk);
            *(unsigned*)(Kb + t * QP + 2 * lane) = kw;
            KT[(c2 * 128 + 2 * lane) * 16 + i] = (bf16_t)(kw & 0xffffu); KT[(c2 * 128 + 2 * lane + 1) * 16 + i] = (bf16_t)(kw >> 16);
            const unsigned vw = cvt_pk_bf16(xs[2][0], xs[2][1]);
            VT[(c2 * 128 + 2 * lane) * 16 + i] = (bf16_t)(vw & 0xffffu); VT[(c2 * 128 + 2 * lane + 1) * 16 + i] = (bf16_t)(vw >> 16);
            const unsigned gw = *(const unsigned*)(raw + (t + 3) * RP + 384 + 2 * lane);
            *(float2*)(Gt + t * 128 + 2 * lane) = make_float2(siluf_(__uint_as_float(gw << 16)), siluf_(__uint_as_float(gw & 0xffff0000u)));
            if (lane == 0) {
                const float al = bf2f(raw[(t + 3) * RP + 512 + h]), be = bf2f(raw[(t + 3) * RP + 516 + h]);
                GB[t * 2] = Aneg * softplusf_(al + dtb); GB[t * 2 + 1] = sigmoidf_(be);
            }
        }
        __syncthreads();
        if (w < 2 && w * 16 < ns) {
            const int c2 = w;
            float cgf = GB[(c2 * 16 + fn) * 2]; const float betf = GB[(c2 * 16 + fn) * 2 + 1];
            cgf += dpp0f<0x111>(cgf); cgf += dpp0f<0x112>(cgf); cgf += dpp0f<0x114>(cgf); cgf += dpp0f<0x118>(cgf);
            if (g == 0) CG[c2 * 16 + fn] = cgf;
            const bf16_t* krow = Kb + (c2 * 16 + fn) * QP;
            f32x4 kk4 = {0.f, 0.f, 0.f, 0.f};
#pragma unroll
            for (int ks = 0; ks < 4; ++ks) { const bf16x8 kf = *(const bf16x8*)(krow + ks * 32 + g * 8); kk4 = __builtin_amdgcn_mfma_f32_16x16x32_bf16(kf, kf, kk4, 0, 0, 0); }
            const float4 cga = *(const float4*)(CG + c2 * 16 + 4 * g);
            const float cga4[4] = {cga.x, cga.y, cga.z, cga.w};
            float m4[4];
#pragma unroll
            for (int jj = 0; jj < 4; ++jj) { const float ba = GB[(c2 * 16 + 4 * g + jj) * 2 + 1]; m4[jj] = (fn < 4 * g + jj) ? ba * kk4[jj] * __expf(cga4[jj] - cgf) : 0.f; }
            float x[16];
#pragma unroll
            for (int i = 0; i < 16; ++i) {
                float acc = (fn == i) ? 1.f : 0.f;
#pragma unroll
                for (int j = 0; j < i; ++j) {
                    const float mij = __int_as_float(__builtin_amdgcn_readlane(__float_as_int(m4[i & 3]), j + 16 * (i >> 2)));
                    acc -= mij * x[j];
                }
                x[i] = acc;
            }
            if (g == 0) {
                const float eb = betf * __expf(cgf);
#pragma unroll
                for (int i = 0; i < 16; ++i) { MinvB[(c2 * 16 + i) * MP + fn] = f2bf(x[i] * betf); MinvE[(c2 * 16 + i) * MP + fn] = f2bf(x[i] * eb); }
            }
        }
        __syncthreads();
        for (int c2 = 0; c2 < 2; ++c2) {
            if (c2 * 16 >= ns) break;
            const u32x2 ma = *(const u32x2*)(MinvE + (c2 * 16 + fn) * MP + 4 * g); const u32x2 kt = *(const u32x2*)(KT + (c2 * 128 + vs + fn) * 16 + 4 * g);
            u32x4 ua; ua.x = ma.x; ua.y = ma.y; ua.z = 0u; ua.w = 0u; u32x4 ub; ub.x = kt.x; ub.y = kt.y; ub.z = 0u; ub.w = 0u;
            const f32x4 c4 = __builtin_amdgcn_mfma_f32_16x16x32_bf16(__builtin_bit_cast(bf16x8, ua), __builtin_bit_cast(bf16x8, ub), (f32x4){0.f, 0.f, 0.f, 0.f}, 0, 0, 0);
#pragma unroll
            for (int jj = 0; jj < 4; ++jj) Wb[(c2 * 16 + 4 * g + jj) * QP + vs + fn] = f2bf(c4[jj]);
        }
        __syncthreads();
        for (int c2 = 0; c2 < 2; ++c2) {
            if (c2 * 16 >= ns) break;
            const float4 cgt = *(const float4*)(CG + c2 * 16 + 4 * g); const float cgt4[4] = {cgt.x, cgt.y, cgt.z, cgt.w};
            const float cgf = CG[c2 * 16 + fn], cg15 = CG[c2 * 16 + 15];
            const bf16_t* qrow = Qb + (c2 * 16 + fn) * QP; const bf16_t* krow = Kb + (c2 * 16 + fn) * QP; const bf16_t* wrow = Wb + (c2 * 16 + fn) * QP;
            f32x4 at4 = {0.f, 0.f, 0.f, 0.f};
#pragma unroll
            for (int ks = 0; ks < 4; ++ks) at4 = __builtin_amdgcn_mfma_f32_16x16x32_bf16(*(const bf16x8*)(krow + ks * 32 + g * 8), *(const bf16x8*)(qrow + ks * 32 + g * 8), at4, 0, 0, 0);
            float qv[4];
#pragma unroll
            for (int jj = 0; jj < 4; ++jj) qv[jj] = (4 * g + jj <= fn) ? at4[jj] * __expf(cgf - cgt4[jj]) : 0.f;
            u32x4 uqk; uqk.x = cvt_pk_bf16(qv[0], qv[1]); uqk.y = cvt_pk_bf16(qv[2], qv[3]); uqk.z = 0u; uqk.w = 0u;
            const u32x2 mb = *(const u32x2*)(MinvB + (c2 * 16 + fn) * MP + 4 * g); const u32x2 vt = *(const u32x2*)(VT + (c2 * 128 + vs + fn) * 16 + 4 * g);
            u32x4 uma; uma.x = mb.x; uma.y = mb.y; uma.z = 0u; uma.w = 0u; u32x4 uvt; uvt.x = vt.x; uvt.y = vt.y; uvt.z = 0u; uvt.w = 0u;
            const f32x4 u4 = __builtin_amdgcn_mfma_f32_16x16x32_bf16(__builtin_bit_cast(bf16x8, uma), __builtin_bit_cast(bf16x8, uvt), (f32x4){0.f, 0.f, 0.f, 0.f}, 0, 0, 0);
            f32x4 ws4 = {0.f, 0.f, 0.f, 0.f}, qs4 = {0.f, 0.f, 0.f, 0.f};
#pragma unroll
            for (int ks = 0; ks < 4; ++ks) {
                u32x4 us; us.x = cvt_pk_bf16(S[2 * ks][0], S[2 * ks][1]); us.y = cvt_pk_bf16(S[2 * ks][2], S[2 * ks][3]); us.z = cvt_pk_bf16(S[2 * ks + 1][0], S[2 * ks + 1][1]); us.w = cvt_pk_bf16(S[2 * ks + 1][2], S[2 * ks + 1][3]);
                const bf16x8 sb = __builtin_bit_cast(bf16x8, us);
                const u32x2 wa = *(const u32x2*)(wrow + (2 * ks) * 16 + 4 * g), wb2 = *(const u32x2*)(wrow + (2 * ks + 1) * 16 + 4 * g);
                u32x4 uw; uw.x = wa.x; uw.y = wa.y; uw.z = wb2.x; uw.w = wb2.y;
                ws4 = __builtin_amdgcn_mfma_f32_16x16x32_bf16(__builtin_bit_cast(bf16x8, uw), sb, ws4, 0, 0, 0);
                const u32x2 qa = *(const u32x2*)(qrow + (2 * ks) * 16 + 4 * g), qb2 = *(const u32x2*)(qrow + (2 * ks + 1) * 16 + 4 * g);
                u32x4 uq; uq.x = qa.x; uq.y = qa.y; uq.z = qb2.x; uq.w = qb2.y;
                qs4 = __builtin_amdgcn_mfma_f32_16x16x32_bf16(__builtin_bit_cast(bf16x8, uq), sb, qs4, 0, 0, 0);
            }
            float vn[4];
#pragma unroll
            for (int jj = 0; jj < 4; ++jj) { vn[jj] = u4[jj] - ws4[jj]; qs4[jj] *= __expf(cgt4[jj]); }
            u32x4 uvn; uvn.x = cvt_pk_bf16(vn[0], vn[1]); uvn.y = cvt_pk_bf16(vn[2], vn[3]); uvn.z = 0u; uvn.w = 0u;
            const f32x4 o4 = __builtin_amdgcn_mfma_f32_16x16x32_bf16(__builtin_bit_cast(bf16x8, uqk), __builtin_bit_cast(bf16x8, uvn), qs4, 0, 0, 0);
#pragma unroll
            for (int jj = 0; jj < 4; ++jj) O[(c2 * 16 + 4 * g + jj) * 128 + vs + fn] = o4[jj];
            u32x4 uvd; uvd.x = cvt_pk_bf16(vn[0] * __expf(cg15 - cgt4[0]), vn[1] * __expf(cg15 - cgt4[1])); uvd.y = cvt_pk_bf16(vn[2] * __expf(cg15 - cgt4[2]), vn[3] * __expf(cg15 - cgt4[3])); uvd.z = 0u; uvd.w = 0u;
            const bf16x8 vdb = __builtin_bit_cast(bf16x8, uvd);
            const float e15 = __expf(cg15);
#pragma unroll
            for (int T = 0; T < 8; ++T) {
                const u32x2 kh = *(const u32x2*)(KT + (c2 * 128 + T * 16 + fn) * 16 + 4 * g);
                u32x4 uk; uk.x = kh.x; uk.y = kh.y; uk.z = 0u; uk.w = 0u;
                f32x4 sc = S[T]; sc[0] *= e15; sc[1] *= e15; sc[2] *= e15; sc[3] *= e15;
                S[T] = __builtin_amdgcn_mfma_f32_16x16x32_bf16(__builtin_bit_cast(bf16x8, uk), vdb, sc, 0, 0, 0);
            }
        }
        if (more) raw_store<PPR, NROW, NLD>(rg, raw, tid);
        __syncthreads();
        for (int t = w; t < ns; t += 8) {
            const size_t row = brow + t0 + t;
            const float2 o2 = *(const float2*)(O + t * 128 + lane * 2);
            const float2 g2 = *(const float2*)(Gt + t * 128 + lane * 2);
            const int v = lane * 2;
            const float ms = wave_sum(o2.x * o2.x + o2.y * o2.y) * (1.0f / 128.0f);
            const float rs = rsqrtf(ms + EPS);
            *(unsigned*)(Y + row * D + 512 + h * 128 + v) = cvt_pk_bf16(o2.x * rs * gn.x * g2.x, o2.y * rs * gn.y * g2.y);
        }
    }
}
__device__ __forceinline__ void odd_scan_phase(const Params& p, float* lds) {
    for (int item = obid(); item < 256; item += gridDim.x) {
        const int y = item & 127, slot = y >> 3; const int bt = (y & 7) * 4 + (slot >> 2), sub = slot & 3;
        if (item < 128) { gdn_item(p, lds, bt, sub); __syncthreads(); }
        else {
            const int half = otid() >> 8;
            rwkv_half(p, lds + half * RW_ITEM_FLOATS, bt, sub * 2 + half, half); __syncthreads();
        }
    }
}

#define XB_TMO      128
#define XB_XCNT(j)  (256  + 64 * (j))
#define XB_XSUB(j)  (1280 + 64 * (j))
#define XB_XGEN(j)  (2304 + 64 * (j))
#define XB_TOP      3328
#define XB_TOPGEN   3392
#define XCD_BAR_WORDS 3456
#define XB_SPIN_CAP (1u << 18)
__device__ __forceinline__ unsigned xb_ld(unsigned* p)              { return __hip_atomic_load(p, __ATOMIC_RELAXED, __HIP_MEMORY_SCOPE_AGENT); }
__device__ __forceinline__ unsigned xb_add(unsigned* p, unsigned v) { return __hip_atomic_fetch_add(p, v, __ATOMIC_RELAXED, __HIP_MEMORY_SCOPE_AGENT); }
__device__ __forceinline__ unsigned xb_xcc_id() { return (unsigned)__builtin_amdgcn_s_getreg((3 << 11) | 20) & 0xFu; }
#define XB_SPIN(cond, bar) do { unsigned _sp = 0; while (cond) { __builtin_amdgcn_s_sleep(1); \
    if ((++_sp & 255u) == 0u) { if (xb_ld(&(bar)[XB_TMO])) break; if (_sp > XB_SPIN_CAP) { atomicAdd(&(bar)[XB_TMO], 1u); break; } } } } while (0)
struct XcdBarrier { unsigned* bar; unsigned x; volatile LAS unsigned* st; };
__device__ __forceinline__ XcdBarrier xcd_barrier_post(unsigned* bar, volatile LAS unsigned* st) {
    XcdBarrier b; b.bar = bar; b.x = xb_xcc_id(); b.st = st;
    if (threadIdx.x == 0) (void)xb_add(&bar[XB_XCNT(b.x)], 1u);
    return b;
}
__device__ __forceinline__ void xcd_barrier_complete(unsigned* bar, unsigned x, unsigned& nloc, unsigned& nx) {
    const unsigned G = gridDim.x * gridDim.y * gridDim.z;
    unsigned sum, cnt, mine, sp = 0u;
    for (;;) {
        sum = 0u; cnt = 0u; mine = 0u;
#pragma unroll
        for (unsigned j = 0; j < 16; ++j) { const unsigned c = xb_ld(&bar[XB_XCNT(j)]); sum += c; cnt += (c > 0u) ? 1u : 0u; mine = (j == x) ? c : mine; }
        if (sum == G) break;
        __builtin_amdgcn_s_sleep(1);
        if ((++sp & 255u) == 0u) { if (xb_ld(&bar[XB_TMO])) break; if (sp > XB_SPIN_CAP) { atomicAdd(&bar[XB_TMO], 1u); break; } }
    }
    nloc = mine > 0u ? mine : 1u; nx = cnt > 0u ? cnt : 1u;
}
__device__ __forceinline__ void xcd_barrier(const XcdBarrier& b) {
    asm volatile("s_waitcnt vmcnt(0)" ::: "memory");
    __syncthreads();
    if (threadIdx.x == 0) {
        unsigned* bar = b.bar;
        __builtin_amdgcn_s_waitcnt(0);
        unsigned nloc = b.st[0], nx = b.st[1];
        if (nloc == 0u) { xcd_barrier_complete(bar, b.x, nloc, nx); b.st[0] = nloc; b.st[1] = nx; }
        const unsigned old = xb_add(&bar[XB_XSUB(b.x)], 1u);
        const unsigned gen = old / nloc;
        if (old + 1u == (gen + 1u) * nloc) {
            __builtin_amdgcn_fence(__ATOMIC_RELEASE, "agent");
            asm volatile("s_waitcnt vmcnt(0)" ::: "memory");
            const unsigned og = xb_add(&bar[XB_TOP], 1u);
            const unsigned tg = og / nx;
            if (og + 1u == (tg + 1u) * nx) xb_add(&bar[XB_TOPGEN], 1u);
            else XB_SPIN(xb_ld(&bar[XB_TOPGEN]) == tg, bar);
            __builtin_amdgcn_fence(__ATOMIC_ACQUIRE, "agent");
            xb_add(&bar[XB_XGEN(b.x)], 1u);
            asm volatile("s_waitcnt vmcnt(0)" ::: "memory");
        } else {
            XB_SPIN(xb_ld(&bar[XB_XGEN(b.x)]) == gen, bar);
            __builtin_amdgcn_fence(__ATOMIC_ACQUIRE, "agent");
            asm volatile("s_waitcnt vmcnt(0)" ::: "memory");
        }
    }
    __syncthreads();
}

__device__ __forceinline__ void sub_barrier(unsigned* word, unsigned nblk) {
    asm volatile("s_waitcnt vmcnt(0)" ::: "memory");
    __syncthreads();
    if (threadIdx.x == 0) {
        __builtin_amdgcn_fence(__ATOMIC_RELEASE, "agent");
        asm volatile("s_waitcnt vmcnt(0)" ::: "memory");
        (void)xb_add(word, 1u);
        unsigned sp = 0;
        while (xb_ld(word) < nblk) { __builtin_amdgcn_s_sleep(2); if (++sp > (1u << 22)) break; }
        __builtin_amdgcn_fence(__ATOMIC_ACQUIRE, "agent");
        asm volatile("s_waitcnt vmcnt(0)" ::: "memory");
    }
    __syncthreads();
}

constexpr int NPHASE = 17;
__global__ void __launch_bounds__(512, 2) hybrid_fwd(Params p) {
    extern __shared__ __attribute__((aligned(16))) unsigned char lds_raw[];
    cg::grid_group grid = cg::this_grid();
    unsigned char* ws = p.ws;
    __shared__ uint4 xb_words;
    if (threadIdx.x == 0) xb_words = make_uint4(0u, 0u, 0u, 0u);
    __syncthreads();
    const XcdBarrier xbar = xcd_barrier_post((unsigned*)(ws + WS_BAR), (volatile LAS unsigned*)&xb_words);
    bf16_t* A1 = (bf16_t*)(ws + WS_A1); bf16_t* BIG = (bf16_t*)(ws + WS_BIG);
    const float* NG = p.in[2];
    for (int ph = p.ph_lo; ph < p.ph_hi; ++ph) {
        int kind = 0;
        pg8::Gemm g{nullptr, nullptr, 0, 0, 0}; pg8::EpiBf16 E{nullptr, 0, 0, nullptr, nullptr, nullptr, (LAS float*)((LAS unsigned char*)lds_raw + 131072)};
        int nmode = 1; const bf16_t* nsrc = nullptr; const float* gA = nullptr; const float* gB = nullptr; int layer = 0;
        const int lyr = ph >= 9 ? 1 : 0; const int q = ph - lyr * 8;
        const bf16_t* Wup = (const bf16_t*)(ws + WS_WB + (lyr ? WB_UP1 : WB_UP0)); const bf16_t* Wdn = (const bf16_t*)(ws + WS_WB + (lyr ? WB_DN1 : WB_DN0));
        const bf16_t* Wout = (const bf16_t*)(ws + WS_WB + (lyr ? WB_OUTO : WB_OUTE));
        bf16_t* ACTF = (bf16_t*)(ws + WS_BIG); bf16_t* HALO = (bf16_t*)(ws + WS_BIG + BIG_HALO);
        int gG = gridDim.x, tailnorm = 0, nlo = 0, nhi = M, then_odd = 0, tailword = 0, ngemm = 1; pg8::Gemm gs{nullptr, nullptr, 0, 0, 0}; bf16_t* EsO = nullptr; const bool split = (gridDim.x == 256); bf16_t* Y2 = (bf16_t*)(ws + WS_Y2);
        if (ph == 0) kind = 0;
        else if (q == 1) { kind = 1; g = pg8::Gemm{A1, (const bf16_t*)(ws + WS_WB + (lyr ? WB_INO : WB_INE)), M, (lyr && split) ? 1792 : PW, D}; E.O = BIG; E.ldc = PW;
            if (lyr && split) {
                ngemm = 2; gs = pg8::Gemm{A1 + (size_t)MHEAD * D, (const bf16_t*)(ws + WS_WB + WB_INO) + (size_t)1792 * D, M - MHEAD, 2304, D}; EsO = BIG + (size_t)MHEAD * PW + 1792; } }
        else if (q == 2) { if (!lyr) kind = 2; else { kind = 1; then_odd = 1; gG = split ? 128 : 0; g = pg8::Gemm{A1, (const bf16_t*)(ws + WS_WB + WB_INO) + (size_t)1792 * D, MHEAD, 2304, D}; E.O = BIG + 1792; E.ldc = PW; } }
        else if (q == 3) { kind = 1; g = pg8::Gemm{lyr ? Y2 : A1, Wout, MHEAD, D, D}; E.O = BIG; E.ldc = D; }
        else if (q == 4) { kind = 1; gG = 8; tailnorm = 1; tailword = 3616 + lyr * 16; g = pg8::Gemm{(lyr ? Y2 : A1) + (size_t)MHEAD * D, Wout, M - MHEAD, D, D}; E.O = BIG + (size_t)MHEAD * D; E.ldc = D;
            nmode = 1; nsrc = BIG; gA = NG + (lyr * 4 + 1) * D; gB = NG + (lyr * 4 + 2) * D; }
        else if (q == 5) {
            kind = 1; g = pg8::Gemm{A1, Wup, M, DFF2, D}; E.O = ACTF; E.ldc = DFF; E.mode = 1; E.cw = p.in[25] + (size_t)lyr * 3 * DFF2; E.cb = p.in[26] + (size_t)lyr * DFF2; E.halo = HALO; }
        else if (q == 6) { kind = 5; layer = lyr; }
        else if (q == 7) { kind = 1; g = pg8::Gemm{ACTF, Wdn, MHEAD, D, DFF}; E.O = A1; E.ldc = D; }
        else {
            nsrc = A1; gA = NG + (lyr * 4 + 3) * D; if (lyr) nmode = 2; else { nmode = 1; gB = NG + (1 * 4 + 0) * D; }
            kind = 1; gG = 8; tailnorm = 1; tailword = 3648 + lyr * 16; g = pg8::Gemm{ACTF + (size_t)MHEAD * DFF, Wdn, M - MHEAD, D, DFF}; E.O = A1 + (size_t)MHEAD * D; E.ldc = D; }

#ifndef PROBE_KIND
#define PROBE_KIND -1
#endif
        for (int rep = 0; rep < ((kind == PROBE_KIND) ? 2 : 1); ++rep) {
        if (rep) xcd_barrier(xbar);
        if (kind == 0) {
            float* tile = (float*)lds_raw;
            bf16_t* wb = (bf16_t*)(ws + WS_WB);
            transpose_job(tile, p.in[3], (bf16_t*)((char*)wb + WB_INE), D, 4096, 4096, 0);
            transpose_job(tile, p.in[4], (bf16_t*)((char*)wb + WB_OUTE), D, D, D, 0);
            transpose_job(tile, p.in[7], (bf16_t*)((char*)wb + WB_INO), D, ODD_IN, 4096, 0);
            transpose_job(tile, p.in[8], (bf16_t*)((char*)wb + WB_OUTO), D, D, D, 0);
            transpose_job(tile, p.in[24], (bf16_t*)((char*)wb + WB_UP0), D, DFF2, DFF2, 1);
            transpose_job(tile, p.in[24] + (size_t)D * DFF2, (bf16_t*)((char*)wb + WB_UP1), D, DFF2, DFF2, 1);
            transpose_job(tile, p.in[27], (bf16_t*)((char*)wb + WB_DN0), DFF, D, D, 0);
            transpose_job(tile, p.in[27] + (size_t)DFF * D, (bf16_t*)((char*)wb + WB_DN1), DFF, D, D, 0);
            norm_phase(p, 0, nullptr, nullptr, NG, A1, 0, M, 0, (int)gridDim.x);
        } else if (kind == 1) {
            const int bid_g = obid();
            for (int gi = 0; gi < ngemm; ++gi) {
                const pg8::Gemm gg = gi ? gs : g; pg8::EpiBf16 EE = E; if (gi) EE.O = EsO;
                const int skipg = gi ? 14 : 0;
                if (bid_g >= skipg && bid_g < gG) { pg8::StaticOrder S; S.init(gg.M, gg.N, gG - skipg, bid_g - skipg); pg8::gemm_phase((LAS unsigned char*)lds_raw, gg, S, EE); }
            }
            if (tailnorm) {
                if (bid_g < 8) { sub_barrier((unsigned*)(ws + WS_BAR) + tailword, 8u); norm_phase(p, nmode, nsrc, gA, gB, A1, MHEAD, M, 0, 8); }
                else norm_phase(p, nmode, nsrc, gA, gB, A1, 0, MHEAD, 8, (int)gridDim.x - 8);
            }
            if (then_odd) {
                if (split && bid_g < 128) sub_barrier((unsigned*)(ws + WS_BAR) + 3600, 128u);
                odd_scan_phase(p, (float*)lds_raw);
            }
        } else if (kind == 2) {
            even_scan_phase(p, (float*)lds_raw);
        } else if (kind == 3) {
            odd_scan_phase(p, (float*)lds_raw);
        } else if (kind == 4) {
            norm_phase(p, nmode, nsrc, gA, gB, A1, nlo, nhi, 0, (int)gridDim.x);
        } else {
            ffn_fixup_phase(p, layer);
        }
        }
        if (ph + 1 < p.ph_hi) { if (p.ph_hi > 1000) grid.sync(); else xcd_barrier(xbar); }
    }
}

extern "C" void kernel_launch(void* const* d_in, const int* in_sizes, int n_in, void* d_out, int out_size, void* d_ws, size_t ws_size, hipStream_t stream) {
    static int grid_blocks = 0;
    if (grid_blocks == 0) {
        if (n_in != 28 || ws_size < WS_END) { fprintf(stderr, "kernel_launch: need 28 inputs and %zu bytes of workspace (got %d, %zu)\n", (size_t)WS_END, n_in, ws_size); grid_blocks = -1; return; }
        int dev = 0, cus = 0, per_cu = 0;
        hipGetDevice(&dev);
        hipDeviceGetAttribute(&cus, hipDeviceAttributeMultiprocessorCount, dev);
        if (hipFuncSetAttribute((const void*)hybrid_fwd, hipFuncAttributeMaxDynamicSharedMemorySize, LDS_BYTES) != hipSuccess) { fprintf(stderr, "kernel_launch: hipFuncSetAttribute failed\n"); grid_blocks = -1; return; }
        if (hipOccupancyMaxActiveBlocksPerMultiprocessor(&per_cu, (const void*)hybrid_fwd, 512, LDS_BYTES) != hipSuccess || per_cu < 1) { fprintf(stderr, "kernel_launch: occupancy query says %d\n", per_cu); per_cu = 1; }
        (void)hipGetLastError();
        grid_blocks = cus;
    }
    if (grid_blocks < 0) return;
    if (hipMemsetAsync((char*)d_ws + WS_BAR, 0, 16384, stream) != hipSuccess) { fprintf(stderr, "kernel_launch: hipMemsetAsync of the barrier words failed\n"); return; }
    Params p{};
    for (int i = 0; i < 28; ++i) p.in[i] = (const float*)d_in[i];
    p.out = (float*)d_out; p.ws = (unsigned char*)d_ws;
#if defined(MK_PER_PHASE)
    for (int ph = 0; ph < NPHASE; ++ph) { p.ph_lo = ph; p.ph_hi = ph + 1; hipLaunchKernelGGL(hybrid_fwd, dim3(grid_blocks), dim3(512), LDS_BYTES, stream, p); }
#else
    p.ph_lo = 0; p.ph_hi = NPHASE;
    void* args[] = {&p};
    hipError_t e = hipLaunchCooperativeKernel((const void*)hybrid_fwd, dim3(grid_blocks), dim3(512), args, LDS_BYTES, stream);
    if (e != hipSuccess) fprintf(stderr, "kernel_launch: cooperative launch failed: %s (grid %d)\n", hipGetErrorString(e), grid_blocks);
#endif
}
```
